# Optimizing an MI355X kernel written in HIP

```python
import math
import jax, jax.numpy as jnp
from jax import lax
import numpy as np

D_MODEL = 1024
BATCH = 8
SEQ = 4096
DEPTH = 1

CONV_CH = 512
CONV_K = 3
N_HEADS = 8
HEAD_DIM = 64
N_KV = 2
HPG = N_HEADS // N_KV
ATTN_W = N_HEADS * HEAD_DIM
KV_W = N_KV * HEAD_DIM
MIX_W = CONV_CH + ATTN_W
CMP_BLOCK = 32
CMP_STRIDE = 16
CMP_HIDDEN = 256
SEL_BLOCK = 64
SEL_TOP = 16
WINDOW = 512
Q_BLOCK = 64
N_GATES = 3 * N_HEADS
PEER_HEADS = 8
PEER_NKEYS = 128
PEER_EXPERTS = PEER_NKEYS * PEER_NKEYS
PEER_DKEY = 256
PEER_TOPK = 16
PEER_CHUNK = 128

EPS = 1e-6
NEG_INF = -1e30
FORCE = 1e4

COL_SIZES = [CONV_CH, CONV_CH, CONV_CH, ATTN_W, KV_W, KV_W, KV_W, KV_W, KV_W, KV_W, N_GATES]
IN_COLS = sum(COL_SIZES)
SPLIT_POINTS = list(np.cumsum(COL_SIZES)[:-1])

kernel_name = "hybrid_conv_nsa_peer_layer"


def rms_norm(x, g):
    x32 = x.astype(jnp.float32)
    y = x32 * lax.rsqrt(jnp.mean(x32 * x32, axis=-1, keepdims=True) + EPS)
    return (y * g.astype(jnp.float32)).astype(x.dtype)


def masked_softmax(s, valid):
    s = jnp.where(valid, s.astype(jnp.float32), NEG_INF)
    return jax.nn.softmax(s, axis=-1)


def short_conv(z, w):
    c = z.shape[-1]
    return lax.conv_general_dilated(
        z, w[:, None, :].astype(z.dtype), window_strides=(1,),
        padding=[(CONV_K - 1, 0)], dimension_numbers=("NWC", "WIO", "NWC"),
        feature_group_count=c)


def compress_blocks(k, pos, w1, w2):
    b, s = k.shape[0], k.shape[1]
    n_cmp = (s - CMP_BLOCK) // CMP_STRIDE + 1
    idx = (jnp.arange(n_cmp) * CMP_STRIDE)[:, None] + jnp.arange(CMP_BLOCK)[None, :]
    blocks = k[:, idx] + pos[None, None, :, None, :]
    flat = blocks.transpose(0, 1, 3, 2, 4).reshape(b, n_cmp, N_KV, CMP_BLOCK * HEAD_DIM)
    return jax.nn.gelu(flat @ w1) @ w2


def nsa(q, kc, vc, ks, vs, kw, vw, gates):
    b, s = q.shape[0], q.shape[1]
    dt = q.dtype
    n_cmp = kc.shape[1]
    n_sel = s // SEL_BLOCK
    n_top = min(SEL_TOP, n_sel)
    scale = HEAD_DIM ** -0.5
    cmp_start = jnp.arange(n_cmp) * CMP_STRIDE
    cmp_end = cmp_start + CMP_BLOCK - 1
    sel_start = jnp.arange(n_sel) * SEL_BLOCK
    overlap = ((cmp_start[:, None] < sel_start[None, :] + SEL_BLOCK)
               & (cmp_start[:, None] + CMP_BLOCK > sel_start[None, :])).astype(jnp.float32)
    ks_blk = ks.reshape(b, n_sel, SEL_BLOCK, N_KV, HEAD_DIM).transpose(0, 3, 1, 2, 4)
    vs_blk = vs.reshape(b, n_sel, SEL_BLOCK, N_KV, HEAD_DIM).transpose(0, 3, 1, 2, 4)
    kw_pad = jnp.pad(kw, ((0, 0), (WINDOW, 0), (0, 0), (0, 0)))
    vw_pad = jnp.pad(vw, ((0, 0), (WINDOW, 0), (0, 0), (0, 0)))
    gather_blocks = jax.vmap(jax.vmap(lambda kb, ix: kb[ix]))
    j = jnp.arange(n_sel)

    def block(i):
        t0 = i * Q_BLOCK
        tq = t0 + jnp.arange(Q_BLOCK)
        qb = lax.dynamic_slice_in_dim(q, t0, Q_BLOCK, axis=1).reshape(b, Q_BLOCK, N_KV, HPG, HEAD_DIM)
        s_c = jnp.einsum('bqghd,bngd->bghqn', qb, kc).astype(jnp.float32) * scale
        valid_c = cmp_end[None, :] <= tq[:, None]
        has_c = jnp.any(valid_c, axis=-1).astype(jnp.float32)[:, None]
        p_c = masked_softmax(s_c, valid_c) * has_c
        o_c = jnp.einsum('bghqn,bngd->bqghd', p_c.astype(dt), vc)
        imp = jnp.einsum('bghqn,nj->bgqj', p_c, overlap)
        qblk = tq // SEL_BLOCK
        forced = (j[None, :] == 0) | (j[None, :] == qblk[:, None]) | (j[None, :] == qblk[:, None] - 1)
        imp = jnp.where(j[None, :] > qblk[:, None], -FORCE, imp + jnp.where(forced, FORCE, 0.0))
        _, sel = lax.top_k(imp, n_top)
        k_sel = gather_blocks(ks_blk, sel)
        v_sel = gather_blocks(vs_blk, sel).reshape(b, N_KV, Q_BLOCK, n_top * SEL_BLOCK, HEAD_DIM)
        kpos = sel[..., None] * SEL_BLOCK + jnp.arange(SEL_BLOCK)
        valid_s = (kpos <= tq[None, None, :, None, None]).reshape(b, N_KV, Q_BLOCK, n_top * SEL_BLOCK)
        s_s = jnp.einsum('bqghd,bgqnkd->bghqnk', qb, k_sel).reshape(
            b, N_KV, HPG, Q_BLOCK, n_top * SEL_BLOCK).astype(jnp.float32) * scale
        p_s = masked_softmax(s_s, valid_s[:, :, None])
        o_s = jnp.einsum('bghqm,bgqmd->bqghd', p_s.astype(dt), v_sel)
        kwb = lax.dynamic_slice_in_dim(kw_pad, t0, WINDOW + Q_BLOCK, axis=1)
        vwb = lax.dynamic_slice_in_dim(vw_pad, t0, WINDOW + Q_BLOCK, axis=1)
        tk = t0 - WINDOW + jnp.arange(WINDOW + Q_BLOCK)
        valid_w = (tk[None, :] <= tq[:, None]) & (tk[None, :] > tq[:, None] - WINDOW) & (tk[None, :] >= 0)
        s_w = jnp.einsum('bqghd,bkgd->bghqk', qb, kwb).astype(jnp.float32) * scale
        p_w = masked_softmax(s_w, valid_w)
        o_w = jnp.einsum('bghqk,bkgd->bqghd', p_w.astype(dt), vwb)
        g = lax.dynamic_slice_in_dim(gates, t0, Q_BLOCK, axis=1).reshape(b, Q_BLOCK, N_KV, HPG, 3).astype(dt)
        o = g[..., 0:1] * o_c + g[..., 1:2] * o_s + g[..., 2:3] * o_w
        return o.reshape(b, Q_BLOCK, ATTN_W)

    out = lax.map(block, jnp.arange(s // Q_BLOCK))
    return out.transpose(1, 0, 2, 3).reshape(b, s, ATTN_W)


def peer(xn, wq, subkeys, u, v):
    b, s, d = xn.shape
    t = b * s
    xt = xn.reshape(t, d)
    q = (xt @ wq).reshape(t, PEER_HEADS, 2, PEER_DKEY // 2)
    sc = jnp.einsum('thcd,hcnd->thcn', q, subkeys).astype(jnp.float32)
    sv, si = lax.top_k(sc, PEER_TOPK)
    cand = (sv[:, :, 0, :, None] + sv[:, :, 1, None, :]).reshape(t, PEER_HEADS, PEER_TOPK * PEER_TOPK)
    best, bi = lax.top_k(cand, PEER_TOPK)
    i1 = jnp.take_along_axis(si[:, :, 0], bi // PEER_TOPK, axis=-1)
    i2 = jnp.take_along_axis(si[:, :, 1], bi % PEER_TOPK, axis=-1)
    eidx = (i1 * PEER_NKEYS + i2).reshape(t, PEER_HEADS * PEER_TOPK)
    gate = jax.nn.softmax(best, axis=-1).reshape(t, PEER_HEADS * PEER_TOPK).astype(xn.dtype)
    n_c = t // PEER_CHUNK

    def chunk(args):
        xc, ec, gc = args
        h = jnp.einsum('td,tkd->tk', xc, u[ec])
        a = gc * jax.nn.gelu(h)
        return jnp.einsum('tk,tkd->td', a, v[ec])

    out = lax.map(chunk, (xt.reshape(n_c, PEER_CHUNK, d),
                          eidx.reshape(n_c, PEER_CHUNK, PEER_HEADS * PEER_TOPK),
                          gate.reshape(n_c, PEER_CHUNK, PEER_HEADS * PEER_TOPK)))
    return out.reshape(b, s, d)


def setup_inputs(seed: int = 0) -> dict:
    key = jax.random.key(seed)
    ks = jax.random.split(key, 20)
    f32 = jnp.float32
    nrm = lambda k, shape, sc: jax.random.normal(k, shape, f32) * sc
    L = DEPTH
    return {
        "x": nrm(ks[0], (BATCH, SEQ, D_MODEL), 1.0),
        "ln1": 1.0 + nrm(ks[1], (L, D_MODEL), 0.02),
        "w_in": nrm(ks[2], (L, D_MODEL, IN_COLS), D_MODEL ** -0.5),
        "conv_w": nrm(ks[3], (L, CONV_K, CONV_CH), CONV_K ** -0.5),
        "cmp_pos_k": nrm(ks[4], (L, CMP_BLOCK, HEAD_DIM), 0.1),
        "cmp_pos_v": nrm(ks[5], (L, CMP_BLOCK, HEAD_DIM), 0.1),
        "cmp_k_w1": nrm(ks[6], (L, CMP_BLOCK * HEAD_DIM, CMP_HIDDEN), (CMP_BLOCK * HEAD_DIM) ** -0.5),
        "cmp_k_w2": nrm(ks[7], (L, CMP_HIDDEN, HEAD_DIM), CMP_HIDDEN ** -0.5),
        "cmp_v_w1": nrm(ks[8], (L, CMP_BLOCK * HEAD_DIM, CMP_HIDDEN), (CMP_BLOCK * HEAD_DIM) ** -0.5),
        "cmp_v_w2": nrm(ks[9], (L, CMP_HIDDEN, HEAD_DIM), CMP_HIDDEN ** -0.5),
        "gn_conv": 1.0 + nrm(ks[10], (L, CONV_CH), 0.02),
        "gn_attn": 1.0 + nrm(ks[11], (L, ATTN_W), 0.02),
        "w_out": nrm(ks[12], (L, MIX_W, D_MODEL), MIX_W ** -0.5),
        "ln2": 1.0 + nrm(ks[13], (L, D_MODEL), 0.02),
        "peer_wq": nrm(ks[14], (L, D_MODEL, PEER_HEADS * PEER_DKEY), D_MODEL ** -0.5),
        "peer_subkeys": nrm(ks[15], (L, PEER_HEADS, 2, PEER_NKEYS, PEER_DKEY // 2), (PEER_DKEY // 2) ** -0.5),
        "peer_u": nrm(ks[16], (L, PEER_EXPERTS, D_MODEL), D_MODEL ** -0.5),
        "peer_v": nrm(ks[17], (L, PEER_EXPERTS, D_MODEL), 0.5),
        "ln_f": 1.0 + nrm(ks[18], (D_MODEL,), 0.02),
    }


def reference(x, ln1, w_in, conv_w, cmp_pos_k, cmp_pos_v, cmp_k_w1, cmp_k_w2, cmp_v_w1, cmp_v_w2,
              gn_conv, gn_attn, w_out, ln2, peer_wq, peer_subkeys, peer_u, peer_v, ln_f):
    b, s, _ = x.shape
    h = x
    for l in range(DEPTH):
        xn = rms_norm(h, ln1[l])
        proj = xn @ w_in[l]
        c_h, c_b, c_c, q, kc, vc, ksl, vsl, kwn, vwn, g = jnp.split(proj, SPLIT_POINTS, axis=-1)
        conv_out = c_b * short_conv(c_c * c_h, conv_w[l])
        r = lambda t: t.reshape(b, s, N_KV, HEAD_DIM)
        kc_c = compress_blocks(r(kc), cmp_pos_k[l], cmp_k_w1[l], cmp_k_w2[l])
        vc_c = compress_blocks(r(vc), cmp_pos_v[l], cmp_v_w1[l], cmp_v_w2[l])
        gates = jax.nn.sigmoid(g.astype(jnp.float32)).reshape(b, s, N_HEADS, 3)
        attn_out = nsa(q.reshape(b, s, N_HEADS, HEAD_DIM), kc_c, vc_c, r(ksl), r(vsl), r(kwn), r(vwn), gates)
        mix = jnp.concatenate([rms_norm(conv_out, gn_conv[l]), rms_norm(attn_out, gn_attn[l])], axis=-1)
        h = h + mix @ w_out[l]
        h = h + peer(rms_norm(h, ln2[l]), peer_wq[l], peer_subkeys[l], peer_u[l], peer_v[l])
    return rms_norm(h, ln_f)
```

```cpp
#include <hip/hip_runtime.h>
#include <cstdio>
#include <cstdint>
namespace pg8 {
#define PG8_LAS __attribute__((address_space(3)))
typedef unsigned short bf16_t;
typedef short bf16x8 __attribute__((ext_vector_type(8)));
typedef float f32x4 __attribute__((ext_vector_type(4)));
typedef unsigned u32x4 __attribute__((ext_vector_type(4)));
constexpr int BM = 256, BK = 64, HALF = 128, HTB = HALF * BK * 2  , STAGE_BYTES = 8 * HTB, NXCD = 8, WGM = 8;

__host__ __device__ __forceinline__ int lds_byte(int r, int c) { const int st = (r >> 4) * 2 + (c >> 5), rr = r & 15, cc = c & 31, ob = rr * 64 + cc * 2; return st * 1024 + (ob ^ (((ob >> 9) & 1) << 5)); }
__host__ __device__ __forceinline__ void stage_rc(int b, int& R, int& C) { const int st = b / 1024, sb = b % 1024, swz = sb ^ (((sb >> 9) & 1) << 5); R = (st >> 1) * 16 + swz / 64; C = (st & 1) * 32 + (swz % 64) / 2; }
__host__ __device__ __forceinline__ int perm32(int rho) { const int n = rho >> 4, i = rho & 15; return 8 * (i >> 2) + 4 * n + (i & 3); }

struct Unit { int pm, pn; };
struct Gemm { const bf16_t* A; const bf16_t* Bt; int M, N, K; };

struct StaticOrder {
    int nM, nN, nwg, G, c;
    __host__ __device__ void init(int M, int N, int G_, int c_) { nM = M / BM; nN = N / BM; nwg = nM * nN; G = G_; c = c_; }
    __host__ __device__ bool next(int i, Unit& u) const {
        const long L = (long)i * G + c; if (L >= nwg) return false;
        int wgid = (int)L; { const int q = nwg / NXCD, r = nwg % NXCD, xcd = wgid % NXCD, off = wgid / NXCD; wgid = (xcd < r ? xcd * (q + 1) : r * (q + 1) + (xcd - r) * q) + off; }
        const int nig = WGM * nN, gid = wgid / nig, fm = gid * WGM, gsz = (nM - fm) < WGM ? (nM - fm) : WGM;
        u.pm = fm + ((wgid % nig) % gsz); u.pn = (wgid % nig) / gsz; return true;
    }
    __device__ __forceinline__ void a_ready(const Unit&) const {}
    __device__ __forceinline__ void done(const Unit&) const {}
};

__device__ __forceinline__ unsigned cvt_pk_bf16(float lo, float hi) { unsigned r; asm volatile("v_cvt_pk_bf16_f32 %0, %1, %2" : "=v"(r) : "v"(lo), "v"(hi)); return r; }
typedef float f32x2 __attribute__((ext_vector_type(2)));
__device__ __forceinline__ f32x2 gelu_pk(f32x2 v) {
    const f32x2 av = __builtin_elementwise_abs(v), d = av * 0.2316418882f + 1.0f;
    f32x2 t; t.x = __builtin_amdgcn_rcpf(d.x); t.y = __builtin_amdgcn_rcpf(d.y);
    f32x2 q = t * 0.5307027145f + (-0.7265760135f); q = q * t + 0.7107068705f; q = q * t + (-0.142248368f); q = q * t + 0.127414796f; q = q * t;
    const f32x2 s = (v * v) * (-0.72134752044f);
    f32x2 e; e.x = __builtin_amdgcn_exp2f(s.x); e.y = __builtin_amdgcn_exp2f(s.y);
    const f32x2 m = v * (q * e), r = v - m;
    f32x2 o; o.x = v.x < 0.f ? m.x : r.x; o.y = v.y < 0.f ? m.y : r.y; return o;
}

template <int ACT  > struct EpiBf16 {
    static constexpr bool PERM = true, AFTER_DRAIN = false, PRE = false; static_assert(ACT == 0 || ACT == 1, "EpiBf16: ACT is 0 (none) or 1 (gelu_pk)");
    bf16_t* O; int ldc; const float* bias; int split_cols; size_t split_stride; float scale0;
    __device__ __forceinline__ void operator()(const f32x4 (&acc)[2][2][4][2], const Unit& u, int wr, int wc, int fr, int fq) const {
        const int row0 = u.pm * BM + wr * 64 + fr; int colt = u.pn * BM; bf16_t* base = O;
        float sc = 1.f; if (split_cols) { const int t = colt / split_cols; base += (size_t)t * split_stride; colt -= t * split_cols; if (t == 0) sc = scale0; }
        const int col0 = colt + wc * 32 + 8 * fq, bcol0 = u.pn * BM + wc * 32 + 8 * fq;
        f32x4 bv[2][2];
#pragma unroll
        for (int bj = 0; bj < 2; ++bj)
#pragma unroll
            for (int n = 0; n < 2; ++n) bv[bj][n] = bias ? *(const f32x4*)(bias + bcol0 + bj * HALF + 4 * n) : (f32x4){0.f, 0.f, 0.f, 0.f};
#pragma unroll
        for (int ai = 0; ai < 2; ++ai)
#pragma unroll
            for (int m = 0; m < 4; ++m) { bf16_t* rowp = base + (size_t)(row0 + ai * HALF + m * 16) * ldc + col0;
#pragma unroll
                for (int bj = 0; bj < 2; ++bj) { f32x4 v0 = acc[ai][bj][m][0] + bv[bj][0], v1 = acc[ai][bj][m][1] + bv[bj][1];
                    if (ACT == 1) { f32x2 a = gelu_pk((f32x2){v0[0], v0[1]}), b = gelu_pk((f32x2){v0[2], v0[3]}), c = gelu_pk((f32x2){v1[0], v1[1]}), d = gelu_pk((f32x2){v1[2], v1[3]});
                        v0 = (f32x4){a.x, a.y, b.x, b.y}; v1 = (f32x4){c.x, c.y, d.x, d.y}; }
                    v0 = v0 * sc; v1 = v1 * sc; u32x4 w; w.x = cvt_pk_bf16(v0[0], v0[1]); w.y = cvt_pk_bf16(v0[2], v0[3]); w.z = cvt_pk_bf16(v1[0], v1[1]); w.w = cvt_pk_bf16(v1[2], v1[3]);
                    *(u32x4*)(rowp + bj * HALF) = w; } }
    }
};
typedef unsigned u32x2e __attribute__((ext_vector_type(2)));
struct EpiProj {
    static constexpr bool PERM = true, AFTER_DRAIN = false, PRE = false;
    bf16_t* O; int ldc; int qt0, qt1; float qscale;
    __device__ __forceinline__ void operator()(const f32x4 (&acc)[2][2][4][2], const Unit& u, int wr, int wc, int fr, int fq) const {
        const int row0 = u.pm * BM + wr * 64 + fr; const int col0 = u.pn * BM + wc * 32 + 8 * fq;
        const float sc = (u.pn >= qt0 && u.pn < qt1) ? qscale : 1.f;
#pragma unroll
        for (int ai = 0; ai < 2; ++ai)
#pragma unroll
            for (int m = 0; m < 4; ++m) { bf16_t* rowp = O + (size_t)(row0 + ai * HALF + m * 16) * ldc + col0;
#pragma unroll
                for (int bj = 0; bj < 2; ++bj) { const f32x4 v0 = acc[ai][bj][m][0] * sc, v1 = acc[ai][bj][m][1] * sc;
                    u32x4 w; w.x = cvt_pk_bf16(v0[0], v0[1]); w.y = cvt_pk_bf16(v0[2], v0[3]); w.z = cvt_pk_bf16(v1[0], v1[1]); w.w = cvt_pk_bf16(v1[2], v1[3]);
                    *(u32x4*)(rowp + bj * HALF) = w; } }
    }
};
struct EpiResid {
    static constexpr bool PERM = false, AFTER_DRAIN = false, PRE = false;
    const float* base; bf16_t* hb; float* ssq; int ldc;
    __device__ __forceinline__ void operator()(const f32x4 (&acc)[2][2][4][2], const Unit& u, int wr, int wc, int fr, int fq) const {
        const int col0 = u.pn * BM + wc * 32 + 4 * fq;
#pragma unroll
        for (int ai = 0; ai < 2; ++ai)
#pragma unroll
            for (int m = 0; m < 4; ++m) { const int r = u.pm * BM + ai * HALF + wr * 64 + m * 16 + fr; const size_t off = (size_t)r * ldc + col0; float s = 0.f;
#pragma unroll
                for (int bj = 0; bj < 2; ++bj)
#pragma unroll
                    for (int n = 0; n < 2; ++n) { const f32x4 bs = *(const f32x4*)(base + off + bj * HALF + n * 16); const f32x4 o = bs + acc[ai][bj][m][n];
                        s += (o[0] * o[0] + o[1] * o[1]) + (o[2] * o[2] + o[3] * o[3]);
                        u32x2e w; w.x = cvt_pk_bf16(o[0], o[1]); w.y = cvt_pk_bf16(o[2], o[3]); *(u32x2e*)(hb + off + bj * HALF + n * 16) = w; }
                s += __shfl_xor(s, 16); s += __shfl_xor(s, 32);
                if (fq == 0) ssq[(size_t)r * 16 + u.pn * 4 + wc] = s;
                if (m & 1) asm volatile("" ::: "memory"); }
    }
};
struct EpiScaleRow {
    static constexpr bool PERM = true, AFTER_DRAIN = false, PRE = true;
    bf16_t* O; int ldc; const float* ssq; float eps;
    __device__ __forceinline__ void pre(const Unit& u, int wr, int fr, int fq, f32x4 (&pq)[8]) const {
        const int row0 = u.pm * BM + wr * 64 + fr;
#pragma unroll
        for (int m = 0; m < 4; ++m) pq[m] = *(const f32x4*)(ssq + (size_t)(row0 + m * 16) * 16 + 4 * fq);
    }
    __device__ __forceinline__ void operator()(const f32x4 (&acc)[2][2][4][2], const Unit& u, int wr, int wc, int fr, int fq, const f32x4 (&pq)[8]) const {
        const int row0 = u.pm * BM + wr * 64 + fr;
        f32x4 p2[4];
#pragma unroll
        for (int m = 0; m < 4; ++m) p2[m] = *(const f32x4*)(ssq + (size_t)(row0 + HALF + m * 16) * 16 + 4 * fq);
#pragma unroll
        for (int ai = 0; ai < 2; ++ai)
#pragma unroll
            for (int m = 0; m < 4; ++m) { const int r = row0 + ai * HALF + m * 16; const f32x4 t4 = ai ? p2[m] : pq[m]; float tot = (t4[0] + t4[1]) + (t4[2] + t4[3]);
                tot += __shfl_xor(tot, 16); tot += __shfl_xor(tot, 32);
                const float rs = 1.0f / sqrtf(tot * (1.0f / 1024.0f) + eps);
#pragma unroll
                for (int bj = 0; bj < 2; ++bj) { const f32x4 v0 = acc[ai][bj][m][0] * rs, v1 = acc[ai][bj][m][1] * rs;
                    u32x4 w; w.x = cvt_pk_bf16(v0[0], v0[1]); w.y = cvt_pk_bf16(v0[2], v0[3]); w.z = cvt_pk_bf16(v1[0], v1[1]); w.w = cvt_pk_bf16(v1[2], v1[3]);
                    const size_t blk = ((size_t)(r >> 5) * 16 + (u.pn * 2 + bj)) * 8 + (2 * wc + (fq >> 1));
                    *(u32x4*)(O + blk * 512 + ((fq & 1) * 32 + (r & 31)) * 8) = w; } }
    }
};

template <class Epi, class Sched, bool ALIGN_EPI = false, bool SP2 = false>
__device__ __forceinline__ void gemm_phase(PG8_LAS unsigned char* lds, const Gemm g, const Sched& S, const Epi& E) {
    const int tid = threadIdx.x, wid = __builtin_amdgcn_readfirstlane(tid >> 6), lane = tid & 63, wr = wid >> 2, wc = wid & 3, fr = lane & 15, fq = lane >> 4;
    const int K = g.K, nt = K / BK;
    unsigned voffA[2], voffB[2];
#pragma unroll
    for (int i = 0; i < 2; ++i) { int R, C; stage_rc(tid * 16 + i * 8192, R, C); const int Rb = Epi::PERM ? ((R & ~31) + perm32(R & 31)) : R;
        voffA[i] = (unsigned)(R * K + C) * 2u; voffB[i] = (unsigned)(Rb * K + C) * 2u; }
    const size_t kstep = (size_t)(BK * 2);
    const size_t hstep = (size_t)HALF * K * 2;
    const size_t tstep = 2 * hstep;
    const unsigned ldsw = (unsigned)wid * 1024u;
    const int aoff = lds_byte(wr * 64 + fr, fq * 8), boff = lds_byte(wc * 32 + fr, fq * 8);
#define PG8_SA(b, h) (((b) * 2 + (h)) * HTB)
#define PG8_SB(b, h) ((4 + (b) * 2 + (h)) * HTB)
#define PG8_STAGE(bufoff, gbase, voff) do { _Pragma("unroll") for (int _i = 0; _i < 2; ++_i) \
        __builtin_amdgcn_global_load_lds((const unsigned*)((const char*)(gbase) + (voff)[_i]), (PG8_LAS unsigned*)(lds + (bufoff) + ldsw + _i * 8192), 16, 0, 0); } while (0)
#define PG8_LDA(dst, b, h) do { _Pragma("unroll") for (int m = 0; m < 4; ++m) _Pragma("unroll") for (int k = 0; k < 2; ++k) dst[m][k] = *(const PG8_LAS bf16x8*)(lds + PG8_SA(b, h) + aoff + m * 2048 + k * 1024); } while (0)
#define PG8_LDB(dst, b, h) do { _Pragma("unroll") for (int n = 0; n < 2; ++n) _Pragma("unroll") for (int k = 0; k < 2; ++k) dst[n][k] = *(const PG8_LAS bf16x8*)(lds + PG8_SB(b, h) + boff + n * 2048 + k * 1024); } while (0)
#define PG8_MMA(ai, bj, At, Bt) do { __builtin_amdgcn_s_setprio(1); _Pragma("unroll") for (int m = 0; m < 4; ++m) _Pragma("unroll") for (int n = 0; n < 2; ++n) _Pragma("unroll") for (int k = 0; k < 2; ++k) \
        acc[ai][bj][m][n] = __builtin_amdgcn_mfma_f32_16x16x32_bf16(Bt[n][k], At[m][k], acc[ai][bj][m][n], 0, 0, 0); __builtin_amdgcn_s_setprio(0); } while (0)
#define PG8_WAIT_V(n) asm volatile("s_waitcnt vmcnt(" #n ")" ::: "memory")
#define PG8_WAIT_L(n) asm volatile("s_waitcnt lgkmcnt(" #n ")" ::: "memory")
#define PG8_BAR __builtin_amdgcn_s_barrier()
#define PG8_SCHED __builtin_amdgcn_sched_barrier(0)
    Unit cur, nxt; int ui = 0;
    if (!S.next(0, cur)) return;
    f32x4 acc[2][2][4][2];
#pragma unroll
    for (int a = 0; a < 2; ++a)
#pragma unroll
        for (int b = 0; b < 2; ++b)
#pragma unroll
            for (int m = 0; m < 4; ++m)
#pragma unroll
                for (int n = 0; n < 2; ++n) acc[a][b][m][n] = (f32x4){0.f, 0.f, 0.f, 0.f};
    bf16x8 At[4][2], B0[2][2], B1[2][2];
    const char* cA = (const char*)g.A + (size_t)cur.pm * tstep; const char* cB = (const char*)g.Bt + (size_t)cur.pn * tstep;
    S.a_ready(cur);
    if constexpr (SP2) {
        PG8_STAGE(PG8_SB(0, 0), cB, voffB); PG8_STAGE(PG8_SB(0, 1), cB + hstep, voffB); PG8_STAGE(PG8_SA(0, 0), cA, voffA); PG8_STAGE(PG8_SA(0, 1), cA + hstep, voffA);
        if (wr == 1) PG8_BAR;
        PG8_WAIT_V(2); PG8_BAR;
        PG8_STAGE(PG8_SB(1, 0), cB + kstep, voffB); PG8_STAGE(PG8_SA(1, 0), cA + kstep, voffA); PG8_STAGE(PG8_SB(1, 1), cB + hstep + kstep, voffB);
        PG8_WAIT_V(6); PG8_BAR;
    } else {
        PG8_STAGE(PG8_SB(0, 0), cB, voffB); PG8_STAGE(PG8_SA(0, 0), cA, voffA); PG8_STAGE(PG8_SB(0, 1), cB + hstep, voffB); PG8_STAGE(PG8_SA(0, 1), cA + hstep, voffA);
        if (wr == 1) PG8_BAR;
        PG8_WAIT_V(4); PG8_BAR;
        PG8_STAGE(PG8_SB(1, 0), cB + kstep, voffB); PG8_STAGE(PG8_SA(1, 0), cA + kstep, voffA); PG8_STAGE(PG8_SB(1, 1), cB + hstep + kstep, voffB);
        PG8_WAIT_V(6); PG8_BAR;
    }
    for (;;) {
        const bool has_next = S.next(ui + 1, nxt);
        const char* nA = has_next ? (const char*)g.A + (size_t)nxt.pm * tstep : cA; const char* nB = has_next ? (const char*)g.Bt + (size_t)nxt.pn * tstep : cB;
        f32x4 epre[8]; if constexpr (Epi::PRE) E.pre(cur, wr, fr, fq, epre);
        for (int t = 0; t < nt; t += 2) {
            const bool last = (t == nt - 2);
            const char* a1 = cA + (size_t)(t + 1) * kstep;
            const char* a2 = last ? nA : cA + (size_t)(t + 2) * kstep; const char* b2 = last ? nB : cB + (size_t)(t + 2) * kstep;
            const char* a3 = a2 + kstep; const char* b3 = b2 + kstep;
            if (last && has_next) S.a_ready(nxt);
            if constexpr (SP2) {
            PG8_LDB(B0, 0, 0); PG8_LDB(B1, 0, 1); PG8_SCHED; PG8_LDA(At, 0, 0); PG8_STAGE(PG8_SA(1, 1), a1 + hstep, voffA);
            PG8_WAIT_V(8); PG8_WAIT_L(0); PG8_BAR; PG8_MMA(0, 0, At, B0); PG8_MMA(0, 1, At, B1); PG8_BAR; PG8_SCHED;
            PG8_LDA(At, 0, 1); PG8_STAGE(PG8_SB(0, 0), b2, voffB); PG8_STAGE(PG8_SB(0, 1), b2 + hstep, voffB); PG8_STAGE(PG8_SA(0, 0), a2, voffA);
            PG8_WAIT_V(8); PG8_WAIT_L(0); PG8_BAR; PG8_MMA(1, 0, At, B0); PG8_MMA(1, 1, At, B1); PG8_BAR; PG8_SCHED;
            PG8_LDB(B0, 1, 0); PG8_LDB(B1, 1, 1); PG8_SCHED; PG8_LDA(At, 1, 0); PG8_STAGE(PG8_SA(0, 1), a2 + hstep, voffA);
            PG8_WAIT_V(8); PG8_WAIT_L(0); PG8_BAR; PG8_MMA(0, 0, At, B0); PG8_MMA(0, 1, At, B1); PG8_BAR; PG8_SCHED;
            PG8_LDA(At, 1, 1); PG8_STAGE(PG8_SB(1, 0), b3, voffB); PG8_STAGE(PG8_SB(1, 1), b3 + hstep, voffB); PG8_STAGE(PG8_SA(1, 0), a3, voffA);
            PG8_WAIT_V(8); PG8_WAIT_L(0); PG8_BAR; PG8_MMA(1, 0, At, B0); PG8_MMA(1, 1, At, B1); PG8_BAR; PG8_SCHED;
            } else {
            PG8_LDB(B0, 0, 0); PG8_SCHED; PG8_LDA(At, 0, 0); PG8_STAGE(PG8_SA(1, 1), a1 + hstep, voffA);
            PG8_WAIT_L(8); PG8_BAR; PG8_WAIT_L(0); PG8_MMA(0, 0, At, B0); PG8_BAR; PG8_SCHED;
            PG8_LDB(B1, 0, 1); PG8_STAGE(PG8_SB(0, 0), b2, voffB);
            PG8_BAR; PG8_WAIT_L(0); PG8_MMA(0, 1, At, B1); PG8_BAR;
            PG8_LDA(At, 0, 1); PG8_STAGE(PG8_SA(0, 0), a2, voffA);
            PG8_BAR; PG8_WAIT_L(0); PG8_MMA(1, 0, At, B0); PG8_BAR; PG8_SCHED;
            PG8_STAGE(PG8_SB(0, 1), b2 + hstep, voffB);
            PG8_WAIT_V(6); PG8_BAR; PG8_MMA(1, 1, At, B1); PG8_BAR;
            PG8_LDB(B0, 1, 0); PG8_SCHED; PG8_LDA(At, 1, 0); PG8_STAGE(PG8_SA(0, 1), a2 + hstep, voffA);
            PG8_WAIT_L(8); PG8_BAR; PG8_WAIT_L(0); PG8_MMA(0, 0, At, B0); PG8_BAR; PG8_SCHED;
            PG8_LDB(B1, 1, 1); PG8_STAGE(PG8_SB(1, 0), b3, voffB);
            PG8_BAR; PG8_WAIT_L(0); PG8_MMA(0, 1, At, B1); PG8_BAR;
            PG8_LDA(At, 1, 1); PG8_STAGE(PG8_SA(1, 0), a3, voffA);
            PG8_BAR; PG8_WAIT_L(0); PG8_MMA(1, 0, At, B0); PG8_BAR; PG8_SCHED;
            PG8_STAGE(PG8_SB(1, 1), b3 + hstep, voffB);
            PG8_WAIT_V(6); PG8_BAR; PG8_MMA(1, 1, At, B1); PG8_BAR;
            }
        }
        if constexpr (ALIGN_EPI) { if (wr == 0) PG8_BAR; }
        if constexpr (!Epi::AFTER_DRAIN) { if constexpr (Epi::PRE) E(acc, cur, wr, wc, fr, fq, epre); else E(acc, cur, wr, wc, fr, fq); S.done(cur); }
        if (!has_next) break;
#pragma unroll
        for (int a = 0; a < 2; ++a)
#pragma unroll
            for (int b = 0; b < 2; ++b)
#pragma unroll
                for (int m = 0; m < 4; ++m)
#pragma unroll
                    for (int n = 0; n < 2; ++n) acc[a][b][m][n] = (f32x4){0.f, 0.f, 0.f, 0.f};
        cur = nxt; cA = nA; cB = nB; ++ui;
        if constexpr (ALIGN_EPI) { if (wr == 1) PG8_BAR; }
    }
    PG8_WAIT_V(0);
    if constexpr (!ALIGN_EPI) { if (wr == 0) PG8_BAR; }
    PG8_BAR;
    if constexpr (Epi::AFTER_DRAIN) { E.fused(acc, cur, wr, wc, fr, fq, lds, wid, lane); S.done(cur); }
#undef PG8_SA
#undef PG8_SB
#undef PG8_STAGE
#undef PG8_LDA
#undef PG8_LDB
#undef PG8_MMA
#undef PG8_WAIT_V
#undef PG8_WAIT_L
#undef PG8_BAR
#undef PG8_SCHED
}
}
#define GAS __attribute__((address_space(1)))
#define LAS __attribute__((address_space(3)))
typedef unsigned short bf16;
typedef unsigned v4u __attribute__((ext_vector_type(4)));
typedef unsigned v2u __attribute__((ext_vector_type(2)));
typedef float f32x4 __attribute__((ext_vector_type(4)));
typedef float f32x16 __attribute__((ext_vector_type(16)));
typedef float f32x2 __attribute__((ext_vector_type(2)));
typedef short bf16x8 __attribute__((ext_vector_type(8)));
typedef short s16x4 __attribute__((ext_vector_type(4)));
typedef __bf16 bf16x2v __attribute__((ext_vector_type(2)));
typedef GAS unsigned gu32;
typedef GAS unsigned long long gu64;
#define RLX_AGENT __ATOMIC_RELAXED, __HIP_MEMORY_SCOPE_AGENT
#define LDS_WAIT() asm volatile("s_waitcnt lgkmcnt(0)" ::: "memory")
#define VM_WAIT() asm volatile("s_waitcnt vmcnt(0)" ::: "memory")
__device__ __forceinline__ unsigned f2bf(float f) { unsigned u = __builtin_bit_cast(unsigned, f); return (u + 0x7fffu + ((u >> 16) & 1u)) >> 16; }
__device__ __forceinline__ unsigned pk2(float lo, float hi) { return f2bf(lo) | (f2bf(hi) << 16); }
__device__ __forceinline__ float bf2f(unsigned short b) { return __builtin_bit_cast(float, (unsigned)b << 16); }
__device__ __forceinline__ float bflo(unsigned w) { return __builtin_bit_cast(float, w << 16); }
__device__ __forceinline__ float bfhi(unsigned w) { return __builtin_bit_cast(float, w & 0xffff0000u); }
__device__ __forceinline__ float wave_sum(float v) {
#pragma unroll
    for (int o = 1; o < 64; o <<= 1) v += __shfl_xor(v, o);
    return v;
}
__device__ __forceinline__ float wave_max(float v) {
#pragma unroll
    for (int o = 1; o < 64; o <<= 1) v = fmaxf(v, __shfl_xor(v, o));
    return v;
}
__device__ __forceinline__ float gelu_tanh(float x) {
    const float u = 0.7978845608028654f * (x + 0.044715f * x * x * x);
    const float e = __expf(2.f * u);
    const float th = 1.f - 2.f / (e + 1.f);
    return 0.5f * x * (1.f + th);
}

#define XB_TMO      128
#define XB_XCNT(j)  (256  + 64 * (j))
#define XB_XSUB(j)  (1280 + 64 * (j))
#define XB_XGEN(j)  (2304 + 64 * (j))
#define XB_TOP      3328
#define XB_TOPGEN   3392
#define XCD_BAR_WORDS 3456
#define XB_SPIN_CAP (1u << 18)

__device__ __forceinline__ unsigned xb_ld(unsigned* p)              { return __hip_atomic_load(p, __ATOMIC_RELAXED, __HIP_MEMORY_SCOPE_AGENT); }
__device__ __forceinline__ unsigned xb_add(unsigned* p, unsigned v) { return __hip_atomic_fetch_add(p, v, __ATOMIC_RELAXED, __HIP_MEMORY_SCOPE_AGENT); }
__device__ __forceinline__ unsigned xb_xcc_id() { return (unsigned)__builtin_amdgcn_s_getreg((3 << 11) | 20) & 0xFu; }
#define XB_SPIN(cond, bar) do { unsigned _sp = 0; while (cond) { __builtin_amdgcn_s_sleep(1); \
    if ((++_sp & 255u) == 0u) { if (xb_ld(&(bar)[XB_TMO])) break; if (_sp > XB_SPIN_CAP) { atomicAdd(&(bar)[XB_TMO], 1u); break; } } } } while (0)

struct XcdBarrier {
    unsigned* bar; unsigned x;
    volatile LAS unsigned* st;
};

__device__ __forceinline__ XcdBarrier xcd_barrier_post(unsigned* bar, volatile LAS unsigned* st) {
    XcdBarrier b; b.bar = bar; b.x = xb_xcc_id(); b.st = st;
    if (threadIdx.x == 0) (void)xb_add(&bar[XB_XCNT(b.x)], 1u);
    return b;
}
__device__ __forceinline__ void xcd_barrier_complete(unsigned* bar, unsigned x, unsigned& nloc, unsigned& nx) {
    const unsigned G = gridDim.x * gridDim.y * gridDim.z;
    unsigned sum, cnt, mine, sp = 0u;
    for (;;) {
        sum = 0u; cnt = 0u; mine = 0u;
#pragma unroll
        for (unsigned j = 0; j < 16; ++j) { const unsigned c = xb_ld(&bar[XB_XCNT(j)]); sum += c; cnt += (c > 0u) ? 1u : 0u; mine = (j == x) ? c : mine; }
        if (sum == G) break;
        __builtin_amdgcn_s_sleep(1);
        if ((++sp & 255u) == 0u) { if (xb_ld(&bar[XB_TMO])) break; if (sp > XB_SPIN_CAP) { atomicAdd(&bar[XB_TMO], 1u); break; } }
    }
    nloc = mine > 0u ? mine : 1u; nx = cnt > 0u ? cnt : 1u;
}

__device__ __forceinline__ void xcd_barrier(const XcdBarrier& b) {
    asm volatile("s_waitcnt vmcnt(0)" ::: "memory");
    __syncthreads();
    if (threadIdx.x == 0) {
        unsigned* bar = b.bar;
        __builtin_amdgcn_s_waitcnt(0);
        unsigned nloc = b.st[0], nx = b.st[1];
        if (nloc == 0u) { xcd_barrier_complete(bar, b.x, nloc, nx); b.st[0] = nloc; b.st[1] = nx; }
        const unsigned old = xb_add(&bar[XB_XSUB(b.x)], 1u);
        const unsigned gen = old / nloc;
        if (old + 1u == (gen + 1u) * nloc) {
            __builtin_amdgcn_fence(__ATOMIC_RELEASE, "agent");
            asm volatile("s_waitcnt vmcnt(0)" ::: "memory");
            const unsigned og = xb_add(&bar[XB_TOP], 1u);
            const unsigned tg = og / nx;
            if (og + 1u == (tg + 1u) * nx) xb_add(&bar[XB_TOPGEN], 1u);
            else XB_SPIN(xb_ld(&bar[XB_TOPGEN]) == tg, bar);
            __builtin_amdgcn_fence(__ATOMIC_ACQUIRE, "agent");
            xb_add(&bar[XB_XGEN(b.x)], 1u);
            asm volatile("s_waitcnt vmcnt(0)" ::: "memory");
        } else {
            XB_SPIN(xb_ld(&bar[XB_XGEN(b.x)]) == gen, bar);
            __builtin_amdgcn_fence(__ATOMIC_ACQUIRE, "agent");
            asm volatile("s_waitcnt vmcnt(0)" ::: "memory");
        }
    }
    __syncthreads();
}
constexpr int NWAVES = 8;
constexpr int BATCH = 8, SEQ = 4096, TT = BATCH * SEQ, DM = 1024;
constexpr int NPROJ = 3072, IN_COLS = 2840;
constexpr int C_H = 0, C_B = 512, C_C = 1024, C_Q = 1536, C_KC = 2048, C_VC = 2176, C_KS = 2304, C_VS = 2432, C_KW = 2560, C_VW = 2688, C_G = 2816;
constexpr int NQP = 2048;
constexpr float RMS_EPS = 1e-6f;
constexpr float QSCALE = 0.125f * 1.4426950408889634f;
constexpr size_t MiB = 1u << 20;
constexpr size_t WS_CTL = 0, CTL_ZERO_BYTES = 32768;
constexpr size_t WS_WIN = 2 * MiB, WS_WOUT = 8 * MiB, WS_WQ = 10 * MiB, WS_KW1 = 14 * MiB, WS_VW1 = 15 * MiB, WS_KW2 = 16 * MiB, WS_VW2 = 16 * MiB + 65536, WS_B1 = 16 * MiB + 131072, WS_SUBK = 17 * MiB;
constexpr size_t WS_U = 32 * MiB, WS_V = 48 * MiB;
constexpr float QSTEP = 0.3352f;
constexpr float USCALE = 32.f / QSTEP, VSCALE = 4.f;
constexpr int NSL = 4;
constexpr size_t WS_XN = 96 * MiB;
constexpr size_t WS_PROJ = 160 * MiB;
constexpr size_t WS_MIXA = 352 * MiB;
constexpr size_t WS_KCC = 416 * MiB, WS_VCC = 417 * MiB;
constexpr size_t WS_SSQ = 418 * MiB;
constexpr size_t WS_EXPG = 64 * MiB, WS_AG = 80 * MiB, WS_DGP = 288 * MiB, WS_SSQF = 420 * MiB;
constexpr size_t WS_END = 421 * MiB;
constexpr int CW_BAR = 4096;
constexpr int RING_OFF = 0, RING_BYTES = 131072;
constexpr int LDSCTL_OFF = RING_BYTES, MISC_OFF = LDSCTL_OFF + 320;
constexpr int LDS_BYTES = 147456;

struct Args { const float* in[19]; float* out; unsigned char* ws; int ph_lo, ph_hi; };
struct Frame {
    LAS unsigned char* lds;
    volatile LAS unsigned* MISC;
    gu32* ctl;
    int tid, lane, wave;
    int vcu, G;
    const Args* a;
};
#define FIN(k) (F.a->in[k])
#define FWS(T, off) ((T*)(F.a->ws + (off)))
#define F_x FIN(0)
#define F_ln1 FIN(1)
#define F_w_in FIN(2)
#define F_conv_w FIN(3)
#define F_pos_k FIN(4)
#define F_pos_v FIN(5)
#define F_k_w1 FIN(6)
#define F_k_w2 FIN(7)
#define F_v_w1 FIN(8)
#define F_v_w2 FIN(9)
#define F_gn_conv FIN(10)
#define F_gn_attn FIN(11)
#define F_w_out FIN(12)
#define F_ln2 FIN(13)
#define F_wq FIN(14)
#define F_subkeys FIN(15)
#define F_pu FIN(16)
#define F_pv FIN(17)
#define F_lnf FIN(18)
#define F_out (F.a->out)
#define F_WinT FWS(bf16, WS_WIN)
#define F_WoutT FWS(bf16, WS_WOUT)
#define F_WqT FWS(bf16, WS_WQ)
#define F_KW1T FWS(bf16, WS_KW1)
#define F_VW1T FWS(bf16, WS_VW1)
#define F_KW2T FWS(bf16, WS_KW2)
#define F_VW2T FWS(bf16, WS_VW2)
#define F_SUBK FWS(bf16, WS_SUBK)
#define F_U FWS(unsigned char, WS_U)
#define F_V FWS(unsigned char, WS_V)
#define F_XN FWS(bf16, WS_XN)
#define F_PROJ FWS(bf16, WS_PROJ)
#define F_MIXA FWS(bf16, WS_MIXA)
#define F_KCC FWS(bf16, WS_KCC)
#define F_VCC FWS(bf16, WS_VCC)
#define F_B1 FWS(float, WS_B1)
#define F_SSQ FWS(float, WS_SSQ)

__device__ __forceinline__ void p0_transpose_item(const float* W, int K, int N, bf16* WT, const float* kscale, LAS float* scr, int item, int nblk, int lane, bool frag = false) {
    const int kb = item / nblk, nb = item % nblk, k0 = 64 * kb, n0 = 32 * nb;
#pragma unroll
    for (int i = 0; i < 32; ++i) { const int kk = 2 * i + (lane >> 5); const int n = n0 + (lane & 31); float v = (n < N) ? W[(size_t)(k0 + kk) * N + n] : 0.f; if (kscale) v *= kscale[k0 + kk]; scr[kk * 33 + (lane & 31)] = v; }
    LDS_WAIT(); asm volatile("" ::: "memory");
    const int c = lane & 7;
#pragma unroll
    for (int j = 0; j < 4; ++j) { const int n = (lane >> 3) + 8 * j; const LAS float* s = scr + (8 * c) * 33 + n;
        v4u o; o.x = pk2(s[0 * 33], s[1 * 33]); o.y = pk2(s[2 * 33], s[3 * 33]); o.z = pk2(s[4 * 33], s[5 * 33]); o.w = pk2(s[6 * 33], s[7 * 33]);
        const int na = n0 + n, ka = k0 + 8 * c;
        const size_t off = frag ? ((size_t)((na >> 4) * 64 + (ka >> 5)) * 64 + (((ka >> 3) & 3) * 16 + (na & 15))) * 8 : (size_t)na * K + ka;
        *(GAS v4u*)(WT + off) = o; }
    LDS_WAIT(); asm volatile("" ::: "memory");
}
__device__ __forceinline__ void p0_cvt_item(const float* src, bf16* dst, const float* cscale, size_t item, int lane) {
    const size_t idx = item * 512 + (size_t)lane * 8;
    f32x4 a = *(const GAS f32x4*)(src + idx), b = *(const GAS f32x4*)(src + idx + 4);
    if (cscale) { const int d = (int)(idx & 1023); const f32x4 sa = *(const GAS f32x4*)(cscale + d), sb = *(const GAS f32x4*)(cscale + d + 4); a = a * sa; b = b * sb; }
    v4u o; o.x = pk2(a[0], a[1]); o.y = pk2(a[2], a[3]); o.z = pk2(b[0], b[1]); o.w = pk2(b[2], b[3]);
    *(GAS v4u*)(dst + idx) = o;
}
__device__ __forceinline__ void p0_cvt4_load(const float* src, size_t item0, int lane, f32x4 (&a)[4], f32x4 (&b)[4]) {
#pragma unroll
    for (int u = 0; u < 4; ++u) { const size_t idx = (item0 + u) * 512 + (size_t)lane * 8; a[u] = *(const GAS f32x4*)(src + idx); b[u] = *(const GAS f32x4*)(src + idx + 4); }
}
__device__ __forceinline__ void p0_cvt4_conv(const f32x4 (&a)[4], const f32x4 (&b)[4], unsigned char* dst, const float* cscale, float scale, bool as_int4, size_t item0, int lane) {
#pragma unroll
    for (int u = 0; u < 4; ++u) {
        const size_t idx = (item0 + u) * 512 + (size_t)lane * 8; const int col = (int)(idx & 1023);
        f32x4 x = a[u] * scale, y = b[u] * scale;
        if (cscale) { const f32x4 sa = *(const GAS f32x4*)(cscale + col), sb = *(const GAS f32x4*)(cscale + col + 4); x = x * sa; y = y * sb; }
        unsigned w = 0u;
        if (as_int4) {
#pragma unroll
            for (int e4 = 0; e4 < 4; ++e4) { const int qa = (int)__builtin_rintf(__builtin_fminf(__builtin_fmaxf(x[e4], -8.f), 7.f)), qb = (int)__builtin_rintf(__builtin_fminf(__builtin_fmaxf(y[e4], -8.f), 7.f));
                w |= ((unsigned)qa & 15u) << (4 * e4); w |= ((unsigned)qb & 15u) << (16 + 4 * e4); }
        } else {
        w = __builtin_amdgcn_cvt_scalef32_pk_fp4_f32(w, x[0], x[1], 1.0f, 0); w = __builtin_amdgcn_cvt_scalef32_pk_fp4_f32(w, x[2], x[3], 1.0f, 1);
        w = __builtin_amdgcn_cvt_scalef32_pk_fp4_f32(w, y[0], y[1], 1.0f, 2); w = __builtin_amdgcn_cvt_scalef32_pk_fp4_f32(w, y[2], y[3], 1.0f, 3);
        }
        const size_t e = idx >> 10; const int q = col >> 6, dc = (col >> 3) & 7;
        *(GAS unsigned*)(dst + e * 512 + 128 * (q >> 2) + 16 * dc + 4 * (q & 3)) = w;
    }
}
__device__ __forceinline__ void rms_row_load(const float* xrow, int lane, f32x4 (&v)[4]) {
    const GAS f32x4* xr = (const GAS f32x4*)xrow + lane;
#pragma unroll
    for (int j = 0; j < 4; ++j) v[j] = xr[64 * j];
}
__device__ __forceinline__ void rms_row_finish(const f32x4 (&v)[4], const f32x4 (&g)[4], bf16* orow, int lane) {
    float s = 0.f;
#pragma unroll
    for (int j = 0; j < 4; ++j) s += (v[j].x * v[j].x + v[j].y * v[j].y) + (v[j].z * v[j].z + v[j].w * v[j].w);
    const float rstd = 1.f / sqrtf(wave_sum(s) * (1.f / DM) + RMS_EPS);
    GAS v2u* o8 = (GAS v2u*)orow + lane;
#pragma unroll
    for (int j = 0; j < 4; ++j) { v2u w; w.x = pk2(v[j].x * rstd * g[j].x, v[j].y * rstd * g[j].y); w.y = pk2(v[j].z * rstd * g[j].z, v[j].w * rstd * g[j].w); o8[64 * j] = w; }
}
__device__ __forceinline__ void p0_prologue(Frame& F) {
    LAS float* scr = (LAS float*)(F.lds + RING_OFF + F.wave * 16384);
    const int gw = F.vcu * NWAVES + F.wave, NGW = F.G * NWAVES, lane = F.lane;
    constexpr int I_IN = 16 * 96, I_OUT = 16 * 32, I_Q = 16 * 64, I_W1 = 32 * 8, I_W2 = 4 * 2;
    constexpr int NTR = I_IN + I_OUT + I_Q + 2 * I_W1 + 2 * I_W2;
    for (int it = gw; it < NTR; it += NGW) {
        int r = it;
        if (r < I_IN) { p0_transpose_item(F_w_in, 1024, IN_COLS, F_WinT, nullptr, scr, r, 96, lane); continue; } r -= I_IN;
        if (r < I_OUT) { p0_transpose_item(F_w_out, 1024, 1024, F_WoutT, nullptr, scr, r, 32, lane); continue; } r -= I_OUT;
        if (r < I_Q) { p0_transpose_item(F_wq, 1024, NQP, F_WqT, F_ln2, scr, r, 64, lane); continue; } r -= I_Q;
        if (r < I_W1) { p0_transpose_item(F_k_w1, 2048, 256, F_KW1T, nullptr, scr, r, 8, lane, true); continue; } r -= I_W1;
        if (r < I_W1) { p0_transpose_item(F_v_w1, 2048, 256, F_VW1T, nullptr, scr, r, 8, lane, true); continue; } r -= I_W1;
        if (r < I_W2) { p0_transpose_item(F_k_w2, 256, 64, F_KW2T, nullptr, scr, r, 2, lane); continue; } r -= I_W2;
        p0_transpose_item(F_v_w2, 256, 64, F_VW2T, nullptr, scr, r, 2, lane);
    }
    for (int it = ((gw & 3) == 3) ? (gw >> 2) : 512 + gw; it < 512; it += NGW) { const int mat = it >> 8, j = it & 255; const float* pos = mat ? F_pos_v : F_pos_k; const float* w1 = mat ? F_v_w1 : F_k_w1;
        float a = 0.f; for (int i = lane; i < 2048; i += 64) a += pos[i] * w1[(size_t)i * 256 + j];
        a = wave_sum(a); if (lane == 0) F_B1[it] = a; }
    for (int it = gw; it < 512; it += NGW) { const int s8 = it & 7, kt = (it >> 3) & 3, hc = it >> 5, hi = lane >> 5, r32 = lane & 31; const int key = 16 * kt + (r32 & 3) + 4 * (r32 >> 3) + 64 * ((r32 >> 2) & 1);
        const float* src = F_subkeys + ((size_t)(hc * 128 + key) * 128 + 16 * s8 + 8 * hi); const f32x4 a = *(const GAS f32x4*)src, b = *(const GAS f32x4*)(src + 4);
        v4u o; o.x = pk2(a[0], a[1]); o.y = pk2(a[2], a[3]); o.z = pk2(b[0], b[1]); o.w = pk2(b[2], b[3]); *(GAS v4u*)(F_SUBK + (size_t)it * 512 + lane * 8) = o; }
    {
        f32x4 ua0[4], ub0[4], va0[4], vb0[4], ua1[4], ub1[4], va1[4], vb1[4];
        int it = gw;
        if (it < 8192) { p0_cvt4_load(F_pu, (size_t)it * 4, lane, ua0, ub0); p0_cvt4_load(F_pv, (size_t)it * 4, lane, va0, vb0); }
        for (; it < 8192; it += 2 * NGW) {
            const int i1 = it + NGW, i2 = it + 2 * NGW;
            if (i1 < 8192) { p0_cvt4_load(F_pu, (size_t)i1 * 4, lane, ua1, ub1); p0_cvt4_load(F_pv, (size_t)i1 * 4, lane, va1, vb1); }
            p0_cvt4_conv(ua0, ub0, F_U, F_ln2, USCALE, true, (size_t)it * 4, lane); p0_cvt4_conv(va0, vb0, F_V, nullptr, VSCALE, false, (size_t)it * 4, lane);
            if (i1 < 8192) {
                if (i2 < 8192) { p0_cvt4_load(F_pu, (size_t)i2 * 4, lane, ua0, ub0); p0_cvt4_load(F_pv, (size_t)i2 * 4, lane, va0, vb0); }
                p0_cvt4_conv(ua1, ub1, F_U, F_ln2, USCALE, true, (size_t)i1 * 4, lane); p0_cvt4_conv(va1, vb1, F_V, nullptr, VSCALE, false, (size_t)i1 * 4, lane);
            }
        }
    }
    {
        f32x4 g[4];
#pragma unroll
        for (int j = 0; j < 4; ++j) g[j] = ((const GAS f32x4*)F_ln1)[lane + 64 * j];
        f32x4 xa0[4], xb0[4], xa1[4], xb1[4];
        int m = gw;
        if (m < TT) rms_row_load(F_x + (size_t)m * DM, lane, xa0); if (m + NGW < TT) rms_row_load(F_x + (size_t)(m + NGW) * DM, lane, xb0);
        for (; m < TT; m += 4 * NGW) {
            const int m1 = m + NGW, m2 = m + 2 * NGW, m3 = m + 3 * NGW, m4 = m + 4 * NGW, m5 = m + 5 * NGW;
            if (m2 < TT) rms_row_load(F_x + (size_t)m2 * DM, lane, xa1); if (m3 < TT) rms_row_load(F_x + (size_t)m3 * DM, lane, xb1);
            rms_row_finish(xa0, g, F_XN + (size_t)m * DM, lane); if (m1 < TT) rms_row_finish(xb0, g, F_XN + (size_t)m1 * DM, lane);
            if (m4 < TT) rms_row_load(F_x + (size_t)m4 * DM, lane, xa0); if (m5 < TT) rms_row_load(F_x + (size_t)m5 * DM, lane, xb0);
            if (m2 < TT) rms_row_finish(xa1, g, F_XN + (size_t)m2 * DM, lane); if (m3 < TT) rms_row_finish(xb1, g, F_XN + (size_t)m3 * DM, lane);
        }
    }
}

__device__ __forceinline__ void up8(const v4u w, float (&f)[8]) { f[0] = bflo(w.x); f[1] = bfhi(w.x); f[2] = bflo(w.y); f[3] = bfhi(w.y); f[4] = bflo(w.z); f[5] = bfhi(w.z); f[6] = bflo(w.w); f[7] = bfhi(w.w); }
struct P2Rows { v4u cc[4], ch[4], cb[4]; };
__device__ __forceinline__ void p2_conv_load(Frame& F, P2Rows& R, int bt0, int lane) {
#pragma unroll
    for (int j = 0; j < 4; ++j) { const bf16* pr = F_PROJ + (size_t)(bt0 + j) * NPROJ + 8 * lane; R.cc[j] = *(const GAS v4u*)(pr + C_C); R.ch[j] = *(const GAS v4u*)(pr + C_H); R.cb[j] = *(const GAS v4u*)(pr + C_B); }
}
__device__ __forceinline__ void p2_conv_four(Frame& F, const P2Rows& R, int bt0, int lane, float (&g1)[8], float (&g2)[8], const float (&w)[3][8], const float (&gn)[8]) {
#pragma unroll
    for (int j = 0; j < 4; ++j) {
        float cc[8], ch[8], cb[8], y[8]; up8(R.cc[j], cc); up8(R.ch[j], ch); up8(R.cb[j], cb);
        float ss = 0.f;
#pragma unroll
        for (int e = 0; e < 8; ++e) { const float g0 = cc[e] * ch[e]; y[e] = (w[0][e] * g2[e] + w[1][e] * g1[e] + w[2][e] * g0) * cb[e]; ss += y[e] * y[e]; g2[e] = g1[e]; g1[e] = g0; }
        const float rs = 1.f / sqrtf(wave_sum(ss) * (1.f / 512.f) + RMS_EPS);
        v4u o; o.x = pk2(y[0] * rs * gn[0], y[1] * rs * gn[1]); o.y = pk2(y[2] * rs * gn[2], y[3] * rs * gn[3]); o.z = pk2(y[4] * rs * gn[4], y[5] * rs * gn[5]); o.w = pk2(y[6] * rs * gn[6], y[7] * rs * gn[7]);
        *(GAS v4u*)(F_MIXA + (size_t)(bt0 + j) * 1024 + 8 * lane) = o;
    }
}
__device__ __forceinline__ void p2_conv_run(Frame& F, int run) {
    const int lane = F.lane; const int bt0 = 16 * run; const int t0 = bt0 & (SEQ - 1);
    P2Rows A, B;
    p2_conv_load(F, A, bt0, lane);
    float w[3][8], gn[8], g1[8], g2[8];
#pragma unroll
    for (int k = 0; k < 3; ++k) { const f32x4 w0 = *(const GAS f32x4*)(F_conv_w + k * 512 + 8 * lane), w1 = *(const GAS f32x4*)(F_conv_w + k * 512 + 8 * lane + 4);
#pragma unroll
        for (int e = 0; e < 4; ++e) { w[k][e] = w0[e]; w[k][4 + e] = w1[e]; } }
    { const f32x4 a0 = *(const GAS f32x4*)(F_gn_conv + 8 * lane), a1 = *(const GAS f32x4*)(F_gn_conv + 8 * lane + 4);
#pragma unroll
      for (int e = 0; e < 4; ++e) { gn[e] = a0[e]; gn[4 + e] = a1[e]; } }
#pragma unroll
    for (int e = 0; e < 8; ++e) { g1[e] = 0.f; g2[e] = 0.f; }
    if (t0 > 0) {
        const bf16* pr = F_PROJ + (size_t)(bt0 - 2) * NPROJ + 8 * lane; float c2[8], h2[8], c1[8], h1[8];
        up8(*(const GAS v4u*)(pr + C_C), c2); up8(*(const GAS v4u*)(pr + C_H), h2); up8(*(const GAS v4u*)(pr + NPROJ + C_C), c1); up8(*(const GAS v4u*)(pr + NPROJ + C_H), h1);
#pragma unroll
        for (int e = 0; e < 8; ++e) { g2[e] = c2[e] * h2[e]; g1[e] = c1[e] * h1[e]; }
    }
    p2_conv_load(F, B, bt0 + 4, lane);  p2_conv_four(F, A, bt0, lane, g1, g2, w, gn);
    p2_conv_load(F, A, bt0 + 8, lane);  p2_conv_four(F, B, bt0 + 4, lane, g1, g2, w, gn);
    p2_conv_load(F, B, bt0 + 12, lane); p2_conv_four(F, A, bt0 + 8, lane, g1, g2, w, gn);
    p2_conv_four(F, B, bt0 + 12, lane, g1, g2, w, gn);
}
__device__ __forceinline__ void p2_compress_unit(Frame& F, int u) {
    const int b = u >> 5, g = (u >> 4) & 1, nb = u & 15; const int tid = F.tid, lane = F.lane, w = F.wave;
    LAS unsigned char* AST = F.lds + RING_OFF;
    LAS unsigned char* HID = F.lds + RING_OFF + 36864;
    const int nrow = lane & 15, kq = lane >> 4;
    for (int mat = 0; mat < 2; ++mat) {
        const int col0 = (mat ? C_VC : C_KC) + g * 64; const bf16* W1T = mat ? F_VW1T : F_KW1T; const bf16* W2T = mat ? F_VW2T : F_KW2T; const float* B1 = F_B1 + mat * 256; bf16* OUT = mat ? F_VCC : F_KCC;
        for (int idx = tid; idx < 272 * 8; idx += NWAVES * 64) { const int pos = idx >> 3, ch = idx & 7; const int p = 256 * nb + pos;
            v4u v = (v4u){0u, 0u, 0u, 0u}; if (p < SEQ) v = *(const GAS v4u*)(F_PROJ + (size_t)(b * SEQ + p) * NPROJ + col0 + 8 * ch);
            *(LAS v4u*)(AST + pos * 128 + ch * 16) = v; }
        __syncthreads();
        f32x4 acc0 = (f32x4){0.f, 0.f, 0.f, 0.f}, acc1 = acc0;
        const bf16* b0p = W1T + (size_t)(2 * w) * 64 * 512 + lane * 8; const bf16* b1p = b0p + (size_t)64 * 512;
#define P2_LOADB(S0, S1, bb) do { _Pragma("unroll") for (int k8 = 0; k8 < 8; ++k8) { S0[k8] = *(const GAS bf16x8*)(b0p + 512 * (8 * (bb) + k8)); S1[k8] = *(const GAS bf16x8*)(b1p + 512 * (8 * (bb) + k8)); } } while (0)
#define P2_MMA(S0, S1, bb) do { _Pragma("unroll") for (int k8 = 0; k8 < 8; ++k8) { const int k0 = 32 * (8 * (bb) + k8) + 8 * kq; const int l = k0 >> 6, d = k0 & 63; \
            const bf16x8 a = *(const LAS bf16x8*)(AST + (16 * nrow + l) * 128 + d * 2); \
            acc0 = __builtin_amdgcn_mfma_f32_16x16x32_bf16(a, S0[k8], acc0, 0, 0, 0); acc1 = __builtin_amdgcn_mfma_f32_16x16x32_bf16(a, S1[k8], acc1, 0, 0, 0); } } while (0)
        { bf16x8 pa0[8], pa1[8], pb0[8], pb1[8];
          P2_LOADB(pa0, pa1, 0);
#pragma unroll 1
          for (int bb = 0; bb < 8; bb += 2) {
              P2_LOADB(pb0, pb1, bb + 1);
              P2_MMA(pa0, pa1, bb);
              if (bb + 2 < 8) P2_LOADB(pa0, pa1, bb + 2);
              P2_MMA(pb0, pb1, bb + 1);
          } }
#undef P2_LOADB
#undef P2_MMA
        { const int j0 = 32 * w + nrow, j1 = j0 + 16; const float bj0 = B1[j0], bj1 = B1[j1];
#pragma unroll
            for (int r = 0; r < 4; ++r) { const int n = 4 * kq + r;
                *(LAS unsigned short*)(HID + n * 528 + j0 * 2) = (unsigned short)f2bf(gelu_tanh(acc0[r] + bj0));
                *(LAS unsigned short*)(HID + n * 528 + j1 * 2) = (unsigned short)f2bf(gelu_tanh(acc1[r] + bj1)); } }
        __syncthreads();
        if (w < 4) { f32x4 acc = (f32x4){0.f, 0.f, 0.f, 0.f}; const bf16* bp = W2T + (size_t)(16 * w + nrow) * 256 + 8 * kq;
#pragma unroll
            for (int kk = 0; kk < 8; ++kk) { const bf16x8 a = *(const LAS bf16x8*)(HID + nrow * 528 + (32 * kk + 8 * kq) * 2); const bf16x8 bb = *(const GAS bf16x8*)(bp + 32 * kk);
                acc = __builtin_amdgcn_mfma_f32_16x16x32_bf16(a, bb, acc, 0, 0, 0); }
            const int d = 16 * w + nrow;
#pragma unroll
            for (int r = 0; r < 4; ++r) { const int n = 16 * nb + 4 * kq + r; OUT[((size_t)(b * 256 + n) * 2 + g) * 64 + d] = (bf16)f2bf(acc[r]); } }
        __syncthreads();
    }
}
__device__ __forceinline__ void p2_phase(Frame& F) {
    const int gw = F.vcu * NWAVES + F.wave, NGW = F.G * NWAVES;
    for (int u = F.vcu; u < 256; u += F.G) p2_compress_unit(F, u);
    for (int run = gw; run < TT / 16; run += NGW) p2_conv_run(F, run);
}

namespace att {
constexpr int KBUF = 0, VBUF = 16384, IMP_OFF = 32768, SELM_OFF = 49152, ANYW_OFF = 49664, SSQ_OFF = 49728, OST_OFF = 50176, OST_ROW = 1040;
static_assert(OST_OFF + 64 * OST_ROW + 512 * 16 <= RING_BYTES, "attention LDS map (output staging + 512 gate slots of 16 B)");
__device__ __forceinline__ int crow(int r, int hi) { return (r & 3) + 8 * (r >> 2) + 4 * hi; }
__device__ __forceinline__ float max3f(float a, float b, float c) { float r; asm("v_max3_f32 %0, %1, %2, %3" : "=v"(r) : "v"(a), "v"(b), "v"(c)); return r; }
__device__ __forceinline__ float max2f(float a, float b) { float r; asm("v_max_f32_e32 %0, %1, %2" : "=v"(r) : "v"(a), "v"(b)); return r; }
__device__ __forceinline__ float swapmax(float v) { auto rr = __builtin_amdgcn_permlane32_swap(__float_as_uint(v), __float_as_uint(v), false, false); return max2f(__uint_as_float(rr[0]), __uint_as_float(rr[1])); }
__device__ __forceinline__ float swapsum(float v) { auto rr = __builtin_amdgcn_permlane32_swap(__float_as_uint(v), __float_as_uint(v), false, false); return __uint_as_float(rr[0]) + __uint_as_float(rr[1]); }
__device__ __forceinline__ unsigned cvtpk(float lo, float hi) { typedef float f2 __attribute__((ext_vector_type(2))); f2 v = {lo, hi}; bf16x2v b = __builtin_convertvector(v, bf16x2v); return __builtin_bit_cast(unsigned, b); }
__device__ __forceinline__ s16x4 vtr(const LAS unsigned char* p) { typedef short v4i16_t __attribute__((ext_vector_type(4))); return __builtin_bit_cast(s16x4, __builtin_amdgcn_ds_read_tr16_b64_v4i16((LAS v4i16_t*)p)); }

struct Stg { v4u k, v; };
__device__ __forceinline__ void tile_load(Stg& s, const bf16* kbase, const bf16* vbase, int rs, int tid) {
    const unsigned ov = (unsigned)((tid >> 3) * rs + (tid & 7) * 8) * 2u, ok = ov;
    s.k = *(const GAS v4u*)((const GAS unsigned char*)kbase + ok);
    s.v = *(const GAS v4u*)((const GAS unsigned char*)vbase + ov);
}
__device__ __forceinline__ void tile_store(const Stg& s, LAS unsigned char* kbuf, LAS unsigned char* vbuf, int tid) {
    const int key = tid >> 3, c = tid & 7;
    *(LAS v4u*)(kbuf + c * 1024 + ((((key + c) & 7) | (key & ~7)) * 16)) = s.k;
    *(LAS v4u*)(vbuf + (c >> 2) * 4096 + (key >> 3) * 512 + (key & 7) * 64 + (c & 3) * 16) = s.v;
}
__device__ __forceinline__ void qkt(f32x16& p0, f32x16& p1, const LAS unsigned char* kbuf, const bf16x8 (&qr)[4], float cinit, int hi, int r32) {
#pragma unroll
    for (int r = 0; r < 16; ++r) { p0[r] = cinit; p1[r] = cinit; }
    bf16x8 kf[8];
#pragma unroll
    for (int s = 0; s < 4; ++s) { const int ch = 2 * s + hi; const LAS unsigned char* kb = kbuf + ch * 1024 + ((((r32 + ch) & 7) | (r32 & ~7)) * 16);
        kf[2 * s] = *(const LAS bf16x8*)(kb); kf[2 * s + 1] = *(const LAS bf16x8*)(kb + 512); }
#pragma unroll
    for (int s = 0; s < 4; ++s) {
        p0 = __builtin_amdgcn_mfma_f32_32x32x16_bf16(kf[2 * s], qr[s], p0, 0, 0, 0);
        p1 = __builtin_amdgcn_mfma_f32_32x32x16_bf16(kf[2 * s + 1], qr[s], p1, 0, 0, 0);
    }
    __builtin_amdgcn_sched_group_barrier(0x100, 8, 0);
    __builtin_amdgcn_sched_group_barrier(0x008, 8, 0);
}
__device__ __forceinline__ void qkt_v(f32x16& p0, f32x16& p1, s16x4 (&vlo)[8], s16x4 (&vhi)[8], const LAS unsigned char* kbuf, const LAS unsigned char* vb, const bf16x8 (&qr)[4], int hi, int r32) {
#pragma unroll
    for (int r = 0; r < 16; ++r) { p0[r] = 0.f; p1[r] = 0.f; }
    bf16x8 kf[8];
#pragma unroll
    for (int s = 0; s < 4; ++s) { const int ch = 2 * s + hi; const LAS unsigned char* kb = kbuf + ch * 1024 + ((((r32 + ch) & 7) | (r32 & ~7)) * 16);
        kf[2 * s] = *(const LAS bf16x8*)(kb); kf[2 * s + 1] = *(const LAS bf16x8*)(kb + 512); }
#pragma unroll
    for (int s = 0; s < 4; ++s) {
        p0 = __builtin_amdgcn_mfma_f32_32x32x16_bf16(kf[2 * s], qr[s], p0, 0, 0, 0);
        vlo[s] = vtr(vb + s * 1024); vhi[s] = vtr(vb + s * 1024 + 512);
        p1 = __builtin_amdgcn_mfma_f32_32x32x16_bf16(kf[2 * s + 1], qr[s], p1, 0, 0, 0);
        vlo[4 + s] = vtr(vb + 4096 + s * 1024); vhi[4 + s] = vtr(vb + 4096 + s * 1024 + 512);
    }
    __builtin_amdgcn_sched_group_barrier(0x100, 8, 0);
#pragma unroll
    for (int s = 0; s < 8; ++s) { __builtin_amdgcn_sched_group_barrier(0x008, 1, 0); __builtin_amdgcn_sched_group_barrier(0x100, 2, 0); }
}
constexpr float ATT_THR = 6.f;
template <bool HAS_LO> __device__ __forceinline__ void tile_step(const LAS unsigned char* kbuf, const LAS unsigned char* vbuf, const bf16x8 (&qr)[4], float& mref, float& l, f32x16& o0, f32x16& o1,
                                          bool sel, bool first, bool need_mask, int hi_lim, int lo_lim, int hi, int r32, int lane) {
    f32x16 p0, p1;
#ifdef DUP_QK
    { f32x16 d0, d1; qkt(d0, d1, kbuf, qr, 0.f, hi, r32); float dm = fmaxf(d0[0], d1[0]);
#pragma unroll
      for (int r = 1; r < 16; ++r) dm = fmaxf(dm, fmaxf(d0[r], d1[r]));
      dm = swapmax(dm); float ds = 0.f;
#pragma unroll
      for (int r = 0; r < 16; ++r) { d0[r] = __builtin_amdgcn_exp2f(d0[r] - dm); d1[r] = __builtin_amdgcn_exp2f(d1[r] - dm); ds += d0[r] + d1[r]; }
      unsigned dk = 0;
#pragma unroll
      for (int r = 0; r < 16; r += 2) dk ^= cvtpk(d0[r], d0[r + 1]) ^ cvtpk(d1[r], d1[r + 1]);
      asm volatile("" :: "v"(ds), "v"(dk)); }
#endif
    if (!first) {
        const float l2 = swapsum(l);
        const bool big = l2 > 1048576.f;
        if (__any(big)) {
            const float dl = big ? __builtin_amdgcn_logf(l2) : 0.f;
            mref += dl;
            const float alpha = __builtin_amdgcn_exp2f(-dl);
            l *= alpha;
#pragma unroll
            for (int r = 0; r < 16; ++r) { o0[r] *= alpha; o1[r] *= alpha; }
        }
    }
    const LAS unsigned char* vb = vbuf + ((lane >> 4) & 1) * 32 + (lane & 3) * 8 + (4 * hi + ((lane & 15) >> 2)) * 64;
    s16x4 vlo[8], vhi[8];
    qkt_v(p0, p1, vlo, vhi, kbuf, vb, qr, hi, r32);
    const float NEG = -INFINITY;
    if (need_mask) {
        int hl = hi_lim - 4 * hi, ll = lo_lim - 4 * hi;
        asm volatile("" : "+v"(hl), "+v"(ll));
#pragma unroll
        for (int r = 0; r < 16; ++r) { const int c = (r & 3) + 8 * (r >> 2); if (!(c <= hl && (!HAS_LO || c > ll))) p0[r] = NEG; if (!(c + 32 <= hl && (!HAS_LO || c + 32 > ll))) p1[r] = NEG; }
    }
    if (first) {
        float mxa = max3f(p0[0], p0[1], p1[0]), mxb = max3f(p0[2], p0[3], p1[1]);
        mxa = max3f(mxa, p1[2], p1[3]);
#pragma unroll
        for (int r = 4; r < 16; r += 4) { mxa = max3f(mxa, p0[r], p0[r + 1]); mxb = max3f(mxb, p0[r + 2], p0[r + 3]); mxa = max3f(mxa, p1[r], p1[r + 1]); mxb = max3f(mxb, p1[r + 2], p1[r + 3]); }
        const float mx = swapmax(max2f(mxa, mxb));
        if (sel && mx > NEG) mref = mx;
    }
    const float msub = sel ? mref : INFINITY;
    float sum = 0.f;
#pragma unroll
    for (int r = 0; r < 16; ++r) { p0[r] = __builtin_amdgcn_exp2f(p0[r] - msub); p1[r] = __builtin_amdgcn_exp2f(p1[r] - msub); sum += p0[r] + p1[r]; }
    l += sum;
    bf16x8 pf[4];
    { v4u w;
      w.x = cvtpk(p0[0], p0[1]); w.y = cvtpk(p0[2], p0[3]); w.z = cvtpk(p0[4], p0[5]); w.w = cvtpk(p0[6], p0[7]); pf[0] = __builtin_bit_cast(bf16x8, w);
      w.x = cvtpk(p0[8], p0[9]); w.y = cvtpk(p0[10], p0[11]); w.z = cvtpk(p0[12], p0[13]); w.w = cvtpk(p0[14], p0[15]); pf[1] = __builtin_bit_cast(bf16x8, w);
      w.x = cvtpk(p1[0], p1[1]); w.y = cvtpk(p1[2], p1[3]); w.z = cvtpk(p1[4], p1[5]); w.w = cvtpk(p1[6], p1[7]); pf[2] = __builtin_bit_cast(bf16x8, w);
      w.x = cvtpk(p1[8], p1[9]); w.y = cvtpk(p1[10], p1[11]); w.z = cvtpk(p1[12], p1[13]); w.w = cvtpk(p1[14], p1[15]); pf[3] = __builtin_bit_cast(bf16x8, w); }
#pragma unroll
    for (int s = 0; s < 4; ++s) {
        const bf16x8 va = (bf16x8){vlo[s][0], vlo[s][1], vlo[s][2], vlo[s][3], vhi[s][0], vhi[s][1], vhi[s][2], vhi[s][3]};
        const bf16x8 vb8 = (bf16x8){vlo[4 + s][0], vlo[4 + s][1], vlo[4 + s][2], vlo[4 + s][3], vhi[4 + s][0], vhi[4 + s][1], vhi[4 + s][2], vhi[4 + s][3]};
        o0 = __builtin_amdgcn_mfma_f32_32x32x16_bf16(va, pf[s], o0, 0, 0, 0);
        o1 = __builtin_amdgcn_mfma_f32_32x32x16_bf16(vb8, pf[s], o1, 0, 0, 0);
    }
#ifdef DUP_PV
    { f32x16 d0, d1;
#pragma unroll
      for (int r = 0; r < 16; ++r) { d0[r] = 0.f; d1[r] = 0.f; }
      s16x4 ulo[8], uhi[8];
#pragma unroll
      for (int s = 0; s < 4; ++s) { ulo[s] = vtr(vb + s * 1024); uhi[s] = vtr(vb + s * 1024 + 512); ulo[4 + s] = vtr(vb + 4096 + s * 1024); uhi[4 + s] = vtr(vb + 4096 + s * 1024 + 512); }
#pragma unroll
      for (int s = 0; s < 4; ++s) {
          const bf16x8 va = (bf16x8){ulo[s][0], ulo[s][1], ulo[s][2], ulo[s][3], uhi[s][0], uhi[s][1], uhi[s][2], uhi[s][3]};
          const bf16x8 vb8 = (bf16x8){ulo[4 + s][0], ulo[4 + s][1], ulo[4 + s][2], ulo[4 + s][3], uhi[4 + s][0], uhi[4 + s][1], uhi[4 + s][2], uhi[4 + s][3]};
          d0 = __builtin_amdgcn_mfma_f32_32x32x16_bf16(va, pf[s], d0, 0, 0, 0);
          d1 = __builtin_amdgcn_mfma_f32_32x32x16_bf16(vb8, pf[s], d1, 0, 0, 0);
      }
      asm volatile("" :: "v"(d0), "v"(d1)); }
#endif
}
__device__ __forceinline__ void imp_step(const LAS unsigned char* kbuf, const bf16x8 (&qr)[4], float mfin, float linv, int hi_lim, int hi, int r32, LAS float* improw, int jbase) {
    f32x16 p0, p1;
    qkt(p0, p1, kbuf, qr, 0.f, hi, r32);
    int hl = hi_lim - 4 * hi; asm volatile("" : "+v"(hl));
#pragma unroll
    for (int r = 0; r < 16; ++r) { const int c = (r & 3) + 8 * (r >> 2);
        p0[r] = (c <= hl) ? __builtin_amdgcn_exp2f(p0[r] - mfin) * linv : 0.f;
        p1[r] = (c + 32 <= hl) ? __builtin_amdgcn_exp2f(p1[r] - mfin) * linv : 0.f; }
#pragma unroll
    for (int gq = 0; gq < 4; ++gq) {
        { const float G = (p0[4 * gq] + p0[4 * gq + 1]) + (p0[4 * gq + 2] + p0[4 * gq + 3]); const int j = jbase + 2 * gq + hi;
          __hip_atomic_fetch_add(improw + j, G, __ATOMIC_RELAXED, __HIP_MEMORY_SCOPE_WORKGROUP);
          if (j + 1 < 64) __hip_atomic_fetch_add(improw + j + 1, p0[4 * gq + 3], __ATOMIC_RELAXED, __HIP_MEMORY_SCOPE_WORKGROUP); }
        { const float G = (p1[4 * gq] + p1[4 * gq + 1]) + (p1[4 * gq + 2] + p1[4 * gq + 3]); const int j = jbase + 8 + 2 * gq + hi;
          __hip_atomic_fetch_add(improw + j, G, __ATOMIC_RELAXED, __HIP_MEMORY_SCOPE_WORKGROUP);
          if (j + 1 < 64) __hip_atomic_fetch_add(improw + j + 1, p1[4 * gq + 3], __ATOMIC_RELAXED, __HIP_MEMORY_SCOPE_WORKGROUP); }
    }
}
__device__ __forceinline__ void ost_acc(LAS unsigned char* orow, const f32x16& o0, const f32x16& o1, float sc, bool first, int hi) {
#pragma unroll
    for (int rg = 0; rg < 4; ++rg) {
        const int d = 8 * rg + 4 * hi;
        float a[4], c[4];
#pragma unroll
        for (int e = 0; e < 4; ++e) { a[e] = o0[4 * rg + e] * sc; c[e] = o1[4 * rg + e] * sc; }
        if (!first) { const v2u w0 = *(const LAS v2u*)(orow + d * 2), w1 = *(const LAS v2u*)(orow + (32 + d) * 2);
            a[0] += bflo(w0.x); a[1] += bfhi(w0.x); a[2] += bflo(w0.y); a[3] += bfhi(w0.y); c[0] += bflo(w1.x); c[1] += bfhi(w1.x); c[2] += bflo(w1.y); c[3] += bfhi(w1.y); }
        v2u w0; w0.x = cvtpk(a[0], a[1]); w0.y = cvtpk(a[2], a[3]); *(LAS v2u*)(orow + d * 2) = w0;
        v2u w1; w1.x = cvtpk(c[0], c[1]); w1.y = cvtpk(c[2], c[3]); *(LAS v2u*)(orow + (32 + d) * 2) = w1;
    }
}
}

#define ATT_PRE(T0, KP, VP, RS) do { const int t_ = (T0); att::tile_load(sA_, (KP), (VP), (RS), tid); } while (0)
#define ATT_PASS(T0, NTL, KP, VP, RS, BODY) do { \
    const int tend_ = (T0) + (NTL); int t_ = (T0), cur_ = 0; \
    { att::tile_store(sA_, L + att::KBUF, L + att::VBUF, tid); } \
    if (t_ + 1 < tend_) { ++t_; att::tile_load(sB_, (KP), (VP), (RS), tid); --t_; } \
    __syncthreads(); \
    for (;;) { \
        if (t_ + 2 < tend_) { t_ += 2; att::tile_load(sA_, (KP), (VP), (RS), tid); t_ -= 2; } \
        { const LAS unsigned char* kb_ = L + att::KBUF + cur_ * 8192; const LAS unsigned char* vb_ = L + att::VBUF + cur_ * 8192; BODY; } \
        if (t_ + 1 >= tend_) break; \
        att::tile_store(sB_, L + att::KBUF + (cur_ ^ 1) * 8192, L + att::VBUF + (cur_ ^ 1) * 8192, tid); \
        __syncthreads(); cur_ ^= 1; ++t_; \
        if (t_ + 2 < tend_) { t_ += 2; att::tile_load(sB_, (KP), (VP), (RS), tid); t_ -= 2; } \
        { const LAS unsigned char* kb_ = L + att::KBUF + cur_ * 8192; const LAS unsigned char* vb_ = L + att::VBUF + cur_ * 8192; BODY; } \
        if (t_ + 1 >= tend_) break; \
        att::tile_store(sA_, L + att::KBUF + (cur_ ^ 1) * 8192, L + att::VBUF + (cur_ ^ 1) * 8192, tid); \
        __syncthreads(); cur_ ^= 1; ++t_; } \
    __syncthreads(); } while (0)

__device__ __forceinline__ void p3_unit(Frame& F, int b, int i) {
    LAS unsigned char* L = F.lds + RING_OFF;
    const int tid = F.tid, lane = F.lane, w = F.wave, hi = lane >> 5, r32 = lane & 31;
    LAS float* IMP = (LAS float*)(L + att::IMP_OFF);
    LAS unsigned long long* SELM = (LAS unsigned long long*)(L + att::SELM_OFF);
    LAS float* SSQ = (LAS float*)(L + att::SSQ_OFF);
    const int q = (w & 1) * 32 + r32;
    const int t = 64 * i + q;
    const size_t bt = (size_t)b * SEQ + t;
    const float NEG = -INFINITY;
    if (tid < 64) SSQ[tid] = 0.f;
    att::Stg sA_, sB_;
#define ATT_CMP_K(G) (F_KCC + ((size_t)(b * 256 + 64 * t_) * 2 + (G)) * 64)
#define ATT_CMP_V(G) (F_VCC + ((size_t)(b * 256 + 64 * t_) * 2 + (G)) * 64)
    ATT_PRE(0, ATT_CMP_K(0), ATT_CMP_V(0), 128);
    for (int g = 0; g < 2; ++g) {
        const int H = g * 4 + (w >> 1);
        for (int z = tid; z < 4096; z += NWAVES * 64) IMP[z] = 0.f;
        bf16x8 qr[4];
#pragma unroll
        for (int s = 0; s < 4; ++s) qr[s] = *(const GAS bf16x8*)(F_PROJ + bt * NPROJ + C_Q + H * 64 + 16 * s + 8 * hi);
        LAS float* gslot = (LAS float*)(L + att::OST_OFF + 64 * att::OST_ROW + tid * 16);
        { const bf16* gp = F_PROJ + bt * NPROJ + C_G + H * 3; const float g0 = bf2f(gp[0]), g1 = bf2f(gp[1]), g2 = bf2f(gp[2]);
          gslot[0] = 1.f / (1.f + __expf(-g0)); gslot[1] = 1.f / (1.f + __expf(-g1)); gslot[2] = 1.f / (1.f + __expf(-g2)); }
#define ATT_GATE(k) (gslot[k])
        LAS unsigned char* orow = L + att::OST_OFF + q * att::OST_ROW + (H * 64) * 2;
        const int nlim = (t - 31) >> 4;
        const int nmaxb = (4 * i + 2 < 254) ? 4 * i + 2 : 254;
        const int nct = (nmaxb >> 6) + 1;
        float m = 0.f, l = 0.f; f32x16 o0, o1;
#pragma unroll
        for (int r = 0; r < 16; ++r) { o0[r] = 0.f; o1[r] = 0.f; }
        bool first = true;
        ATT_PASS(0, nct, ATT_CMP_K(g), ATT_CMP_V(g), 128,
                 { att::tile_step<false>(kb_, vb_, qr, m, l, o0, o1, true, first, true, nlim - 64 * t_, -1, hi, r32, lane); first = false; });
        ATT_PRE(0, ATT_CMP_K(g), ATT_CMP_V(g), 128);
        float mfin, linv;
        { const float lt = att::swapsum(l); linv = lt > 0.f ? 1.f / lt : 0.f; mfin = m; att::ost_acc(orow, o0, o1, ATT_GATE(0) * linv, true, hi); }
        ATT_PASS(0, nct, ATT_CMP_K(g), ATT_CMP_V(g), 128,
                 att::imp_step(kb_, qr, mfin, linv, nlim - 64 * t_, hi, r32, IMP + q * 64, 16 * t_));
        ATT_PRE(0, F_PROJ + ((size_t)b * SEQ + 64 * t_) * NPROJ + C_KS + g * 64, F_PROJ + ((size_t)b * SEQ + 64 * t_) * NPROJ + C_VS + g * 64, NPROJ);
        { const int j = lane; const bool forced = (j == 0) || (j == i) || (j == i - 1);
          for (int qq = 0; qq < 8; qq += 4) {
              unsigned key[4]; int rank[4];
#pragma unroll
              for (int u = 0; u < 4; ++u) { const float v0 = IMP[(8 * w + qq + u) * 64 + lane];
                  key[u] = (j > i) ? (unsigned)(63 - j) : (((__builtin_bit_cast(unsigned, v0) & ~63u) | (unsigned)(63 - j)) | (forced ? 0x80000000u : 0u)); rank[u] = 0; }
#pragma unroll
              for (int jc = 0; jc < 4; ++jc) {
                  if (16 * jc <= i) {
#pragma unroll
                      for (int jj = 16 * jc; jj < 16 * jc + 16; ++jj) {
#pragma unroll
                          for (int u = 0; u < 4; ++u) { const unsigned o = (unsigned)__builtin_amdgcn_readlane((int)key[u], jj); rank[u] += (o > key[u]) ? 1 : 0; } } } }
#pragma unroll
              for (int u = 0; u < 4; ++u) { const unsigned long long msk = __ballot(rank[u] < 16); if (lane == 0) SELM[8 * w + qq + u] = msk; } } }
        __syncthreads();
        m = 0.f; l = 0.f; first = true;
#pragma unroll
        for (int r = 0; r < 16; ++r) { o0[r] = 0.f; o1[r] = 0.f; }
        ATT_PASS(0, i + 1, F_PROJ + ((size_t)b * SEQ + 64 * t_) * NPROJ + C_KS + g * 64, F_PROJ + ((size_t)b * SEQ + 64 * t_) * NPROJ + C_VS + g * 64, NPROJ,
                 { att::tile_step<false>(kb_, vb_, qr, m, l, o0, o1, ((SELM[q] >> t_) & 1ull) != 0ull, first, t_ == i, (t_ == i) ? q : 63, -1, hi, r32, lane); first = false; });
        const int wlo = (i >= 8) ? i - 8 : 0;
        ATT_PRE(wlo, F_PROJ + ((size_t)b * SEQ + 64 * t_) * NPROJ + C_KW + g * 64, F_PROJ + ((size_t)b * SEQ + 64 * t_) * NPROJ + C_VW + g * 64, NPROJ);
        { const float lt = att::swapsum(l); att::ost_acc(orow, o0, o1, lt > 0.f ? ATT_GATE(1) / lt : 0.f, false, hi); }
        m = 0.f; l = 0.f; first = true;
#pragma unroll
        for (int r = 0; r < 16; ++r) { o0[r] = 0.f; o1[r] = 0.f; }
        ATT_PASS(wlo, i - wlo + 1, F_PROJ + ((size_t)b * SEQ + 64 * t_) * NPROJ + C_KW + g * 64, F_PROJ + ((size_t)b * SEQ + 64 * t_) * NPROJ + C_VW + g * 64, NPROJ,
                 { att::tile_step<true>(kb_, vb_, qr, m, l, o0, o1, true, first, (t_ == i) || (t_ == i - 8), (t_ == i) ? q : 63, (t_ == i - 8) ? q : -1, hi, r32, lane); first = false; });
        if (g == 0) ATT_PRE(0, ATT_CMP_K(1), ATT_CMP_V(1), 128);
        { const float lt = att::swapsum(l); att::ost_acc(orow, o0, o1, lt > 0.f ? ATT_GATE(2) / lt : 0.f, false, hi); }
        { float ss = 0.f;
#pragma unroll
          for (int rg = 0; rg < 4; ++rg) { const int d = 8 * rg + 4 * hi; const v2u w0 = *(const LAS v2u*)(orow + d * 2), w1 = *(const LAS v2u*)(orow + (32 + d) * 2);
              const float a0 = bflo(w0.x), a1 = bfhi(w0.x), a2 = bflo(w0.y), a3 = bfhi(w0.y), c0 = bflo(w1.x), c1 = bfhi(w1.x), c2 = bflo(w1.y), c3 = bfhi(w1.y);
              ss += (a0 * a0 + a1 * a1) + (a2 * a2 + a3 * a3) + (c0 * c0 + c1 * c1) + (c2 * c2 + c3 * c3); }
          __hip_atomic_fetch_add(SSQ + q, ss, __ATOMIC_RELAXED, __HIP_MEMORY_SCOPE_WORKGROUP); }
        __syncthreads();
    }
    { const int qx = tid >> 3, part = tid & 7; const float rs = 1.f / sqrtf(SSQ[qx] * (1.f / 512.f) + RMS_EPS);
      const LAS unsigned char* orow = L + att::OST_OFF + qx * att::OST_ROW + part * 128; bf16* dst = F_MIXA + ((size_t)b * SEQ + 64 * i + qx) * 1024 + 512 + part * 64;
#pragma unroll
      for (int c = 0; c < 8; ++c) { float f[8]; up8(*(const LAS v4u*)(orow + c * 16), f); const f32x4 g0 = *(const GAS f32x4*)(F_gn_attn + part * 64 + c * 8), g1 = *(const GAS f32x4*)(F_gn_attn + part * 64 + c * 8 + 4);
          v4u o; o.x = pk2(f[0] * rs * g0[0], f[1] * rs * g0[1]); o.y = pk2(f[2] * rs * g0[2], f[3] * rs * g0[3]); o.z = pk2(f[4] * rs * g1[0], f[5] * rs * g1[1]); o.w = pk2(f[6] * rs * g1[2], f[7] * rs * g1[3]);
          *(GAS v4u*)(dst + c * 8) = o; } }
    __syncthreads();
}
__device__ __forceinline__ void p3_attention(Frame& F) {
    for (int u = F.vcu; u < 512; u += F.G) { const int k = u >> 8, v = u & 255; const int b = v >> 5, s = v & 31; p3_unit(F, b, k ? 63 - s : s); }
}

namespace peer {
constexpr int IDX_OFF = 0, W6_OFF = 16384;
__device__ __forceinline__ unsigned f2key(float f) { const unsigned u = __builtin_bit_cast(unsigned, f); return u ^ ((unsigned)((int)u >> 31) | 0x80000000u); }
__device__ __forceinline__ float key2f(unsigned k) { return __builtin_bit_cast(float, k ^ ((k & 0x80000000u) ? 0x80000000u : 0xFFFFFFFFu)); }
__device__ __forceinline__ unsigned umax(unsigned a, unsigned b) { return a > b ? a : b; }
__device__ __forceinline__ unsigned umin(unsigned a, unsigned b) { return a < b ? a : b; }
__device__ __forceinline__ void sort16_desc(unsigned (&a)[16]) {
#pragma unroll
    for (int k = 2; k <= 16; k <<= 1) {
#pragma unroll
        for (int j = k >> 1; j > 0; j >>= 1) {
#pragma unroll
            for (int i = 0; i < 16; ++i) { const int l = i ^ j; if (l > i) { const bool up = ((i & k) == 0); const unsigned mx = umax(a[i], a[l]), mn = umin(a[i], a[l]); a[i] = up ? mx : mn; a[l] = up ? mn : mx; } }
        }
    }
}
__device__ __forceinline__ void merge16_desc(unsigned (&A)[16], const unsigned (&B)[16]) {
#pragma unroll
    for (int i = 0; i < 16; ++i) A[i] = umax(A[i], B[15 - i]);
#pragma unroll
    for (int j = 8; j > 0; j >>= 1) {
#pragma unroll
        for (int i = 0; i < 16; ++i) { const int l = i ^ j; if (l > i) { const unsigned mx = umax(A[i], A[l]), mn = umin(A[i], A[l]); A[i] = mx; A[l] = mn; } }
    }
}
template <int GQ> __device__ __forceinline__ void fill_cands(unsigned (&g)[16], const float (&f0)[16], const float (&f1)[16]) {
    if constexpr (GQ == 0) {
        g[0] = (f2key(f0[0] + f1[0]) & ~255u) | 255u;
        g[1] = (f2key(f0[0] + f1[1]) & ~255u) | 254u;
        g[2] = (f2key(f0[0] + f1[2]) & ~255u) | 253u;
        g[3] = (f2key(f0[0] + f1[3]) & ~255u) | 252u;
        g[4] = (f2key(f0[0] + f1[4]) & ~255u) | 251u;
        g[5] = (f2key(f0[0] + f1[5]) & ~255u) | 250u;
        g[6] = (f2key(f0[0] + f1[6]) & ~255u) | 249u;
        g[7] = (f2key(f0[0] + f1[7]) & ~255u) | 248u;
        g[8] = (f2key(f0[0] + f1[8]) & ~255u) | 247u;
        g[9] = (f2key(f0[0] + f1[9]) & ~255u) | 246u;
        g[10] = (f2key(f0[0] + f1[10]) & ~255u) | 245u;
        g[11] = (f2key(f0[0] + f1[11]) & ~255u) | 244u;
        g[12] = (f2key(f0[0] + f1[12]) & ~255u) | 243u;
        g[13] = (f2key(f0[0] + f1[13]) & ~255u) | 242u;
        g[14] = (f2key(f0[0] + f1[14]) & ~255u) | 241u;
        g[15] = (f2key(f0[0] + f1[15]) & ~255u) | 240u;
    }
    if constexpr (GQ == 1) {
        g[0] = (f2key(f0[1] + f1[0]) & ~255u) | 239u;
        g[1] = (f2key(f0[1] + f1[1]) & ~255u) | 238u;
        g[2] = (f2key(f0[1] + f1[2]) & ~255u) | 237u;
        g[3] = (f2key(f0[1] + f1[3]) & ~255u) | 236u;
        g[4] = (f2key(f0[1] + f1[4]) & ~255u) | 235u;
        g[5] = (f2key(f0[1] + f1[5]) & ~255u) | 234u;
        g[6] = (f2key(f0[1] + f1[6]) & ~255u) | 233u;
        g[7] = (f2key(f0[1] + f1[7]) & ~255u) | 232u;
        g[8] = (f2key(f0[2] + f1[0]) & ~255u) | 223u;
        g[9] = (f2key(f0[2] + f1[1]) & ~255u) | 222u;
        g[10] = (f2key(f0[2] + f1[2]) & ~255u) | 221u;
        g[11] = (f2key(f0[2] + f1[3]) & ~255u) | 220u;
        g[12] = (f2key(f0[2] + f1[4]) & ~255u) | 219u;
        g[13] = (f2key(f0[3] + f1[0]) & ~255u) | 207u;
        g[14] = (f2key(f0[3] + f1[1]) & ~255u) | 206u;
        g[15] = (f2key(f0[3] + f1[2]) & ~255u) | 205u;
    }
    if constexpr (GQ == 2) {
        g[0] = (f2key(f0[3] + f1[3]) & ~255u) | 204u;
        g[1] = (f2key(f0[4] + f1[0]) & ~255u) | 191u;
        g[2] = (f2key(f0[4] + f1[1]) & ~255u) | 190u;
        g[3] = (f2key(f0[4] + f1[2]) & ~255u) | 189u;
        g[4] = (f2key(f0[5] + f1[0]) & ~255u) | 175u;
        g[5] = (f2key(f0[5] + f1[1]) & ~255u) | 174u;
        g[6] = (f2key(f0[6] + f1[0]) & ~255u) | 159u;
        g[7] = (f2key(f0[6] + f1[1]) & ~255u) | 158u;
        g[8] = (f2key(f0[7] + f1[0]) & ~255u) | 143u;
        g[9] = (f2key(f0[7] + f1[1]) & ~255u) | 142u;
        g[10] = (f2key(f0[8] + f1[0]) & ~255u) | 127u;
        g[11] = (f2key(f0[9] + f1[0]) & ~255u) | 111u;
        g[12] = (f2key(f0[10] + f1[0]) & ~255u) | 95u;
        g[13] = (f2key(f0[11] + f1[0]) & ~255u) | 79u;
        g[14] = (f2key(f0[12] + f1[0]) & ~255u) | 63u;
        g[15] = (f2key(f0[13] + f1[0]) & ~255u) | 47u;
    }
    if constexpr (GQ == 3) {
        g[0] = (f2key(f0[14] + f1[0]) & ~255u) | 31u;
        g[1] = (f2key(f0[15] + f1[0]) & ~255u) | 15u;
        g[2] = 0u;
        g[3] = 0u;
        g[4] = 0u;
        g[5] = 0u;
        g[6] = 0u;
        g[7] = 0u;
        g[8] = 0u;
        g[9] = 0u;
        g[10] = 0u;
        g[11] = 0u;
        g[12] = 0u;
        g[13] = 0u;
        g[14] = 0u;
        g[15] = 0u;
    }
}
__device__ __forceinline__ float dot2bf(unsigned a, unsigned b, float c) { return __builtin_amdgcn_fdot2_f32_bf16(__builtin_bit_cast(bf16x2v, a), __builtin_bit_cast(bf16x2v, b), c, false); }
__device__ __forceinline__ float dot8(const v4u a, const v4u b, float c) { c = dot2bf(a.x, b.x, c); c = dot2bf(a.y, b.y, c); c = dot2bf(a.z, b.z, c); return dot2bf(a.w, b.w, c); }
__device__ __forceinline__ float dot32b(const v4u u, const unsigned (&h)[16]) {
    float s0 = 0.f, s1 = 0.f, s2 = 0.f, s3 = 0.f;
#define P6_D2(W, bs, hi_, acc_) acc_ = __builtin_amdgcn_fdot2_f32_bf16(__builtin_amdgcn_cvt_scalef32_pk_bf16_fp4((W), 1.0f, (bs)), __builtin_bit_cast(bf16x2v, h[hi_]), acc_, false)
    P6_D2(u.x, 0, 0, s0); P6_D2(u.x, 1, 1, s1); P6_D2(u.x, 2, 2, s2); P6_D2(u.x, 3, 3, s3);
    P6_D2(u.y, 0, 4, s0); P6_D2(u.y, 1, 5, s1); P6_D2(u.y, 2, 6, s2); P6_D2(u.y, 3, 7, s3);
    P6_D2(u.z, 0, 8, s0); P6_D2(u.z, 1, 9, s1); P6_D2(u.z, 2, 10, s2); P6_D2(u.z, 3, 11, s3);
    P6_D2(u.w, 0, 12, s0); P6_D2(u.w, 1, 13, s1); P6_D2(u.w, 2, 14, s2); P6_D2(u.w, 3, 15, s3);
#undef P6_D2
    return (s0 + s1) + (s2 + s3);
}
typedef _Float16 h16x2 __attribute__((ext_vector_type(2)));
template <int BS> __device__ __forceinline__ h16x2 cvt4h(unsigned w) { return __builtin_bit_cast(h16x2, __builtin_amdgcn_cvt_scalef32_pk_f16_fp4(w, 1.0f, BS)); }
__device__ __forceinline__ void axpy32h(h16x2 (&acc)[16], const v4u v, _Float16 a) {
    const h16x2 a2 = (h16x2){a, a};
    acc[0] = __builtin_elementwise_fma(cvt4h<0>(v.x), a2, acc[0]); acc[1] = __builtin_elementwise_fma(cvt4h<1>(v.x), a2, acc[1]); acc[2] = __builtin_elementwise_fma(cvt4h<2>(v.x), a2, acc[2]); acc[3] = __builtin_elementwise_fma(cvt4h<3>(v.x), a2, acc[3]);
    acc[4] = __builtin_elementwise_fma(cvt4h<0>(v.y), a2, acc[4]); acc[5] = __builtin_elementwise_fma(cvt4h<1>(v.y), a2, acc[5]); acc[6] = __builtin_elementwise_fma(cvt4h<2>(v.y), a2, acc[6]); acc[7] = __builtin_elementwise_fma(cvt4h<3>(v.y), a2, acc[7]);
    acc[8] = __builtin_elementwise_fma(cvt4h<0>(v.z), a2, acc[8]); acc[9] = __builtin_elementwise_fma(cvt4h<1>(v.z), a2, acc[9]); acc[10] = __builtin_elementwise_fma(cvt4h<2>(v.z), a2, acc[10]); acc[11] = __builtin_elementwise_fma(cvt4h<3>(v.z), a2, acc[11]);
    acc[12] = __builtin_elementwise_fma(cvt4h<0>(v.w), a2, acc[12]); acc[13] = __builtin_elementwise_fma(cvt4h<1>(v.w), a2, acc[13]); acc[14] = __builtin_elementwise_fma(cvt4h<2>(v.w), a2, acc[14]); acc[15] = __builtin_elementwise_fma(cvt4h<3>(v.w), a2, acc[15]);
}
__device__ __forceinline__ float dot32(const v4u u, const f32x2 (&h)[16]) {
    f32x2 s = __builtin_amdgcn_cvt_scalef32_pk_f32_fp4(u.x, 1.0f, 0) * h[0];
    s += __builtin_amdgcn_cvt_scalef32_pk_f32_fp4(u.x, 1.0f, 1) * h[1]; s += __builtin_amdgcn_cvt_scalef32_pk_f32_fp4(u.x, 1.0f, 2) * h[2]; s += __builtin_amdgcn_cvt_scalef32_pk_f32_fp4(u.x, 1.0f, 3) * h[3];
    s += __builtin_amdgcn_cvt_scalef32_pk_f32_fp4(u.y, 1.0f, 0) * h[4]; s += __builtin_amdgcn_cvt_scalef32_pk_f32_fp4(u.y, 1.0f, 1) * h[5]; s += __builtin_amdgcn_cvt_scalef32_pk_f32_fp4(u.y, 1.0f, 2) * h[6]; s += __builtin_amdgcn_cvt_scalef32_pk_f32_fp4(u.y, 1.0f, 3) * h[7];
    s += __builtin_amdgcn_cvt_scalef32_pk_f32_fp4(u.z, 1.0f, 0) * h[8]; s += __builtin_amdgcn_cvt_scalef32_pk_f32_fp4(u.z, 1.0f, 1) * h[9]; s += __builtin_amdgcn_cvt_scalef32_pk_f32_fp4(u.z, 1.0f, 2) * h[10]; s += __builtin_amdgcn_cvt_scalef32_pk_f32_fp4(u.z, 1.0f, 3) * h[11];
    s += __builtin_amdgcn_cvt_scalef32_pk_f32_fp4(u.w, 1.0f, 0) * h[12]; s += __builtin_amdgcn_cvt_scalef32_pk_f32_fp4(u.w, 1.0f, 1) * h[13]; s += __builtin_amdgcn_cvt_scalef32_pk_f32_fp4(u.w, 1.0f, 2) * h[14]; s += __builtin_amdgcn_cvt_scalef32_pk_f32_fp4(u.w, 1.0f, 3) * h[15];
    return s.x + s.y;
}
__device__ __forceinline__ void axpy32(f32x2 (&acc)[16], const v4u v, float a) {
    const f32x2 a2 = (f32x2){a, a};
    acc[0] += __builtin_amdgcn_cvt_scalef32_pk_f32_fp4(v.x, 1.0f, 0) * a2; acc[1] += __builtin_amdgcn_cvt_scalef32_pk_f32_fp4(v.x, 1.0f, 1) * a2; acc[2] += __builtin_amdgcn_cvt_scalef32_pk_f32_fp4(v.x, 1.0f, 2) * a2; acc[3] += __builtin_amdgcn_cvt_scalef32_pk_f32_fp4(v.x, 1.0f, 3) * a2;
    acc[4] += __builtin_amdgcn_cvt_scalef32_pk_f32_fp4(v.y, 1.0f, 0) * a2; acc[5] += __builtin_amdgcn_cvt_scalef32_pk_f32_fp4(v.y, 1.0f, 1) * a2; acc[6] += __builtin_amdgcn_cvt_scalef32_pk_f32_fp4(v.y, 1.0f, 2) * a2; acc[7] += __builtin_amdgcn_cvt_scalef32_pk_f32_fp4(v.y, 1.0f, 3) * a2;
    acc[8] += __builtin_amdgcn_cvt_scalef32_pk_f32_fp4(v.z, 1.0f, 0) * a2; acc[9] += __builtin_amdgcn_cvt_scalef32_pk_f32_fp4(v.z, 1.0f, 1) * a2; acc[10] += __builtin_amdgcn_cvt_scalef32_pk_f32_fp4(v.z, 1.0f, 2) * a2; acc[11] += __builtin_amdgcn_cvt_scalef32_pk_f32_fp4(v.z, 1.0f, 3) * a2;
    acc[12] += __builtin_amdgcn_cvt_scalef32_pk_f32_fp4(v.w, 1.0f, 0) * a2; acc[13] += __builtin_amdgcn_cvt_scalef32_pk_f32_fp4(v.w, 1.0f, 1) * a2; acc[14] += __builtin_amdgcn_cvt_scalef32_pk_f32_fp4(v.w, 1.0f, 2) * a2; acc[15] += __builtin_amdgcn_cvt_scalef32_pk_f32_fp4(v.w, 1.0f, 3) * a2;
}
__device__ __forceinline__ float dot16(const v4u u, const f32x2 (&h)[8]) {
    f32x2 s = __builtin_amdgcn_cvt_pk_f32_fp8((int)u.x, false) * h[0];
    s += __builtin_amdgcn_cvt_pk_f32_fp8((int)u.x, true) * h[1];
    s += __builtin_amdgcn_cvt_pk_f32_fp8((int)u.y, false) * h[2]; s += __builtin_amdgcn_cvt_pk_f32_fp8((int)u.y, true) * h[3];
    s += __builtin_amdgcn_cvt_pk_f32_fp8((int)u.z, false) * h[4]; s += __builtin_amdgcn_cvt_pk_f32_fp8((int)u.z, true) * h[5];
    s += __builtin_amdgcn_cvt_pk_f32_fp8((int)u.w, false) * h[6]; s += __builtin_amdgcn_cvt_pk_f32_fp8((int)u.w, true) * h[7];
    return s.x + s.y;
}
__device__ __forceinline__ void axpy16(f32x2 (&acc)[8], const v4u v, float a) {
    const f32x2 a2 = (f32x2){a, a};
    acc[0] += __builtin_amdgcn_cvt_pk_f32_fp8((int)v.x, false) * a2; acc[1] += __builtin_amdgcn_cvt_pk_f32_fp8((int)v.x, true) * a2;
    acc[2] += __builtin_amdgcn_cvt_pk_f32_fp8((int)v.y, false) * a2; acc[3] += __builtin_amdgcn_cvt_pk_f32_fp8((int)v.y, true) * a2;
    acc[4] += __builtin_amdgcn_cvt_pk_f32_fp8((int)v.z, false) * a2; acc[5] += __builtin_amdgcn_cvt_pk_f32_fp8((int)v.z, true) * a2;
    acc[6] += __builtin_amdgcn_cvt_pk_f32_fp8((int)v.w, false) * a2; acc[7] += __builtin_amdgcn_cvt_pk_f32_fp8((int)v.w, true) * a2;
}
__device__ __forceinline__ float xsum32(float a, float b) { auto r = __builtin_amdgcn_permlane32_swap(__float_as_uint(a), __float_as_uint(b), false, false); return __uint_as_float(r[0]) + __uint_as_float(r[1]); }
__device__ __forceinline__ float xsum16(float a, float b) { auto r = __builtin_amdgcn_permlane16_swap(__float_as_uint(a), __float_as_uint(b), false, false); return __uint_as_float(r[0]) + __uint_as_float(r[1]); }
template <int CTRL> __device__ __forceinline__ float dppf(float v) { return __builtin_bit_cast(float, __builtin_amdgcn_update_dpp(0, __builtin_bit_cast(int, v), CTRL, 0xF, 0xF, true)); }
__device__ __forceinline__ float transpose_reduce8_dc(const float (&p)[8], int lane) {
    float x4[4], x2[2];
    { const bool bt = (lane & 4) != 0;
#pragma unroll
      for (int k = 0; k < 4; ++k) { const float keep = bt ? p[k + 4] : p[k], send = bt ? p[k] : p[k + 4]; x4[k] = keep + dppf<0x141>(send); } }
    { const bool bt = (lane & 2) != 0;
#pragma unroll
      for (int k = 0; k < 2; ++k) { const float keep = bt ? x4[k + 2] : x4[k], send = bt ? x4[k] : x4[k + 2]; x2[k] = keep + dppf<0x4E>(send); } }
    const bool bt = (lane & 1) != 0; const float keep = bt ? x2[1] : x2[0], send = bt ? x2[0] : x2[1]; return keep + dppf<0xB1>(send);
}
__device__ __forceinline__ float transpose_reduce8(const float (&p)[8], int lane) {
    float x4[4], x2[2];
    { const bool bt = (lane & 4) != 0;
#pragma unroll
      for (int k = 0; k < 4; ++k) { const float keep = bt ? p[k + 4] : p[k], send = bt ? p[k] : p[k + 4]; x4[k] = keep + __shfl_xor(send, 4); } }
    { const bool bt = (lane & 2) != 0;
#pragma unroll
      for (int k = 0; k < 2; ++k) { const float keep = bt ? x4[k + 2] : x4[k], send = bt ? x4[k] : x4[k + 2]; x2[k] = keep + __shfl_xor(send, 2); } }
    float r;
    { const bool bt = (lane & 1) != 0; const float keep = bt ? x2[1] : x2[0], send = bt ? x2[0] : x2[1]; r = keep + __shfl_xor(send, 1); }
    r += __shfl_xor(r, 8); r += __shfl_xor(r, 16); r += __shfl_xor(r, 32);
    return r;
}
__device__ __forceinline__ void cexf(float& a, float& b) { float mx, mn; asm("v_max_f32 %0, %1, %2" : "=v"(mx) : "v"(a), "v"(b)); asm("v_min_f32 %0, %1, %2" : "=v"(mn) : "v"(a), "v"(b)); a = mx; b = mn; }
__device__ __forceinline__ float fmaxr(float a, float b) { float mx; asm("v_max_f32 %0, %1, %2" : "=v"(mx) : "v"(a), "v"(b)); return mx; }
__device__ __forceinline__ void sort16f(float (&a)[16]) {
#define CX(i, j) cexf(a[i], a[j]);
    CX(0,1) CX(2,3) CX(4,5) CX(6,7) CX(8,9) CX(10,11) CX(12,13) CX(14,15) CX(0,2) CX(1,3) CX(4,6) CX(5,7) CX(8,10) CX(9,11) CX(12,14) CX(13,15) CX(1,2) CX(5,6) CX(9,10) CX(13,14) CX(0,4) CX(1,5) CX(2,6) CX(3,7) CX(8,12) CX(9,13) CX(10,14) CX(11,15) CX(2,4) CX(3,5) CX(10,12) CX(11,13) CX(1,2) CX(3,4) CX(5,6) CX(9,10) CX(11,12) CX(13,14) CX(0,8) CX(1,9) CX(2,10) CX(3,11) CX(4,12) CX(5,13) CX(6,14) CX(7,15) CX(4,8) CX(5,9) CX(6,10) CX(7,11) CX(2,4) CX(3,5) CX(6,8) CX(7,9) CX(10,12) CX(11,13) CX(1,2) CX(3,4) CX(5,6) CX(7,8) CX(9,10) CX(11,12) CX(13,14)
#undef CX
}
__device__ __forceinline__ void merge16f(float (&A)[16], const float (&B)[16]) {
#pragma unroll
    for (int i = 0; i < 16; ++i) A[i] = fmaxr(A[i], B[15 - i]);
#pragma unroll
    for (int j = 8; j > 0; j >>= 1) {
#pragma unroll
        for (int i = 0; i < 16; ++i) { const int l = i ^ j; if (l > i) cexf(A[i], A[l]); }
    }
}
__device__ __forceinline__ float keyf(float v, unsigned mask, unsigned code) { return __builtin_bit_cast(float, (__builtin_bit_cast(unsigned, v) & mask) | code); }
}

__device__ __forceinline__ void p6a_ldq(const bf16* QP, int tg32, int h, int c, int ln, bf16x8 (&bq)[8]) {
    const bf16* base = QP + ((size_t)(tg32 * 16 + (h * 2 + c)) * 8) * 512 + ln * 8;
#pragma unroll
    for (int s = 0; s < 8; ++s) bq[s] = *(const GAS bf16x8*)(base + 512 * s);
}
template <bool LOADQ, bool PREQ> __device__ __forceinline__ void p6a_top(Frame& F, const bf16* QP, int tg32, int h, int c, int hn, int cn, int hi, int r32, bf16x8 (&bq)[8], bf16x8 (&bqn)[8], float (&top)[16]) {
    int ln = hi * 32 + r32; asm volatile("" : "+v"(ln));
    if (LOADQ) p6a_ldq(QP, tg32, h, c, ln, bq);
    const bf16* ap0 = F_SUBK + (size_t)((h * 2 + c) * 32) * 512 + ln * 8;
    bf16x8 af[8];
#pragma unroll
    for (int s = 0; s < 8; ++s) af[s] = *(const GAS bf16x8*)(ap0 + 512 * s);
    unsigned km = ~127u; asm volatile("" : "+s"(km));
#pragma unroll
    for (int kt = 0; kt < 4; ++kt) {
        f32x16 acc;
#pragma unroll
        for (int r = 0; r < 16; ++r) acc[r] = 0.f;
#pragma unroll
        for (int s = 0; s < 8; ++s) acc = __builtin_amdgcn_mfma_f32_32x32x16_bf16(af[s], bq[s], acc, 0, 0, 0);
        if (kt < 3) {
#pragma unroll
            for (int s = 0; s < 8; ++s) af[s] = *(const GAS bf16x8*)(ap0 + 512 * (8 * (kt + 1) + s));
        }
        if (PREQ && kt == 3) p6a_ldq(QP, tg32, hn, cn, ln, bqn);
        __builtin_amdgcn_sched_group_barrier(0x008, 8, 0);
        if (kt < 3 || PREQ) __builtin_amdgcn_sched_group_barrier(0x020, 8, 0);
        float g[16];
#pragma unroll
        for (int r = 0; r < 16; ++r) g[r] = peer::keyf(acc[r], km, 63u - (unsigned)(16 * kt + r));
        peer::sort16f(g);
        if (kt == 0) {
#pragma unroll
            for (int r = 0; r < 16; ++r) top[r] = g[r];
        } else peer::merge16f(top, g);
    }
    const unsigned hb = hi ? 0u : 64u;
#pragma unroll
    for (int r = 0; r < 16; ++r) top[r] = __builtin_bit_cast(float, __builtin_bit_cast(unsigned, top[r]) | hb);
}
__device__ __forceinline__ void p6a_unit(Frame& F, int unit) {
    LAS unsigned char* L = F.lds + RING_OFF;
    const int lane = F.lane, w = F.wave, hi = lane >> 5, r32 = lane & 31;
    const bf16* QP = F_PROJ;
    const int tg = w & 3, hs = w >> 2;
    const size_t tokrow = (size_t)unit * 128 + tg * 32 + r32;
    LAS unsigned char* myidx = L + peer::IDX_OFF + (w * 64 + lane) * 32;
    const int tg32 = unit * 4 + tg;
    bf16x8 bqa[8], bqb[8];
    { int ln0 = lane; asm volatile("" : "+v"(ln0)); p6a_ldq(QP, tg32, hs * 4, 0, ln0, bqa); }
    for (int hp = 0; hp < 2; ++hp) {
        const int h0 = hs * 4 + 2 * hp, h = h0 + hi;
        const int hnx = hp ? h0 : h0 + 2;
        float s01[2][16];
#define P6A_XMERGE(C) do { \
            _Pragma("unroll") for (int r = 0; r < 16; ++r) { auto rr = __builtin_amdgcn_permlane32_swap(__builtin_bit_cast(unsigned, T0[r]), __builtin_bit_cast(unsigned, T1[r]), false, false); \
                T0[r] = __builtin_bit_cast(float, (unsigned)rr[0]); T1[r] = __builtin_bit_cast(float, (unsigned)rr[1]); }     \
            peer::merge16f(T0, T1); \
            _Pragma("unroll") for (int r = 0; r < 16; ++r) s01[C][r] = T0[r]; } while (0)
        { float T0[16], T1[16];
          p6a_top<false, true>(F, QP, tg32, h0, 0, h0 + 1, 0, hi, r32, bqa, bqb, T0); p6a_top<false, true>(F, QP, tg32, h0 + 1, 0, h0, 1, hi, r32, bqb, bqa, T1);
          P6A_XMERGE(0); }
        { float T0[16], T1[16];
          p6a_top<false, true>(F, QP, tg32, h0, 1, h0 + 1, 1, hi, r32, bqa, bqb, T0); p6a_top<false, true>(F, QP, tg32, h0 + 1, 1, hnx, 0, hi, r32, bqb, bqa, T1);
          P6A_XMERGE(1); }
#undef P6A_XMERGE
        { v4u i0, i1;
#define IDX4(S, o) ((127u - (__builtin_bit_cast(unsigned, (S)[o]) & 127u)) | ((127u - (__builtin_bit_cast(unsigned, (S)[o + 1]) & 127u)) << 8) | ((127u - (__builtin_bit_cast(unsigned, (S)[o + 2]) & 127u)) << 16) | ((127u - (__builtin_bit_cast(unsigned, (S)[o + 3]) & 127u)) << 24))
          i0.x = IDX4(s01[0], 0); i0.y = IDX4(s01[0], 4); i0.z = IDX4(s01[0], 8); i0.w = IDX4(s01[0], 12);
          i1.x = IDX4(s01[1], 0); i1.y = IDX4(s01[1], 4); i1.z = IDX4(s01[1], 8); i1.w = IDX4(s01[1], 12);
#undef IDX4
          *(LAS v4u*)(myidx) = i0; *(LAS v4u*)(myidx + 16) = i1; }
        const float NEG = __builtin_bit_cast(float, 0xFF800000u);
        const float (&f0)[16] = s01[0]; const float (&f1)[16] = s01[1];
#define CK(a, b) peer::keyf(f0[a] + f1[b], ~255u, 255u - (unsigned)(16 * (a) + (b)))
        float best[16], g[16];
#pragma unroll
        for (int b = 0; b < 16; ++b) best[b] = CK(0, b);
#pragma unroll
        for (int a = 1; a < 16; ++a) g[a - 1] = CK(a, 0);
        g[15] = NEG;
        peer::merge16f(best, g);
        g[0] = CK(1, 1); g[1] = CK(1, 2); g[2] = CK(1, 3); g[3] = CK(1, 4); g[4] = CK(1, 5); g[5] = CK(1, 6); g[6] = CK(1, 7);
        g[7] = CK(2, 1); g[8] = CK(2, 2); g[9] = CK(2, 3); g[10] = CK(2, 4); g[11] = CK(3, 1); g[12] = CK(3, 2); g[13] = CK(3, 3); g[14] = CK(4, 1); g[15] = CK(4, 2);
        peer::sort16f(g); peer::merge16f(best, g);
        g[0] = CK(5, 1); g[1] = CK(6, 1); g[2] = CK(7, 1);
#pragma unroll
        for (int r = 3; r < 16; ++r) g[r] = NEG;
        peer::merge16f(best, g);
#undef CK
        float ev[16]; float esum = 0.f; const float vmax = best[0];
#pragma unroll
        for (int k = 0; k < 16; ++k) { ev[k] = __expf(best[k] - vmax); esum += ev[k]; }
        const float einv = 1.f / esum;
        unsigned ent[16];
#pragma unroll
        for (int k = 0; k < 16; ++k) { const unsigned ab = 255u - (__builtin_bit_cast(unsigned, best[k]) & 255u); const unsigned ia = *(const LAS unsigned char*)(myidx + (ab >> 4)), ib = *(const LAS unsigned char*)(myidx + 16 + (ab & 15u));
            ent[k] = (ia * 128u + ib) | (f2bf(ev[k] * einv) << 16); }
        GAS v4u* dst = (GAS v4u*)((GAS unsigned*)(FWS(unsigned, WS_EXPG)) + tokrow * 128 + h * 16);
#pragma unroll
        for (int k = 0; k < 4; ++k) { v4u o; o.x = ent[4 * k]; o.y = ent[4 * k + 1]; o.z = ent[4 * k + 2]; o.w = ent[4 * k + 3]; dst[k] = o; }
    }
}
template <bool DUMMY> __device__ __forceinline__ void p6b_phase(Frame& F) {
    LAS unsigned char* L = F.lds + RING_OFF;
    const int lane = F.lane, w = F.wave;
    const unsigned* EXPG = FWS(unsigned, WS_EXPG);
    LAS unsigned* EW = (LAS unsigned*)(L + peer::W6_OFF + w * 6144);
    LAS _Float16* AH = (LAS _Float16*)(L + peer::W6_OFF + w * 6144 + 4096);
    const int gw = F.vcu * NWAVES + w, NGW = F.G * NWAVES;
    for (int tok0 = gw * 8; tok0 < TT; tok0 += NGW * 8) {
        int ln = lane; asm volatile("" : "+v"(ln));
        const int ts = ln >> 3, dc = ln & 7;
        const unsigned char* ubase = F_U + dc * 16;
        const unsigned char* vbase = F_V + dc * 16;
        const size_t tok = (size_t)tok0 + ts;
#pragma unroll
        for (int i = 0; i < 16; ++i) EW[i * 64 + ln] = EXPG[(size_t)tok0 * 128 + i * 64 + ln];
        float rstd;
        { const float* sq = F_SSQ + tok * 16 + 2 * dc; float ssp = sq[0] + sq[1]; ssp += __shfl_xor(ssp, 1); ssp += __shfl_xor(ssp, 2); ssp += __shfl_xor(ssp, 4);
          rstd = 1.f / sqrtf(ssp * (1.f / 1024.f) + RMS_EPS); }
        unsigned hq[16];
        { const float qs = rstd * (1.f / QSTEP);
#pragma unroll
          for (int q = 0; q < 16; ++q) { float g8[8]; up8(*(const GAS v4u*)(F_XN + tok * 1024 + 64 * q + 8 * dc), g8); unsigned wq = 0u;
#pragma unroll
              for (int e2 = 0; e2 < 8; ++e2) { const int qv = (int)__builtin_rintf(__builtin_fminf(__builtin_fmaxf(g8[e2] * qs, -8.f), 7.f)); wq |= ((unsigned)qv & 15u) << (4 * e2); }
              hq[q] = wq; } }
        const float dscale = QSTEP * QSTEP * (1.f / 32.f);
        LDS_WAIT(); asm volatile("" ::: "memory");
#define P6_ROWLD(R, base_, st_) do { const unsigned e0_ = EW[ts * 128 + 2 * (st_)] & 0xffffu, e1_ = EW[ts * 128 + 2 * (st_) + 1] & 0xffffu; \
            _Pragma("unroll") for (int c = 0; c < 4; ++c) { R[c] = *(const GAS v4u*)((base_) + (size_t)e0_ * 512 + 128 * c); R[4 + c] = *(const GAS v4u*)((base_) + (size_t)e1_ * 512 + 128 * c); } } while (0)
#define P6_IDOT(V4, hq4_, acc_) do { acc_ = __builtin_amdgcn_sdot8((int)(V4).x, (int)hq[(hq4_)], acc_, false); acc_ = __builtin_amdgcn_sdot8((int)(V4).y, (int)hq[(hq4_) + 1], acc_, false); \
            acc_ = __builtin_amdgcn_sdot8((int)(V4).z, (int)hq[(hq4_) + 2], acc_, false); acc_ = __builtin_amdgcn_sdot8((int)(V4).w, (int)hq[(hq4_) + 3], acc_, false); } while (0)
#define P6_DOT2(R, P, j0_) do { int i0_ = 0, i1_ = 0, i2_ = 0, i3_ = 0; \
            P6_IDOT(R[0], 0, i0_); P6_IDOT(R[1], 4, i1_); P6_IDOT(R[2], 8, i0_); P6_IDOT(R[3], 12, i1_); \
            P6_IDOT(R[4], 0, i2_); P6_IDOT(R[5], 4, i3_); P6_IDOT(R[6], 8, i2_); P6_IDOT(R[7], 12, i3_); \
            P[j0_] = (float)(i0_ + i1_); P[(j0_) + 1] = (float)(i2_ + i3_); } while (0)
        {
            v4u ra[8], rb[8];
            P6_ROWLD(ra, ubase, 0);
#pragma unroll 1
            for (int gq = 0; gq < 16; ++gq) {
                float p8[8];
                const int st = 4 * gq;
                P6_ROWLD(rb, ubase, st + 1); P6_DOT2(ra, p8, 0);
                P6_ROWLD(ra, ubase, st + 2); P6_DOT2(rb, p8, 2);
                P6_ROWLD(rb, ubase, st + 3); P6_DOT2(ra, p8, 4);
                if (gq < 15) P6_ROWLD(ra, ubase, st + 4);
                P6_DOT2(rb, p8, 6);
                const float d = peer::transpose_reduce8_dc(p8, lane);
                const unsigned ent = EW[ts * 128 + 8 * gq + dc];
                AH[ts * 128 + 8 * gq + dc] = (_Float16)(__builtin_bit_cast(float, ent & 0xffff0000u) * gelu_tanh(d * dscale));
            }
        }
        LDS_WAIT(); asm volatile("" ::: "memory");
        peer::h16x2 acc[64];
#pragma unroll
        for (int j = 0; j < 64; ++j) acc[j] = (peer::h16x2){(_Float16)0.f, (_Float16)0.f};
#define P6_AXPY2(R, st_) do { const _Float16 a0_ = AH[ts * 128 + 2 * (st_)], a1_ = AH[ts * 128 + 2 * (st_) + 1]; \
            _Pragma("unroll") for (int c = 0; c < 4; ++c) { peer::axpy32h(*(peer::h16x2 (*)[16])(acc + 16 * c), R[c], a0_); peer::axpy32h(*(peer::h16x2 (*)[16])(acc + 16 * c), R[4 + c], a1_); } } while (0)
        {
            v4u ra[8], rb[8];
            P6_ROWLD(ra, vbase, 0);
#pragma unroll 1
            for (int st = 0; st < 64; st += 2) {
                P6_ROWLD(rb, vbase, st + 1); P6_AXPY2(ra, st);
                if (st + 2 < 64) P6_ROWLD(ra, vbase, st + 2);
                P6_AXPY2(rb, st + 1);
            }
        }
#undef P6_ROWLD
#undef P6_DOT2
#undef P6_IDOT
#undef P6_AXPY2
        const float vs = 1.f / VSCALE; float ss = 0.f;
        int ln2 = lane; asm volatile("" : "+v"(ln2));
        const int ts2 = ln2 >> 3, dc2 = ln2 & 7; const size_t tok2 = (size_t)tok0 + ts2;
#pragma unroll
        for (int q = 0; q < 16; ++q) { float g8[8]; up8(*(const GAS v4u*)(F_XN + tok2 * 1024 + 64 * q + 8 * dc2), g8);
#pragma unroll
            for (int e2 = 0; e2 < 4; ++e2) { const peer::h16x2 av = acc[4 * q + e2]; g8[2 * e2] += (float)av.x * vs; g8[2 * e2 + 1] += (float)av.y * vs; }
#pragma unroll
            for (int e2 = 0; e2 < 8; ++e2) ss += g8[e2] * g8[e2]; }
        ss += __shfl_xor(ss, 1); ss += __shfl_xor(ss, 2); ss += __shfl_xor(ss, 4);
        const float rs = 1.f / sqrtf(ss * (1.f / 1024.f) + RMS_EPS);
        int zo = 0; asm volatile("" : "+v"(zo));
#pragma unroll
        for (int q = 0; q < 16; ++q) { const bf16* hp = F_XN + tok2 * 1024 + 64 * q + 8 * dc2 + zo; float* op = (DUMMY ? FWS(float, 160 * MiB) : F_out) + tok2 * 1024 + 64 * q + 8 * dc2; const float* gp = F_lnf + 64 * q + 8 * dc2;
            float g8[8]; up8(*(const GAS v4u*)hp, g8);
#pragma unroll
            for (int e2 = 0; e2 < 4; ++e2) { const peer::h16x2 av = acc[4 * q + e2]; g8[2 * e2] += (float)av.x * vs; g8[2 * e2 + 1] += (float)av.y * vs; }
            const f32x4 ga = *(const GAS f32x4*)gp, gb = *(const GAS f32x4*)(gp + 4);
            *(GAS f32x4*)op = (f32x4){g8[0], g8[1], g8[2], g8[3]} * rs * ga; *(GAS f32x4*)(op + 4) = (f32x4){g8[4], g8[5], g8[6], g8[7]} * rs * gb; }
        LDS_WAIT(); asm volatile("" ::: "memory");
    }
}
__device__ __forceinline__ void p6a_phase(Frame& F) { for (int u = F.vcu; u < TT / 128; u += F.G) p6a_unit(F, u); }
#ifndef HYB
#define HYB 7
#endif
__global__ void __launch_bounds__(NWAVES * 64, 2) mk_fwd(Args args) {
    extern __shared__ __attribute__((aligned(16))) unsigned char lds[];
    Frame F;
    F.lds = (LAS unsigned char*)lds;
    F.MISC = (volatile LAS unsigned*)(F.lds + MISC_OFF);
    F.tid = threadIdx.x; F.lane = F.tid & 63; F.wave = __builtin_amdgcn_readfirstlane(F.tid >> 6);
    F.G = gridDim.x; { const int bx = blockIdx.x; F.vcu = (F.G % 8 == 0) ? (bx % 8) * (F.G / 8) + bx / 8 : bx; }
    F.a = &args;
    F.ctl = (gu32*)(args.ws + WS_CTL);
    for (int u = F.tid; u < (LDS_BYTES - LDSCTL_OFF) / 4; u += NWAVES * 64) ((LAS unsigned*)(F.lds + LDSCTL_OFF))[u] = 0u;
    __syncthreads();
    XcdBarrier bar = xcd_barrier_post((unsigned*)(F.ctl + CW_BAR), F.MISC + 8);
    const int lo = args.ph_lo, hi = args.ph_hi;
#define IN(k) (lo <= (k) && (k) < hi)
#define BOTH(k) (IN(k) && IN((k) + 1))
    if (IN(0)) { p0_prologue(F);
#ifdef DUP_P0
        p0_prologue(F);
#endif
        if (BOTH(0)) xcd_barrier(bar); }
    if (IN(1)) {
        pg8::Gemm g{F_XN, F_WinT, TT, NPROJ, DM}; pg8::StaticOrder S; S.init(TT, NPROJ, F.G, (int)blockIdx.x);
        pg8::EpiProj E{F_PROJ, NPROJ, C_Q / 256, C_KC / 256, QSCALE};
        pg8::gemm_phase<pg8::EpiProj, pg8::StaticOrder, true, true>(F.lds + RING_OFF, g, S, E);
#ifdef DUP_P1
        pg8::gemm_phase<pg8::EpiProj, pg8::StaticOrder, true, true>(F.lds + RING_OFF, g, S, E);
#endif
        if (BOTH(1)) xcd_barrier(bar);
    }
#ifdef DUP_BAR
    if (IN(2)) { for (int zz = 0; zz < 10; ++zz) xcd_barrier(bar); }
#endif
    if (IN(2)) { p2_phase(F);
#ifdef DUP_P2
        p2_phase(F);
#endif
        if (BOTH(2)) xcd_barrier(bar); }
#if HYB >= 4
    if (IN(3)) { p3_attention(F);
#ifdef DUP_P3
        p3_attention(F);
#endif
        if (BOTH(3)) xcd_barrier(bar); }
#endif
#if HYB >= 5
    if (IN(4)) {
        pg8::Gemm g{F_MIXA, F_WoutT, TT, DM, DM}; pg8::StaticOrder S; S.init(TT, DM, F.G, (int)blockIdx.x);
        pg8::EpiResid E{F_x, F_XN, F_SSQ, DM};
        pg8::gemm_phase<pg8::EpiResid, pg8::StaticOrder, true, true>(F.lds + RING_OFF, g, S, E);
#ifdef DUP_P4
        pg8::gemm_phase<pg8::EpiResid, pg8::StaticOrder, true, true>(F.lds + RING_OFF, g, S, E);
#endif
        if (BOTH(4)) xcd_barrier(bar);
    }
#endif
#if HYB >= 6
    if (IN(5)) {
        pg8::Gemm g{F_XN, F_WqT, TT, NQP, DM}; pg8::StaticOrder S; S.init(TT, NQP, F.G, (int)blockIdx.x);
        pg8::EpiScaleRow E{F_PROJ, NQP, F_SSQ, RMS_EPS};
        pg8::gemm_phase<pg8::EpiScaleRow, pg8::StaticOrder, true, true>(F.lds + RING_OFF, g, S, E);
#ifdef DUP_P5
        pg8::gemm_phase<pg8::EpiScaleRow, pg8::StaticOrder, true, true>(F.lds + RING_OFF, g, S, E);
#endif
        if (BOTH(5)) xcd_barrier(bar);
    }
#endif
#if HYB >= 7
    if (IN(6)) { p6a_phase(F);
#ifdef DUP_6A
        p6a_phase(F);
#endif
        xcd_barrier(bar);
#ifdef DUP_6B
        p6b_phase<true>(F);
#endif
        p6b_phase<false>(F); }
#endif
#undef IN
#undef BOTH
}

extern "C" void kernel_launch(void* const* d_in, const int* in_sizes, int n_in, void* d_out, int out_size, void* d_ws, size_t ws_size, hipStream_t stream) {
    static int grid = 0;
    if (grid == 0) {
        if (n_in != 19 || in_sizes[0] != TT * DM || out_size != TT * DM || ws_size < 512 * MiB) { fprintf(stderr, "kernel_launch: unexpected shapes (n_in %d, in0 %d, out %d, ws %zu); nothing launched\n", n_in, n_in > 0 ? in_sizes[0] : -1, out_size, ws_size); grid = -1; return; }
        int dev = 0, cus = 0, per_cu = 0;
        if (hipGetDevice(&dev) != hipSuccess || hipDeviceGetAttribute(&cus, hipDeviceAttributeMultiprocessorCount, dev) != hipSuccess) { grid = -1; return; }
        if (hipFuncSetAttribute((const void*)mk_fwd, hipFuncAttributeMaxDynamicSharedMemorySize, LDS_BYTES) != hipSuccess) { fprintf(stderr, "kernel_launch: hipFuncSetAttribute failed\n"); grid = -1; return; }
        if (hipOccupancyMaxActiveBlocksPerMultiprocessor(&per_cu, (const void*)mk_fwd, NWAVES * 64, LDS_BYTES) != hipSuccess || per_cu < 1) fprintf(stderr, "kernel_launch: note: occupancy query reports %d workgroups per CU\n", per_cu);
        (void)hipGetLastError();
        grid = cus;
    }
    if (grid < 0) return;
    if (hipMemsetAsync((char*)d_ws + WS_CTL, 0, CTL_ZERO_BYTES, stream) != hipSuccess) return;
    Args a{};
    for (int i = 0; i < 19; ++i) a.in[i] = (const float*)d_in[i];
    a.out = (float*)d_out; a.ws = (unsigned char*)d_ws; a.ph_lo = 0; a.ph_hi = HYB;
    hipLaunchKernelGGL(mk_fwd, dim3(grid), dim3(NWAVES * 64), LDS_BYTES, stream, a);
#if HYB < 7
    using namespace nv;
    char* ws = (char*)d_ws;
    const float* x = a.in[0]; const float* conv_w = a.in[3]; const float* pos_k = a.in[4]; const float* pos_v = a.in[5]; const float* k_w1 = a.in[6]; const float* k_w2 = a.in[7]; const float* v_w1 = a.in[8]; const float* v_w2 = a.in[9];
    const float* gn_conv = a.in[10]; const float* gn_attn = a.in[11]; const float* w_out = a.in[12]; const float* ln2 = a.in[13]; const float* wq = a.in[14]; const float* subkeys = a.in[15]; const float* pu = a.in[16]; const float* pv = a.in[17]; const float* lnf = a.in[18];
    float* out = (float*)d_out;
    const bf16* PROJ = (const bf16*)(ws + WS_PROJ); const bf16* MIXA = (const bf16*)(ws + WS_MIXA); const bf16* KCC = (const bf16*)(ws + WS_KCC); const bf16* VCC = (const bf16*)(ws + WS_VCC);
    float* MIXF = (float*)(ws + 32 * MiB);
    float* KCF = (float*)(ws + 420 * MiB); float* VCF = (float*)(ws + 422 * MiB);
    float* QPF = (float*)(ws + 160 * MiB);
    int* EIDX = (int*)(ws + 424 * MiB); float* EGATE = (float*)(ws + 440 * MiB);
#if HYB <= 2
    conv_kernel<bf16><<<TT / 4, 256, 0, stream>>>(PROJ, NPROJ, conv_w, gn_conv, MIXF);
    (void)hipMemsetAsync(KCF, 0, 4 * MiB, stream);
    compress_kernel<bf16><<<BATCH * N_CMP * 2, 256, 0, stream>>>(PROJ, NPROJ, C_KC, pos_k, k_w1, k_w2, KCF);
    compress_kernel<bf16><<<BATCH * N_CMP * 2, 256, 0, stream>>>(PROJ, NPROJ, C_VC, pos_v, v_w1, v_w2, VCF);
    nsa_naive<bf16, float, true><<<TT * 2, 256, 0, stream>>>(PROJ, NPROJ, KCF, VCF, MIXF);
    attn_norm<<<TT / 4, 256, 0, stream>>>(MIXF, gn_attn);
#elif HYB == 3
    cvt_bf16_f32<<<4096, 256, 0, stream>>>(MIXA, 1024, MIXF, 1024, TT, 512);
    nsa_naive<bf16, bf16, true><<<TT * 2, 256, 0, stream>>>(PROJ, NPROJ, KCC, VCC, MIXF);
    attn_norm<<<TT / 4, 256, 0, stream>>>(MIXF, gn_attn);
#elif HYB == 4
    cvt_bf16_f32<<<4096, 256, 0, stream>>>(MIXA, 1024, MIXF, 1024, TT, 1024);
#endif
#if HYB <= 4
    gemm_f32<float, true><<<dim3(1024 / 64, TT / 64), 256, 0, stream>>>(MIXF, 1024, w_out, out, x, TT, 1024, 1024);
#endif
    rmsnorm1024<<<TT / 4, 256, 0, stream>>>(out, ln2, MIXF, TT);
#if HYB <= 5
    gemm_f32<float, false><<<dim3(2048 / 64, TT / 64), 256, 0, stream>>>(MIXF, 1024, wq, QPF, nullptr, TT, 2048, 1024);
    peer_topk<float><<<TT * 8, 128, 0, stream>>>(QPF, subkeys, EIDX, EGATE);
#else
    peer_topk<bf16><<<TT * 8, 128, 0, stream>>>(PROJ, subkeys, EIDX, EGATE);
#endif
    peer_experts<<<TT, 256, 0, stream>>>(MIXF, EIDX, EGATE, pu, pv, lnf, out);
    (void)ln2; (void)KCC; (void)VCC; (void)MIXA;
#endif
}
```

```cpp
#include <hip/hip_runtime.h>
#include <cstdio>
#include <cstdint>
namespace pg8 {
#define PG8_LAS __attribute__((address_space(3)))
typedef unsigned short bf16_t;
typedef short bf16x8 __attribute__((ext_vector_type(8)));
typedef float f32x4 __attribute__((ext_vector_type(4)));
typedef unsigned u32x4 __attribute__((ext_vector_type(4)));
constexpr int BM = 256, BK = 64, HALF = 128, HTB = HALF * BK * 2  , STAGE_BYTES = 8 * HTB, NXCD = 8, WGM = 8;

__host__ __device__ __forceinline__ int lds_byte(int r, int c) { const int st = (r >> 4) * 2 + (c >> 5), rr = r & 15, cc = c & 31, ob = rr * 64 + cc * 2; return st * 1024 + (ob ^ (((ob >> 9) & 1) << 5)); }
__host__ __device__ __forceinline__ void stage_rc(int b, int& R, int& C) { const int st = b / 1024, sb = b % 1024, swz = sb ^ (((sb >> 9) & 1) << 5); R = (st >> 1) * 16 + swz / 64; C = (st & 1) * 32 + (swz % 64) / 2; }
__host__ __device__ __forceinline__ int perm32(int rho) { const int n = rho >> 4, i = rho & 15; return 8 * (i >> 2) + 4 * n + (i & 3); }

struct Unit { int pm, pn; };
struct Gemm { const bf16_t* A; const bf16_t* Bt; int M, N, K; };

struct StaticOrder {
    int nM, nN, nwg, G, c;
    __host__ __device__ void init(int M, int N, int G_, int c_) { nM = M / BM; nN = N / BM; nwg = nM * nN; G = G_; c = c_; }
    __host__ __device__ bool next(int i, Unit& u) const {
        const long L = (long)i * G + c; if (L >= nwg) return false;
        int wgid = (int)L; { const int q = nwg / NXCD, r = nwg % NXCD, xcd = wgid % NXCD, off = wgid / NXCD; wgid = (xcd < r ? xcd * (q + 1) : r * (q + 1) + (xcd - r) * q) + off; }
        const int nig = WGM * nN, gid = wgid / nig, fm = gid * WGM, gsz = (nM - fm) < WGM ? (nM - fm) : WGM;
        u.pm = fm + ((wgid % nig) % gsz); u.pn = (wgid % nig) / gsz; return true;
    }
    __device__ __forceinline__ void a_ready(const Unit&) const {}
    __device__ __forceinline__ void done(const Unit&) const {}
};

__device__ __forceinline__ unsigned cvt_pk_bf16(float lo, float hi) { unsigned r; asm volatile("v_cvt_pk_bf16_f32 %0, %1, %2" : "=v"(r) : "v"(lo), "v"(hi)); return r; }
typedef float f32x2 __attribute__((ext_vector_type(2)));
__device__ __forceinline__ f32x2 gelu_pk(f32x2 v) {
    const f32x2 av = __builtin_elementwise_abs(v), d = av * 0.2316418882f + 1.0f;
    f32x2 t; t.x = __builtin_amdgcn_rcpf(d.x); t.y = __builtin_amdgcn_rcpf(d.y);
    f32x2 q = t * 0.5307027145f + (-0.7265760135f); q = q * t + 0.7107068705f; q = q * t + (-0.142248368f); q = q * t + 0.127414796f; q = q * t;
    const f32x2 s = (v * v) * (-0.72134752044f);
    f32x2 e; e.x = __builtin_amdgcn_exp2f(s.x); e.y = __builtin_amdgcn_exp2f(s.y);
    const f32x2 m = v * (q * e), r = v - m;
    f32x2 o; o.x = v.x < 0.f ? m.x : r.x; o.y = v.y < 0.f ? m.y : r.y; return o;
}

template <int ACT  > struct EpiBf16 {
    static constexpr bool PERM = true, AFTER_DRAIN = false, PRE = false; static_assert(ACT == 0 || ACT == 1, "EpiBf16: ACT is 0 (none) or 1 (gelu_pk)");
    bf16_t* O; int ldc; const float* bias; int split_cols; size_t split_stride; float scale0;
    __device__ __forceinline__ void operator()(const f32x4 (&acc)[2][2][4][2], const Unit& u, int wr, int wc, int fr, int fq) const {
        const int row0 = u.pm * BM + wr * 64 + fr; int colt = u.pn * BM; bf16_t* base = O;
        float sc = 1.f; if (split_cols) { const int t = colt / split_cols; base += (size_t)t * split_stride; colt -= t * split_cols; if (t == 0) sc = scale0; }
        const int col0 = colt + wc * 32 + 8 * fq, bcol0 = u.pn * BM + wc * 32 + 8 * fq;
        f32x4 bv[2][2];
#pragma unroll
        for (int bj = 0; bj < 2; ++bj)
#pragma unroll
            for (int n = 0; n < 2; ++n) bv[bj][n] = bias ? *(const f32x4*)(bias + bcol0 + bj * HALF + 4 * n) : (f32x4){0.f, 0.f, 0.f, 0.f};
#pragma unroll
        for (int ai = 0; ai < 2; ++ai)
#pragma unroll
            for (int m = 0; m < 4; ++m) { bf16_t* rowp = base + (size_t)(row0 + ai * HALF + m * 16) * ldc + col0;
#pragma unroll
                for (int bj = 0; bj < 2; ++bj) { f32x4 v0 = acc[ai][bj][m][0] + bv[bj][0], v1 = acc[ai][bj][m][1] + bv[bj][1];
                    if (ACT == 1) { f32x2 a = gelu_pk((f32x2){v0[0], v0[1]}), b = gelu_pk((f32x2){v0[2], v0[3]}), c = gelu_pk((f32x2){v1[0], v1[1]}), d = gelu_pk((f32x2){v1[2], v1[3]});
                        v0 = (f32x4){a.x, a.y, b.x, b.y}; v1 = (f32x4){c.x, c.y, d.x, d.y}; }
                    v0 = v0 * sc; v1 = v1 * sc; u32x4 w; w.x = cvt_pk_bf16(v0[0], v0[1]); w.y = cvt_pk_bf16(v0[2], v0[3]); w.z = cvt_pk_bf16(v1[0], v1[1]); w.w = cvt_pk_bf16(v1[2], v1[3]);
                    *(u32x4*)(rowp + bj * HALF) = w; } }
    }
};
typedef unsigned u32x2e __attribute__((ext_vector_type(2)));
struct EpiProj {
    static constexpr bool PERM = true, AFTER_DRAIN = false, PRE = false;
    bf16_t* O; int ldc; int qt0, qt1; float qscale;
    __device__ __forceinline__ void operator()(const f32x4 (&acc)[2][2][4][2], const Unit& u, int wr, int wc, int fr, int fq) const {
        const int row0 = u.pm * BM + wr * 64 + fr; const int col0 = u.pn * BM + wc * 32 + 8 * fq;
        const float sc = (u.pn >= qt0 && u.pn < qt1) ? qscale : 1.f;
#pragma unroll
        for (int ai = 0; ai < 2; ++ai)
#pragma unroll
            for (int m = 0; m < 4; ++m) { bf16_t* rowp = O + (size_t)(row0 + ai * HALF + m * 16) * ldc + col0;
#pragma unroll
                for (int bj = 0; bj < 2; ++bj) { const f32x4 v0 = acc[ai][bj][m][0] * sc, v1 = acc[ai][bj][m][1] * sc;
                    u32x4 w; w.x = cvt_pk_bf16(v0[0], v0[1]); w.y = cvt_pk_bf16(v0[2], v0[3]); w.z = cvt_pk_bf16(v1[0], v1[1]); w.w = cvt_pk_bf16(v1[2], v1[3]);
                    *(u32x4*)(rowp + bj * HALF) = w; } }
    }
};
struct EpiResid {
    static constexpr bool PERM = false, AFTER_DRAIN = false, PRE = false;
    const float* base; bf16_t* hb; float* ssq; int ldc;
    __device__ __forceinline__ void operator()(const f32x4 (&acc)[2][2][4][2], const Unit& u, int wr, int wc, int fr, int fq) const {
        const int col0 = u.pn * BM + wc * 32 + 4 * fq;
#pragma unroll
        for (int ai = 0; ai < 2; ++ai)
#pragma unroll
            for (int m = 0; m < 4; ++m) { const int r = u.pm * BM + ai * HALF + wr * 64 + m * 16 + fr; const size_t off = (size_t)r * ldc + col0; float s = 0.f;
#pragma unroll
                for (int bj = 0; bj < 2; ++bj)
#pragma unroll
                    for (int n = 0; n < 2; ++n) { const f32x4 bs = *(const f32x4*)(base + off + bj * HALF + n * 16); const f32x4 o = bs + acc[ai][bj][m][n];
                        s += (o[0] * o[0] + o[1] * o[1]) + (o[2] * o[2] + o[3] * o[3]);
                        u32x2e w; w.x = cvt_pk_bf16(o[0], o[1]); w.y = cvt_pk_bf16(o[2], o[3]); *(u32x2e*)(hb + off + bj * HALF + n * 16) = w; }
                s += __shfl_xor(s, 16); s += __shfl_xor(s, 32);
                if (fq == 0) ssq[(size_t)r * 16 + u.pn * 4 + wc] = s;
                if (m & 1) asm volatile("" ::: "memory"); }
    }
};
struct EpiScaleRow {
    static constexpr bool PERM = true, AFTER_DRAIN = false, PRE = true;
    bf16_t* O; int ldc; const float* ssq; float eps;
    __device__ __forceinline__ void pre(const Unit& u, int wr, int fr, int fq, f32x4 (&pq)[8]) const {
        const int row0 = u.pm * BM + wr * 64 + fr;
#pragma unroll
        for (int m = 0; m < 4; ++m) pq[m] = *(const f32x4*)(ssq + (size_t)(row0 + m * 16) * 16 + 4 * fq);
    }
    __device__ __forceinline__ void operator()(const f32x4 (&acc)[2][2][4][2], const Unit& u, int wr, int wc, int fr, int fq, const f32x4 (&pq)[8]) const {
        const int row0 = u.pm * BM + wr * 64 + fr;
        f32x4 p2[4];
#pragma unroll
        for (int m = 0; m < 4; ++m) p2[m] = *(const f32x4*)(ssq + (size_t)(row0 + HALF + m * 16) * 16 + 4 * fq);
#pragma unroll
        for (int ai = 0; ai < 2; ++ai)
#pragma unroll
            for (int m = 0; m < 4; ++m) { const int r = row0 + ai * HALF + m * 16; const f32x4 t4 = ai ? p2[m] : pq[m]; float tot = (t4[0] + t4[1]) + (t4[2] + t4[3]);
                tot += __shfl_xor(tot, 16); tot += __shfl_xor(tot, 32);
                const float rs = 1.0f / sqrtf(tot * (1.0f / 1024.0f) + eps);
#pragma unroll
                for (int bj = 0; bj < 2; ++bj) { const f32x4 v0 = acc[ai][bj][m][0] * rs, v1 = acc[ai][bj][m][1] * rs;
                    u32x4 w; w.x = cvt_pk_bf16(v0[0], v0[1]); w.y = cvt_pk_bf16(v0[2], v0[3]); w.z = cvt_pk_bf16(v1[0], v1[1]); w.w = cvt_pk_bf16(v1[2], v1[3]);
                    const size_t blk = ((size_t)(r >> 5) * 16 + (u.pn * 2 + bj)) * 8 + (2 * wc + (fq >> 1));
                    *(u32x4*)(O + blk * 512 + ((fq & 1) * 32 + (r & 31)) * 8) = w; } }
    }
};

template <class Epi, class Sched, bool ALIGN_EPI = false, bool SP2 = false>
__device__ __forceinline__ void gemm_phase(PG8_LAS unsigned char* lds, const Gemm g, const Sched& S, const Epi& E) {
    const int tid = threadIdx.x, wid = __builtin_amdgcn_readfirstlane(tid >> 6), lane = tid & 63, wr = wid >> 2, wc = wid & 3, fr = lane & 15, fq = lane >> 4;
    const int K = g.K, nt = K / BK;
    unsigned voffA[2], voffB[2];
#pragma unroll
    for (int i = 0; i < 2; ++i) { int R, C; stage_rc(tid * 16 + i * 8192, R, C); const int Rb = Epi::PERM ? ((R & ~31) + perm32(R & 31)) : R;
        voffA[i] = (unsigned)(R * K + C) * 2u; voffB[i] = (unsigned)(Rb * K + C) * 2u; }
    const size_t kstep = (size_t)(BK * 2);
    const size_t hstep = (size_t)HALF * K * 2;
    const size_t tstep = 2 * hstep;
    const unsigned ldsw = (unsigned)wid * 1024u;
    const int aoff = lds_byte(wr * 64 + fr, fq * 8), boff = lds_byte(wc * 32 + fr, fq * 8);
#define PG8_SA(b, h) (((b) * 2 + (h)) * HTB)
#define PG8_SB(b, h) ((4 + (b) * 2 + (h)) * HTB)
#define PG8_STAGE(bufoff, gbase, voff) do { _Pragma("unroll") for (int _i = 0; _i < 2; ++_i) \
        __builtin_amdgcn_global_load_lds((const unsigned*)((const char*)(gbase) + (voff)[_i]), (PG8_LAS unsigned*)(lds + (bufoff) + ldsw + _i * 8192), 16, 0, 0); } while (0)
#define PG8_LDA(dst, b, h) do { _Pragma("unroll") for (int m = 0; m < 4; ++m) _Pragma("unroll") for (int k = 0; k < 2; ++k) dst[m][k] = *(const PG8_LAS bf16x8*)(lds + PG8_SA(b, h) + aoff + m * 2048 + k * 1024); } while (0)
#define PG8_LDB(dst, b, h) do { _Pragma("unroll") for (int n = 0; n < 2; ++n) _Pragma("unroll") for (int k = 0; k < 2; ++k) dst[n][k] = *(const PG8_LAS bf16x8*)(lds + PG8_SB(b, h) + boff + n * 2048 + k * 1024); } while (0)
#define PG8_MMA(ai, bj, At, Bt) do { __builtin_amdgcn_s_setprio(1); _Pragma("unroll") for (int m = 0; m < 4; ++m) _Pragma("unroll") for (int n = 0; n < 2; ++n) _Pragma("unroll") for (int k = 0; k < 2; ++k) \
        acc[ai][bj][m][n] = __builtin_amdgcn_mfma_f32_16x16x32_bf16(Bt[n][k], At[m][k], acc[ai][bj][m][n], 0, 0, 0); __builtin_amdgcn_s_setprio(0); } while (0)
#define PG8_WAIT_V(n) asm volatile("s_waitcnt vmcnt(" #n ")" ::: "memory")
#define PG8_WAIT_L(n) asm volatile("s_waitcnt lgkmcnt(" #n ")" ::: "memory")
#define PG8_BAR __builtin_amdgcn_s_barrier()
#define PG8_SCHED __builtin_amdgcn_sched_barrier(0)
    Unit cur, nxt; int ui = 0;
    if (!S.next(0, cur)) return;
    f32x4 acc[2][2][4][2];
#pragma unroll
    for (int a = 0; a < 2; ++a)
#pragma unroll
        for (int b = 0; b < 2; ++b)
#pragma unroll
            for (int m = 0; m < 4; ++m)
#pragma unroll
                for (int n = 0; n < 2; ++n) acc[a][b][m][n] = (f32x4){0.f, 0.f, 0.f, 0.f};
    bf16x8 At[4][2], B0[2][2], B1[2][2];
    const char* cA = (const char*)g.A + (size_t)cur.pm * tstep; const char* cB = (const char*)g.Bt + (size_t)cur.pn * tstep;
    S.a_ready(cur);
    if constexpr (SP2) {
        PG8_STAGE(PG8_SB(0, 0), cB, voffB); PG8_STAGE(PG8_SB(0, 1), cB + hstep, voffB); PG8_STAGE(PG8_SA(0, 0), cA, voffA); PG8_STAGE(PG8_SA(0, 1), cA + hstep, voffA);
        if (wr == 1) PG8_BAR;
        PG8_WAIT_V(2); PG8_BAR;
        PG8_STAGE(PG8_SB(1, 0), cB + kstep, voffB); PG8_STAGE(PG8_SA(1, 0), cA + kstep, voffA); PG8_STAGE(PG8_SB(1, 1), cB + hstep + kstep, voffB);
        PG8_WAIT_V(6); PG8_BAR;
    } else {
        PG8_STAGE(PG8_SB(0, 0), cB, voffB); PG8_STAGE(PG8_SA(0, 0), cA, voffA); PG8_STAGE(PG8_SB(0, 1), cB + hstep, voffB); PG8_STAGE(PG8_SA(0, 1), cA + hstep, voffA);
        if (wr == 1) PG8_BAR;
        PG8_WAIT_V(4); PG8_BAR;
        PG8_STAGE(PG8_SB(1, 0), cB + kstep, voffB); PG8_STAGE(PG8_SA(1, 0), cA + kstep, voffA); PG8_STAGE(PG8_SB(1, 1), cB + hstep + kstep, voffB);
        PG8_WAIT_V(6); PG8_BAR;
    }
    for (;;) {
        const bool has_next = S.next(ui + 1, nxt);
        const char* nA = has_next ? (const char*)g.A + (size_t)nxt.pm * tstep : cA; const char* nB = has_next ? (const char*)g.Bt + (size_t)nxt.pn * tstep : cB;
        f32x4 epre[8]; if constexpr (Epi::PRE) E.pre(cur, wr, fr, fq, epre);
        for (int t = 0; t < nt; t += 2) {
            const bool last = (t == nt - 2);
            const char* a1 = cA + (size_t)(t + 1) * kstep;
            const char* a2 = last ? nA : cA + (size_t)(t + 2) * kstep; const char* b2 = last ? nB : cB + (size_t)(t + 2) * kstep;
            const char* a3 = a2 + kstep; const char* b3 = b2 + kstep;
            if (last && has_next) S.a_ready(nxt);
            if constexpr (SP2) {
            PG8_LDB(B0, 0, 0); PG8_LDB(B1, 0, 1); PG8_SCHED; PG8_LDA(At, 0, 0); PG8_STAGE(PG8_SA(1, 1), a1 + hstep, voffA);
            PG8_WAIT_V(8); PG8_WAIT_L(0); PG8_BAR; PG8_MMA(0, 0, At, B0); PG8_MMA(0, 1, At, B1); PG8_BAR; PG8_SCHED;
            PG8_LDA(At, 0, 1); PG8_STAGE(PG8_SB(0, 0), b2, voffB); PG8_STAGE(PG8_SB(0, 1), b2 + hstep, voffB); PG8_STAGE(PG8_SA(0, 0), a2, voffA);
            PG8_WAIT_V(8); PG8_WAIT_L(0); PG8_BAR; PG8_MMA(1, 0, At, B0); PG8_MMA(1, 1, At, B1); PG8_BAR; PG8_SCHED;
            PG8_LDB(B0, 1, 0); PG8_LDB(B1, 1, 1); PG8_SCHED; PG8_LDA(At, 1, 0); PG8_STAGE(PG8_SA(0, 1), a2 + hstep, voffA);
            PG8_WAIT_V(8); PG8_WAIT_L(0); PG8_BAR; PG8_MMA(0, 0, At, B0); PG8_MMA(0, 1, At, B1); PG8_BAR; PG8_SCHED;
            PG8_LDA(At, 1, 1); PG8_STAGE(PG8_SB(1, 0), b3, voffB); PG8_STAGE(PG8_SB(1, 1), b3 + hstep, voffB); PG8_STAGE(PG8_SA(1, 0), a3, voffA);
            PG8_WAIT_V(8); PG8_WAIT_L(0); PG8_BAR; PG8_MMA(1, 0, At, B0); PG8_MMA(1, 1, At, B1); PG8_BAR; PG8_SCHED;
            } else {
            PG8_LDB(B0, 0, 0); PG8_SCHED; PG8_LDA(At, 0, 0); PG8_STAGE(PG8_SA(1, 1), a1 + hstep, voffA);
            PG8_WAIT_L(8); PG8_BAR; PG8_WAIT_L(0); PG8_MMA(0, 0, At, B0); PG8_BAR; PG8_SCHED;
            PG8_LDB(B1, 0, 1); PG8_STAGE(PG8_SB(0, 0), b2, voffB);
            PG8_BAR; PG8_WAIT_L(0); PG8_MMA(0, 1, At, B1); PG8_BAR;
            PG8_LDA(At, 0, 1); PG8_STAGE(PG8_SA(0, 0), a2, voffA);
            PG8_BAR; PG8_WAIT_L(0); PG8_MMA(1, 0, At, B0); PG8_BAR; PG8_SCHED;
            PG8_STAGE(PG8_SB(0, 1), b2 + hstep, voffB);
            PG8_WAIT_V(6); PG8_BAR; PG8_MMA(1, 1, At, B1); PG8_BAR;
            PG8_LDB(B0, 1, 0); PG8_SCHED; PG8_LDA(At, 1, 0); PG8_STAGE(PG8_SA(0, 1), a2 + hstep, voffA);
            PG8_WAIT_L(8); PG8_BAR; PG8_WAIT_L(0); PG8_MMA(0, 0, At, B0); PG8_BAR; PG8_SCHED;
            PG8_LDB(B1, 1, 1); PG8_STAGE(PG8_SB(1, 0), b3, voffB);
            PG8_BAR; PG8_WAIT_L(0); PG8_MMA(0, 1, At, B1); PG8_BAR;
            PG8_LDA(At, 1, 1); PG8_STAGE(PG8_SA(1, 0), a3, voffA);
            PG8_BAR; PG8_WAIT_L(0); PG8_MMA(1, 0, At, B0); PG8_BAR; PG8_SCHED;
            PG8_STAGE(PG8_SB(1, 1), b3 + hstep, voffB);
            PG8_WAIT_V(6); PG8_BAR; PG8_MMA(1, 1, At, B1); PG8_BAR;
            }
        }
        if constexpr (ALIGN_EPI) { if (wr == 0) PG8_BAR; }
        if constexpr (!Epi::AFTER_DRAIN) { if constexpr (Epi::PRE) E(acc, cur, wr, wc, fr, fq, epre); else E(acc, cur, wr, wc, fr, fq); S.done(cur); }
        if (!has_next) break;
#pragma unroll
        for (int a = 0; a < 2; ++a)
#pragma unroll
            for (int b = 0; b < 2; ++b)
#pragma unroll
                for (int m = 0; m < 4; ++m)
#pragma unroll
                    for (int n = 0; n < 2; ++n) acc[a][b][m][n] = (f32x4){0.f, 0.f, 0.f, 0.f};
        cur = nxt; cA = nA; cB = nB; ++ui;
        if constexpr (ALIGN_EPI) { if (wr == 1) PG8_BAR; }
    }
    PG8_WAIT_V(0);
    if constexpr (!ALIGN_EPI) { if (wr == 0) PG8_BAR; }
    PG8_BAR;
    if constexpr (Epi::AFTER_DRAIN) { E.fused(acc, cur, wr, wc, fr, fq, lds, wid, lane); S.done(cur); }
#undef PG8_SA
#undef PG8_SB
#undef PG8_STAGE
#undef PG8_LDA
#undef PG8_LDB
#undef PG8_MMA
#undef PG8_WAIT_V
#undef PG8_WAIT_L
#undef PG8_BAR
#undef PG8_SCHED
}
}
#define GAS __attribute__((address_space(1)))
#define LAS __attribute__((address_space(3)))
typedef unsigned short bf16;
typedef unsigned v4u __attribute__((ext_vector_type(4)));
typedef unsigned v2u __attribute__((ext_vector_type(2)));
typedef float f32x4 __attribute__((ext_vector_type(4)));
typedef float f32x16 __attribute__((ext_vector_type(16)));
typedef float f32x2 __attribute__((ext_vector_type(2)));
typedef short bf16x8 __attribute__((ext_vector_type(8)));
typedef short s16x4 __attribute__((ext_vector_type(4)));
typedef __bf16 bf16x2v __attribute__((ext_vector_type(2)));
typedef GAS unsigned gu32;
typedef GAS unsigned long long gu64;
#define RLX_AGENT __ATOMIC_RELAXED, __HIP_MEMORY_SCOPE_AGENT
#define LDS_WAIT() asm volatile("s_waitcnt lgkmcnt(0)" ::: "memory")
#define VM_WAIT() asm volatile("s_waitcnt vmcnt(0)" ::: "memory")
__device__ __forceinline__ unsigned f2bf(float f) { unsigned u = __builtin_bit_cast(unsigned, f); return (u + 0x7fffu + ((u >> 16) & 1u)) >> 16; }
__device__ __forceinline__ unsigned pk2(float lo, float hi) { return f2bf(lo) | (f2bf(hi) << 16); }
__device__ __forceinline__ float bf2f(unsigned short b) { return __builtin_bit_cast(float, (unsigned)b << 16); }
__device__ __forceinline__ float bflo(unsigned w) { return __builtin_bit_cast(float, w << 16); }
__device__ __forceinline__ float bfhi(unsigned w) { return __builtin_bit_cast(float, w & 0xffff0000u); }
__device__ __forceinline__ float wave_sum(float v) {
#pragma unroll
    for (int o = 1; o < 64; o <<= 1) v += __shfl_xor(v, o);
    return v;
}
__device__ __forceinline__ float wave_max(float v) {
#pragma unroll
    for (int o = 1; o < 64; o <<= 1) v = fmaxf(v, __shfl_xor(v, o));
    return v;
}
__device__ __forceinline__ float gelu_tanh(float x) {
    const float u = 0.7978845608028654f * (x + 0.044715f * x * x * x);
    const float e = __expf(2.f * u);
    const float th = 1.f - 2.f / (e + 1.f);
    return 0.5f * x * (1.f + th);
}

#define XB_TMO      128
#define XB_XCNT(j)  (256  + 64 * (j))
#define XB_XSUB(j)  (1280 + 64 * (j))
#define XB_XGEN(j)  (2304 + 64 * (j))
#define XB_TOP      3328
#define XB_TOPGEN   3392
#define XCD_BAR_WORDS 3456
#define XB_SPIN_CAP (1u << 18)

__device__ __forceinline__ unsigned xb_ld(unsigned* p)              { return __hip_atomic_load(p, __ATOMIC_RELAXED, __HIP_MEMORY_SCOPE_AGENT); }
__device__ __forceinline__ unsigned xb_add(unsigned* p, unsigned v) { return __hip_atomic_fetch_add(p, v, __ATOMIC_RELAXED, __HIP_MEMORY_SCOPE_AGENT); }
__device__ __forceinline__ unsigned xb_xcc_id() { return (unsigned)__builtin_amdgcn_s_getreg((3 << 11) | 20) & 0xFu; }
#define XB_SPIN(cond, bar) do { unsigned _sp = 0; while (cond) { __builtin_amdgcn_s_sleep(1); \
    if ((++_sp & 255u) == 0u) { if (xb_ld(&(bar)[XB_TMO])) break; if (_sp > XB_SPIN_CAP) { atomicAdd(&(bar)[XB_TMO], 1u); break; } } } } while (0)

struct XcdBarrier {
    unsigned* bar; unsigned x;
    volatile LAS unsigned* st;
};

__device__ __forceinline__ XcdBarrier xcd_barrier_post(unsigned* bar, volatile LAS unsigned* st) {
    XcdBarrier b; b.bar = bar; b.x = xb_xcc_id(); b.st = st;
    if (threadIdx.x == 0) (void)xb_add(&bar[XB_XCNT(b.x)], 1u);
    return b;
}
__device__ __forceinline__ void xcd_barrier_complete(unsigned* bar, unsigned x, unsigned& nloc, unsigned& nx) {
    const unsigned G = gridDim.x * gridDim.y * gridDim.z;
    unsigned sum, cnt, mine, sp = 0u;
    for (;;) {
        sum = 0u; cnt = 0u; mine = 0u;
#pragma unroll
        for (unsigned j = 0; j < 16; ++j) { const unsigned c = xb_ld(&bar[XB_XCNT(j)]); sum += c; cnt += (c > 0u) ? 1u : 0u; mine = (j == x) ? c : mine; }
        if (sum == G) break;
        __builtin_amdgcn_s_sleep(1);
        if ((++sp & 255u) == 0u) { if (xb_ld(&bar[XB_TMO])) break; if (sp > XB_SPIN_CAP) { atomicAdd(&bar[XB_TMO], 1u); break; } }
    }
    nloc = mine > 0u ? mine : 1u; nx = cnt > 0u ? cnt : 1u;
}

__device__ __forceinline__ void xcd_barrier(const XcdBarrier& b) {
    asm volatile("s_waitcnt vmcnt(0)" ::: "memory");
    __syncthreads();
    if (threadIdx.x == 0) {
        unsigned* bar = b.bar;
        __builtin_amdgcn_s_waitcnt(0);
        unsigned nloc = b.st[0], nx = b.st[1];
        if (nloc == 0u) { xcd_barrier_complete(bar, b.x, nloc, nx); b.st[0] = nloc; b.st[1] = nx; }
        const unsigned old = xb_add(&bar[XB_XSUB(b.x)], 1u);
        const unsigned gen = old / nloc;
        if (old + 1u == (gen + 1u) * nloc) {
            __builtin_amdgcn_fence(__ATOMIC_RELEASE, "agent");
            asm volatile("s_waitcnt vmcnt(0)" ::: "memory");
            const unsigned og = xb_add(&bar[XB_TOP], 1u);
            const unsigned tg = og / nx;
            if (og + 1u == (tg + 1u) * nx) xb_add(&bar[XB_TOPGEN], 1u);
            else XB_SPIN(xb_ld(&bar[XB_TOPGEN]) == tg, bar);
            __builtin_amdgcn_fence(__ATOMIC_ACQUIRE, "agent");
            xb_add(&bar[XB_XGEN(b.x)], 1u);
            asm volatile("s_waitcnt vmcnt(0)" ::: "memory");
        } else {
            XB_SPIN(xb_ld(&bar[XB_XGEN(b.x)]) == gen, bar);
            __builtin_amdgcn_fence(__ATOMIC_ACQUIRE, "agent");
            asm volatile("s_waitcnt vmcnt(0)" ::: "memory");
        }
    }
    __syncthreads();
}
constexpr int NWAVES = 8;
constexpr int BATCH = 8, SEQ = 4096, TT = BATCH * SEQ, DM = 1024;
constexpr int NPROJ = 3072, IN_COLS = 2840;
constexpr int C_H = 0, C_B = 512, C_C = 1024, C_Q = 1536, C_KC = 2048, C_VC = 2176, C_KS = 2304, C_VS = 2432, C_KW = 2560, C_VW = 2688, C_G = 2816;
constexpr int NQP = 2048;
constexpr float RMS_EPS = 1e-6f;
constexpr float QSCALE = 0.125f * 1.4426950408889634f;
constexpr size_t MiB = 1u << 20;
constexpr size_t WS_CTL = 0, CTL_ZERO_BYTES = 32768;
constexpr size_t WS_WIN = 2 * MiB, WS_WOUT = 8 * MiB, WS_WQ = 10 * MiB, WS_KW1 = 14 * MiB, WS_VW1 = 15 * MiB, WS_KW2 = 16 * MiB, WS_VW2 = 16 * MiB + 65536, WS_B1 = 16 * MiB + 131072, WS_SUBK = 17 * MiB;
constexpr size_t WS_U = 32 * MiB, WS_V = 48 * MiB;
constexpr float QSTEP = 0.3352f;
constexpr float USCALE = 32.f / QSTEP, VSCALE = 4.f;
constexpr int NSL = 4;
constexpr size_t WS_XN = 96 * MiB;
constexpr size_t WS_PROJ = 160 * MiB;
constexpr size_t WS_MIXA = 352 * MiB;
constexpr size_t WS_KCC = 416 * MiB, WS_VCC = 417 * MiB;
constexpr size_t WS_SSQ = 418 * MiB;
constexpr size_t WS_EXPG = 64 * MiB, WS_AG = 80 * MiB, WS_DGP = 288 * MiB, WS_SSQF = 420 * MiB;
constexpr size_t WS_END = 421 * MiB;
constexpr int CW_BAR = 4096;
constexpr int RING_OFF = 0, RING_BYTES = 131072;
constexpr int LDSCTL_OFF = RING_BYTES, MISC_OFF = LDSCTL_OFF + 320;
constexpr int LDS_BYTES = 155648;

struct Args { const float* in[19]; float* out; unsigned char* ws; int ph_lo, ph_hi; };
struct Frame {
    LAS unsigned char* lds;
    volatile LAS unsigned* MISC;
    gu32* ctl;
    int tid, lane, wave;
    int vcu, G;
    const Args* a;
};
#define FIN(k) (F.a->in[k])
#define FWS(T, off) ((T*)(F.a->ws + (off)))
#define F_x FIN(0)
#define F_ln1 FIN(1)
#define F_w_in FIN(2)
#define F_conv_w FIN(3)
#define F_pos_k FIN(4)
#define F_pos_v FIN(5)
#define F_k_w1 FIN(6)
#define F_k_w2 FIN(7)
#define F_v_w1 FIN(8)
#define F_v_w2 FIN(9)
#define F_gn_conv FIN(10)
#define F_gn_attn FIN(11)
#define F_w_out FIN(12)
#define F_ln2 FIN(13)
#define F_wq FIN(14)
#define F_subkeys FIN(15)
#define F_pu FIN(16)
#define F_pv FIN(17)
#define F_lnf FIN(18)
#define F_out (F.a->out)
#define F_WinT FWS(bf16, WS_WIN)
#define F_WoutT FWS(bf16, WS_WOUT)
#define F_WqT FWS(bf16, WS_WQ)
#define F_KW1T FWS(bf16, WS_KW1)
#define F_VW1T FWS(bf16, WS_VW1)
#define F_KW2T FWS(bf16, WS_KW2)
#define F_VW2T FWS(bf16, WS_VW2)
#define F_SUBK FWS(bf16, WS_SUBK)
#define F_U FWS(unsigned char, WS_U)
#define F_V FWS(unsigned char, WS_V)
#define F_XN FWS(bf16, WS_XN)
#define F_PROJ FWS(bf16, WS_PROJ)
#define F_MIXA FWS(bf16, WS_MIXA)
#define F_KCC FWS(bf16, WS_KCC)
#define F_VCC FWS(bf16, WS_VCC)
#define F_B1 FWS(float, WS_B1)
#define F_SSQ FWS(float, WS_SSQ)

__device__ __forceinline__ void p0_transpose_item(const float* W, int K, int N, bf16* WT, const float* kscale, LAS float* scr, int item, int nblk, int lane, bool frag = false) {
    const int kb = item / nblk, nb = item % nblk, k0 = 64 * kb, n0 = 32 * nb;
#pragma unroll
    for (int i = 0; i < 32; ++i) { const int kk = 2 * i + (lane >> 5); const int n = n0 + (lane & 31); float v = (n < N) ? W[(size_t)(k0 + kk) * N + n] : 0.f; if (kscale) v *= kscale[k0 + kk]; scr[kk * 33 + (lane & 31)] = v; }
    LDS_WAIT(); asm volatile("" ::: "memory");
    const int c = lane & 7;
#pragma unroll
    for (int j = 0; j < 4; ++j) { const int n = (lane >> 3) + 8 * j; const LAS float* s = scr + (8 * c) * 33 + n;
        v4u o; o.x = pk2(s[0 * 33], s[1 * 33]); o.y = pk2(s[2 * 33], s[3 * 33]); o.z = pk2(s[4 * 33], s[5 * 33]); o.w = pk2(s[6 * 33], s[7 * 33]);
        const int na = n0 + n, ka = k0 + 8 * c;
        const size_t off = frag ? ((size_t)((na >> 4) * 64 + (ka >> 5)) * 64 + (((ka >> 3) & 3) * 16 + (na & 15))) * 8 : (size_t)na * K + ka;
        *(GAS v4u*)(WT + off) = o; }
    LDS_WAIT(); asm volatile("" ::: "memory");
}
__device__ __forceinline__ void p0_cvt_item(const float* src, bf16* dst, const float* cscale, size_t item, int lane) {
    const size_t idx = item * 512 + (size_t)lane * 8;
    f32x4 a = *(const GAS f32x4*)(src + idx), b = *(const GAS f32x4*)(src + idx + 4);
    if (cscale) { const int d = (int)(idx & 1023); const f32x4 sa = *(const GAS f32x4*)(cscale + d), sb = *(const GAS f32x4*)(cscale + d + 4); a = a * sa; b = b * sb; }
    v4u o; o.x = pk2(a[0], a[1]); o.y = pk2(a[2], a[3]); o.z = pk2(b[0], b[1]); o.w = pk2(b[2], b[3]);
    *(GAS v4u*)(dst + idx) = o;
}
__device__ __forceinline__ void p0_cvt4_load(const float* src, size_t item0, int lane, f32x4 (&a)[4], f32x4 (&b)[4]) {
#pragma unroll
    for (int u = 0; u < 4; ++u) { const size_t idx = (item0 + u) * 512 + (size_t)lane * 8; a[u] = *(const GAS f32x4*)(src + idx); b[u] = *(const GAS f32x4*)(src + idx + 4); }
}
__device__ __forceinline__ void p0_cvt4_conv(const f32x4 (&a)[4], const f32x4 (&b)[4], unsigned char* dst, const float* cscale, float scale, bool as_int4, size_t item0, int lane) {
#pragma unroll
    for (int u = 0; u < 4; ++u) {
        const size_t idx = (item0 + u) * 512 + (size_t)lane * 8; const int col = (int)(idx & 1023);
        f32x4 x = a[u] * scale, y = b[u] * scale;
        if (cscale) { const f32x4 sa = *(const GAS f32x4*)(cscale + col), sb = *(const GAS f32x4*)(cscale + col + 4); x = x * sa; y = y * sb; }
        unsigned w = 0u;
        if (as_int4) {
#pragma unroll
            for (int e4 = 0; e4 < 4; ++e4) { const int qa = (int)__builtin_rintf(__builtin_fminf(__builtin_fmaxf(x[e4], -8.f), 7.f)), qb = (int)__builtin_rintf(__builtin_fminf(__builtin_fmaxf(y[e4], -8.f), 7.f));
                w |= ((unsigned)qa & 15u) << (4 * e4); w |= ((unsigned)qb & 15u) << (16 + 4 * e4); }
        } else {
        w = __builtin_amdgcn_cvt_scalef32_pk_fp4_f32(w, x[0], x[1], 1.0f, 0); w = __builtin_amdgcn_cvt_scalef32_pk_fp4_f32(w, x[2], x[3], 1.0f, 1);
        w = __builtin_amdgcn_cvt_scalef32_pk_fp4_f32(w, y[0], y[1], 1.0f, 2); w = __builtin_amdgcn_cvt_scalef32_pk_fp4_f32(w, y[2], y[3], 1.0f, 3);
        }
        const size_t e = idx >> 10; const int q = col >> 6, dc = (col >> 3) & 7;
        *(GAS unsigned*)(dst + e * 512 + 128 * (q >> 2) + 16 * dc + 4 * (q & 3)) = w;
    }
}
__device__ __forceinline__ void rms_row_load(const float* xrow, int lane, f32x4 (&v)[4]) {
    const GAS f32x4* xr = (const GAS f32x4*)xrow + lane;
#pragma unroll
    for (int j = 0; j < 4; ++j) v[j] = xr[64 * j];
}
__device__ __forceinline__ void rms_row_finish(const f32x4 (&v)[4], const f32x4 (&g)[4], bf16* orow, int lane) {
    float s = 0.f;
#pragma unroll
    for (int j = 0; j < 4; ++j) s += (v[j].x * v[j].x + v[j].y * v[j].y) + (v[j].z * v[j].z + v[j].w * v[j].w);
    const float rstd = 1.f / sqrtf(wave_sum(s) * (1.f / DM) + RMS_EPS);
    GAS v2u* o8 = (GAS v2u*)orow + lane;
#pragma unroll
    for (int j = 0; j < 4; ++j) { v2u w; w.x = pk2(v[j].x * rstd * g[j].x, v[j].y * rstd * g[j].y); w.y = pk2(v[j].z * rstd * g[j].z, v[j].w * rstd * g[j].w); o8[64 * j] = w; }
}
__device__ __forceinline__ void p0_prologue(Frame& F) {
    LAS float* scr = (LAS float*)(F.lds + RING_OFF + F.wave * 16384);
    const int gw = F.vcu * NWAVES + F.wave, NGW = F.G * NWAVES, lane = F.lane;
    constexpr int I_IN = 16 * 96, I_OUT = 16 * 32, I_Q = 16 * 64, I_W1 = 32 * 8, I_W2 = 4 * 2;
    constexpr int NTR = I_IN + I_OUT + I_Q + 2 * I_W1 + 2 * I_W2;
    for (int it = gw; it < NTR; it += NGW) {
        int r = it;
        if (r < I_IN) { p0_transpose_item(F_w_in, 1024, IN_COLS, F_WinT, nullptr, scr, r, 96, lane); continue; } r -= I_IN;
        if (r < I_OUT) { p0_transpose_item(F_w_out, 1024, 1024, F_WoutT, nullptr, scr, r, 32, lane); continue; } r -= I_OUT;
        if (r < I_Q) { p0_transpose_item(F_wq, 1024, NQP, F_WqT, F_ln2, scr, r, 64, lane); continue; } r -= I_Q;
        if (r < I_W1) { p0_transpose_item(F_k_w1, 2048, 256, F_KW1T, nullptr, scr, r, 8, lane, true); continue; } r -= I_W1;
        if (r < I_W1) { p0_transpose_item(F_v_w1, 2048, 256, F_VW1T, nullptr, scr, r, 8, lane, true); continue; } r -= I_W1;
        if (r < I_W2) { p0_transpose_item(F_k_w2, 256, 64, F_KW2T, nullptr, scr, r, 2, lane); continue; } r -= I_W2;
        p0_transpose_item(F_v_w2, 256, 64, F_VW2T, nullptr, scr, r, 2, lane);
    }
    for (int it = (gw + 512) % NGW; it < 512; it += NGW) { const int mat = it >> 8, j = it & 255; const float* pos = mat ? F_pos_v : F_pos_k; const float* w1 = mat ? F_v_w1 : F_k_w1;
        float a = 0.f; for (int i = lane; i < 2048; i += 64) a += pos[i] * w1[(size_t)i * 256 + j];
        a = wave_sum(a); if (lane == 0) F_B1[it] = a; }
    for (int it = gw; it < 512; it += NGW) { const int s8 = it & 7, kt = (it >> 3) & 3, hc = it >> 5, hi = lane >> 5, r32 = lane & 31; const int key = 16 * kt + (r32 & 3) + 4 * (r32 >> 3) + 64 * ((r32 >> 2) & 1);
        const float* src = F_subkeys + ((size_t)(hc * 128 + key) * 128 + 16 * s8 + 8 * hi); const f32x4 a = *(const GAS f32x4*)src, b = *(const GAS f32x4*)(src + 4);
        v4u o; o.x = pk2(a[0], a[1]); o.y = pk2(a[2], a[3]); o.z = pk2(b[0], b[1]); o.w = pk2(b[2], b[3]); *(GAS v4u*)(F_SUBK + (size_t)it * 512 + lane * 8) = o; }
    {
        f32x4 ua0[4], ub0[4], va0[4], vb0[4], ua1[4], ub1[4], va1[4], vb1[4];
        int it = gw;
        if (it < 8192) { p0_cvt4_load(F_pu, (size_t)it * 4, lane, ua0, ub0); p0_cvt4_load(F_pv, (size_t)it * 4, lane, va0, vb0); }
        for (; it < 8192; it += 2 * NGW) {
            const int i1 = it + NGW, i2 = it + 2 * NGW;
            if (i1 < 8192) { p0_cvt4_load(F_pu, (size_t)i1 * 4, lane, ua1, ub1); p0_cvt4_load(F_pv, (size_t)i1 * 4, lane, va1, vb1); }
            p0_cvt4_conv(ua0, ub0, F_U, F_ln2, USCALE, true, (size_t)it * 4, lane); p0_cvt4_conv(va0, vb0, F_V, nullptr, VSCALE, false, (size_t)it * 4, lane);
            if (i1 < 8192) {
                if (i2 < 8192) { p0_cvt4_load(F_pu, (size_t)i2 * 4, lane, ua0, ub0); p0_cvt4_load(F_pv, (size_t)i2 * 4, lane, va0, vb0); }
                p0_cvt4_conv(ua1, ub1, F_U, F_ln2, USCALE, true, (size_t)i1 * 4, lane); p0_cvt4_conv(va1, vb1, F_V, nullptr, VSCALE, false, (size_t)i1 * 4, lane);
            }
        }
    }
    {
        f32x4 g[4];
#pragma unroll
        for (int j = 0; j < 4; ++j) g[j] = ((const GAS f32x4*)F_ln1)[lane + 64 * j];
        f32x4 xa0[4], xb0[4], xa1[4], xb1[4];
        int m = gw;
        if (m < TT) rms_row_load(F_x + (size_t)m * DM, lane, xa0); if (m + NGW < TT) rms_row_load(F_x + (size_t)(m + NGW) * DM, lane, xb0);
        for (; m < TT; m += 4 * NGW) {
            const int m1 = m + NGW, m2 = m + 2 * NGW, m3 = m + 3 * NGW, m4 = m + 4 * NGW, m5 = m + 5 * NGW;
            if (m2 < TT) rms_row_load(F_x + (size_t)m2 * DM, lane, xa1); if (m3 < TT) rms_row_load(F_x + (size_t)m3 * DM, lane, xb1);
            rms_row_finish(xa0, g, F_XN + (size_t)m * DM, lane); if (m1 < TT) rms_row_finish(xb0, g, F_XN + (size_t)m1 * DM, lane);
            if (m4 < TT) rms_row_load(F_x + (size_t)m4 * DM, lane, xa0); if (m5 < TT) rms_row_load(F_x + (size_t)m5 * DM, lane, xb0);
            if (m2 < TT) rms_row_finish(xa1, g, F_XN + (size_t)m2 * DM, lane); if (m3 < TT) rms_row_finish(xb1, g, F_XN + (size_t)m3 * DM, lane);
        }
    }
}

__device__ __forceinline__ void up8(const v4u w, float (&f)[8]) { f[0] = bflo(w.x); f[1] = bfhi(w.x); f[2] = bflo(w.y); f[3] = bfhi(w.y); f[4] = bflo(w.z); f[5] = bfhi(w.z); f[6] = bflo(w.w); f[7] = bfhi(w.w); }
struct P2Rows { v4u cc[4], ch[4], cb[4]; };
__device__ __forceinline__ void p2_conv_load(Frame& F, P2Rows& R, int bt0, int lane) {
#pragma unroll
    for (int j = 0; j < 4; ++j) { const bf16* pr = F_PROJ + (size_t)(bt0 + j) * NPROJ + 8 * lane; R.cc[j] = *(const GAS v4u*)(pr + C_C); R.ch[j] = *(const GAS v4u*)(pr + C_H); R.cb[j] = *(const GAS v4u*)(pr + C_B); }
}
__device__ __forceinline__ void p2_conv_four(Frame& F, const P2Rows& R, int bt0, int lane, float (&g1)[8], float (&g2)[8], const float (&w)[3][8], const float (&gn)[8]) {
#pragma unroll
    for (int j = 0; j < 4; ++j) {
        float cc[8], ch[8], cb[8], y[8]; up8(R.cc[j], cc); up8(R.ch[j], ch); up8(R.cb[j], cb);
        float ss = 0.f;
#pragma unroll
        for (int e = 0; e < 8; ++e) { const float g0 = cc[e] * ch[e]; y[e] = (w[0][e] * g2[e] + w[1][e] * g1[e] + w[2][e] * g0) * cb[e]; ss += y[e] * y[e]; g2[e] = g1[e]; g1[e] = g0; }
        const float rs = 1.f / sqrtf(wave_sum(ss) * (1.f / 512.f) + RMS_EPS);
        v4u o; o.x = pk2(y[0] * rs * gn[0], y[1] * rs * gn[1]); o.y = pk2(y[2] * rs * gn[2], y[3] * rs * gn[3]); o.z = pk2(y[4] * rs * gn[4], y[5] * rs * gn[5]); o.w = pk2(y[6] * rs * gn[6], y[7] * rs * gn[7]);
        *(GAS v4u*)(F_MIXA + (size_t)(bt0 + j) * 1024 + 8 * lane) = o;
    }
}
__device__ __forceinline__ void p2_conv_run(Frame& F, int run) {
    const int lane = F.lane; const int bt0 = 16 * run; const int t0 = bt0 & (SEQ - 1);
    P2Rows A, B;
    p2_conv_load(F, A, bt0, lane);
    float w[3][8], gn[8], g1[8], g2[8];
#pragma unroll
    for (int k = 0; k < 3; ++k) { const f32x4 w0 = *(const GAS f32x4*)(F_conv_w + k * 512 + 8 * lane), w1 = *(const GAS f32x4*)(F_conv_w + k * 512 + 8 * lane + 4);
#pragma unroll
        for (int e = 0; e < 4; ++e) { w[k][e] = w0[e]; w[k][4 + e] = w1[e]; } }
    { const f32x4 a0 = *(const GAS f32x4*)(F_gn_conv + 8 * lane), a1 = *(const GAS f32x4*)(F_gn_conv + 8 * lane + 4);
#pragma unroll
      for (int e = 0; e < 4; ++e) { gn[e] = a0[e]; gn[4 + e] = a1[e]; } }
#pragma unroll
    for (int e = 0; e < 8; ++e) { g1[e] = 0.f; g2[e] = 0.f; }
    if (t0 > 0) {
        const bf16* pr = F_PROJ + (size_t)(bt0 - 2) * NPROJ + 8 * lane; float c2[8], h2[8], c1[8], h1[8];
        up8(*(const GAS v4u*)(pr + C_C), c2); up8(*(const GAS v4u*)(pr + C_H), h2); up8(*(const GAS v4u*)(pr + NPROJ + C_C), c1); up8(*(const GAS v4u*)(pr + NPROJ + C_H), h1);
#pragma unroll
        for (int e = 0; e < 8; ++e) { g2[e] = c2[e] * h2[e]; g1[e] = c1[e] * h1[e]; }
    }
    p2_conv_load(F, B, bt0 + 4, lane);  p2_conv_four(F, A, bt0, lane, g1, g2, w, gn);
    p2_conv_load(F, A, bt0 + 8, lane);  p2_conv_four(F, B, bt0 + 4, lane, g1, g2, w, gn);
    p2_conv_load(F, B, bt0 + 12, lane); p2_conv_four(F, A, bt0 + 8, lane, g1, g2, w, gn);
    p2_conv_four(F, B, bt0 + 12, lane, g1, g2, w, gn);
}
__device__ __forceinline__ void p2_compress_unit(Frame& F, int u) {
    const int b = u >> 5, g = (u >> 4) & 1, nb = u & 15; const int tid = F.tid, lane = F.lane, w = F.wave;
    LAS unsigned char* AST = F.lds + RING_OFF;
    LAS unsigned char* HID = F.lds + RING_OFF + 36864;
    const int nrow = lane & 15, kq = lane >> 4;
    for (int mat = 0; mat < 2; ++mat) {
        const int col0 = (mat ? C_VC : C_KC) + g * 64; const bf16* W1T = mat ? F_VW1T : F_KW1T; const bf16* W2T = mat ? F_VW2T : F_KW2T; const float* B1 = F_B1 + mat * 256; bf16* OUT = mat ? F_VCC : F_KCC;
        for (int idx = tid; idx < 272 * 8; idx += NWAVES * 64) { const int pos = idx >> 3, ch = idx & 7; const int p = 256 * nb + pos;
            v4u v = (v4u){0u, 0u, 0u, 0u}; if (p < SEQ) v = *(const GAS v4u*)(F_PROJ + (size_t)(b * SEQ + p) * NPROJ + col0 + 8 * ch);
            *(LAS v4u*)(AST + pos * 128 + ch * 16) = v; }
        __syncthreads();
        f32x4 acc0 = (f32x4){0.f, 0.f, 0.f, 0.f}, acc1 = acc0;
        const bf16* b0p = W1T + (size_t)(2 * w) * 64 * 512 + lane * 8; const bf16* b1p = b0p + (size_t)64 * 512;
#define P2_LOADB(S0, S1, bb) do { _Pragma("unroll") for (int k8 = 0; k8 < 8; ++k8) { S0[k8] = *(const GAS bf16x8*)(b0p + 512 * (8 * (bb) + k8)); S1[k8] = *(const GAS bf16x8*)(b1p + 512 * (8 * (bb) + k8)); } } while (0)
#define P2_MMA(S0, S1, bb) do { _Pragma("unroll") for (int k8 = 0; k8 < 8; ++k8) { const int k0 = 32 * (8 * (bb) + k8) + 8 * kq; const int l = k0 >> 6, d = k0 & 63; \
            const bf16x8 a = *(const LAS bf16x8*)(AST + (16 * nrow + l) * 128 + d * 2); \
            acc0 = __builtin_amdgcn_mfma_f32_16x16x32_bf16(a, S0[k8], acc0, 0, 0, 0); acc1 = __builtin_amdgcn_mfma_f32_16x16x32_bf16(a, S1[k8], acc1, 0, 0, 0); } } while (0)
        { bf16x8 pa0[8], pa1[8], pb0[8], pb1[8];
          P2_LOADB(pa0, pa1, 0);
#pragma unroll 1
          for (int bb = 0; bb < 8; bb += 2) {
              P2_LOADB(pb0, pb1, bb + 1);
              P2_MMA(pa0, pa1, bb);
              if (bb + 2 < 8) P2_LOADB(pa0, pa1, bb + 2);
              P2_MMA(pb0, pb1, bb + 1);
          } }
#undef P2_LOADB
#undef P2_MMA
        { const int j0 = 32 * w + nrow, j1 = j0 + 16; const float bj0 = B1[j0], bj1 = B1[j1];
#pragma unroll
            for (int r = 0; r < 4; ++r) { const int n = 4 * kq + r;
                *(LAS unsigned short*)(HID + n * 528 + j0 * 2) = (unsigned short)f2bf(gelu_tanh(acc0[r] + bj0));
                *(LAS unsigned short*)(HID + n * 528 + j1 * 2) = (unsigned short)f2bf(gelu_tanh(acc1[r] + bj1)); } }
        __syncthreads();
        if (w < 4) { f32x4 acc = (f32x4){0.f, 0.f, 0.f, 0.f}; const bf16* bp = W2T + (size_t)(16 * w + nrow) * 256 + 8 * kq;
#pragma unroll
            for (int kk = 0; kk < 8; ++kk) { const bf16x8 a = *(const LAS bf16x8*)(HID + nrow * 528 + (32 * kk + 8 * kq) * 2); const bf16x8 bb = *(const GAS bf16x8*)(bp + 32 * kk);
                acc = __builtin_amdgcn_mfma_f32_16x16x32_bf16(a, bb, acc, 0, 0, 0); }
            const int d = 16 * w + nrow;
#pragma unroll
            for (int r = 0; r < 4; ++r) { const int n = 16 * nb + 4 * kq + r; OUT[((size_t)(b * 256 + n) * 2 + g) * 64 + d] = (bf16)f2bf(acc[r]); } }
        __syncthreads();
    }
}
__device__ __forceinline__ void p2_phase(Frame& F) {
    const int gw = F.vcu * NWAVES + F.wave, NGW = F.G * NWAVES;
    for (int u = F.vcu; u < 256; u += F.G) p2_compress_unit(F, u);
    for (int run = gw; run < TT / 16; run += NGW) p2_conv_run(F, run);
}

namespace att {
constexpr int KBUF = 0, VBUF = 16384, IMP_OFF = 32768  , OST_OFF = 57344, OST_ROW = 1040, SELM_OFF = 123904, ANYW_OFF = 124416, SSQ_OFF = 124480, LINV_OFF = 124736  ;
constexpr int GATE_OFF = RING_BYTES + 1024  , IMP3_OFF = GATE_OFF + 8192  ;
static_assert(OST_OFF + 64 * OST_ROW <= SELM_OFF && LINV_OFF + 1024 <= RING_BYTES && IMP3_OFF + 8192 <= LDS_BYTES, "attention LDS map");
__device__ __forceinline__ LAS _Float16* imp_plane(LAS unsigned char* L, int h) { return (LAS _Float16*)(L + (h < 3 ? IMP_OFF + h * 8192 : IMP3_OFF)); }
__device__ __forceinline__ int crow(int r, int hi) { return (r & 3) + 8 * (r >> 2) + 4 * hi; }
__device__ __forceinline__ float max3f(float a, float b, float c) { float r; asm("v_max3_f32 %0, %1, %2, %3" : "=v"(r) : "v"(a), "v"(b), "v"(c)); return r; }
__device__ __forceinline__ float max2f(float a, float b) { float r; asm("v_max_f32_e32 %0, %1, %2" : "=v"(r) : "v"(a), "v"(b)); return r; }
__device__ __forceinline__ float swapmax(float v) { auto rr = __builtin_amdgcn_permlane32_swap(__float_as_uint(v), __float_as_uint(v), false, false); return max2f(__uint_as_float(rr[0]), __uint_as_float(rr[1])); }
__device__ __forceinline__ float swapsum(float v) { auto rr = __builtin_amdgcn_permlane32_swap(__float_as_uint(v), __float_as_uint(v), false, false); return __uint_as_float(rr[0]) + __uint_as_float(rr[1]); }
__device__ __forceinline__ unsigned cvtpk(float lo, float hi) { typedef float f2 __attribute__((ext_vector_type(2))); f2 v = {lo, hi}; bf16x2v b = __builtin_convertvector(v, bf16x2v); return __builtin_bit_cast(unsigned, b); }
__device__ __forceinline__ s16x4 vtr(const LAS unsigned char* p) { typedef short v4i16_t __attribute__((ext_vector_type(4))); return __builtin_bit_cast(s16x4, __builtin_amdgcn_ds_read_tr16_b64_v4i16((LAS v4i16_t*)p)); }

struct Stg { v4u k, v; };
__device__ __forceinline__ void tile_load(Stg& s, const bf16* kbase, const bf16* vbase, int rs, int tid) {
    const unsigned ov = (unsigned)((tid >> 3) * rs + (tid & 7) * 8) * 2u, ok = ov;
    s.k = *(const GAS v4u*)((const GAS unsigned char*)kbase + ok);
    s.v = *(const GAS v4u*)((const GAS unsigned char*)vbase + ov);
}
__device__ __forceinline__ void tile_store(const Stg& s, LAS unsigned char* kbuf, LAS unsigned char* vbuf, int tid) {
    const int key = tid >> 3, c = tid & 7;
    *(LAS v4u*)(kbuf + c * 1024 + ((((key + c) & 7) | (key & ~7)) * 16)) = s.k;
    *(LAS v4u*)(vbuf + (c >> 2) * 4096 + (key >> 3) * 512 + (key & 7) * 64 + (c & 3) * 16) = s.v;
}
__device__ __forceinline__ void qkt(f32x16& p0, f32x16& p1, const LAS unsigned char* kbuf, const bf16x8 (&qr)[4], float cinit, int hi, int r32) {
#pragma unroll
    for (int r = 0; r < 16; ++r) { p0[r] = cinit; p1[r] = cinit; }
    bf16x8 kf[8];
#pragma unroll
    for (int s = 0; s < 4; ++s) { const int ch = 2 * s + hi; const LAS unsigned char* kb = kbuf + ch * 1024 + ((((r32 + ch) & 7) | (r32 & ~7)) * 16);
        kf[2 * s] = *(const LAS bf16x8*)(kb); kf[2 * s + 1] = *(const LAS bf16x8*)(kb + 512); }
#pragma unroll
    for (int s = 0; s < 4; ++s) {
        p0 = __builtin_amdgcn_mfma_f32_32x32x16_bf16(kf[2 * s], qr[s], p0, 0, 0, 0);
        p1 = __builtin_amdgcn_mfma_f32_32x32x16_bf16(kf[2 * s + 1], qr[s], p1, 0, 0, 0);
    }
    __builtin_amdgcn_sched_group_barrier(0x100, 8, 0);
    __builtin_amdgcn_sched_group_barrier(0x008, 8, 0);
}
__device__ __forceinline__ void qkt_v(f32x16& p0, f32x16& p1, s16x4 (&vlo)[8], s16x4 (&vhi)[8], const LAS unsigned char* kbuf, const LAS unsigned char* vb, const bf16x8 (&qr)[4], int hi, int r32) {
#pragma unroll
    for (int r = 0; r < 16; ++r) { p0[r] = 0.f; p1[r] = 0.f; }
    bf16x8 kf[8];
#pragma unroll
    for (int s = 0; s < 4; ++s) { const int ch = 2 * s + hi; const LAS unsigned char* kb = kbuf + ch * 1024 + ((((r32 + ch) & 7) | (r32 & ~7)) * 16);
        kf[2 * s] = *(const LAS bf16x8*)(kb); kf[2 * s + 1] = *(const LAS bf16x8*)(kb + 512); }
#pragma unroll
    for (int s = 0; s < 4; ++s) {
        p0 = __builtin_amdgcn_mfma_f32_32x32x16_bf16(kf[2 * s], qr[s], p0, 0, 0, 0);
        vlo[s] = vtr(vb + s * 1024); vhi[s] = vtr(vb + s * 1024 + 512);
        p1 = __builtin_amdgcn_mfma_f32_32x32x16_bf16(kf[2 * s + 1], qr[s], p1, 0, 0, 0);
        vlo[4 + s] = vtr(vb + 4096 + s * 1024); vhi[4 + s] = vtr(vb + 4096 + s * 1024 + 512);
    }
    __builtin_amdgcn_sched_group_barrier(0x100, 8, 0);
#pragma unroll
    for (int s = 0; s < 8; ++s) { __builtin_amdgcn_sched_group_barrier(0x008, 1, 0); __builtin_amdgcn_sched_group_barrier(0x100, 2, 0); }
}
constexpr float ATT_THR = 6.f;
template <bool HAS_LO, bool IMPA = false> __device__ __forceinline__ void tile_step(const LAS unsigned char* kbuf, const LAS unsigned char* vbuf, const bf16x8 (&qr)[4], float& mref, float& l, f32x16& o0, f32x16& o1,
                                          bool sel, bool first, bool need_mask, int hi_lim, int lo_lim, int hi, int r32, int lane, LAS _Float16* improw = nullptr, int jbase = 0) {
    f32x16 p0, p1;
#ifdef DUP_QK
    { f32x16 d0, d1; qkt(d0, d1, kbuf, qr, 0.f, hi, r32); float dm = fmaxf(d0[0], d1[0]);
#pragma unroll
      for (int r = 1; r < 16; ++r) dm = fmaxf(dm, fmaxf(d0[r], d1[r]));
      dm = swapmax(dm); float ds = 0.f;
#pragma unroll
      for (int r = 0; r < 16; ++r) { d0[r] = __builtin_amdgcn_exp2f(d0[r] - dm); d1[r] = __builtin_amdgcn_exp2f(d1[r] - dm); ds += d0[r] + d1[r]; }
      unsigned dk = 0;
#pragma unroll
      for (int r = 0; r < 16; r += 2) dk ^= cvtpk(d0[r], d0[r + 1]) ^ cvtpk(d1[r], d1[r + 1]);
      asm volatile("" :: "v"(ds), "v"(dk)); }
#endif
    if (!first) {
        const float l2 = swapsum(l);
        const bool big = l2 > 1048576.f;
        if (__any(big)) {
            const float dl = big ? __builtin_amdgcn_logf(l2) : 0.f;
            mref += dl;
            const float alpha = __builtin_amdgcn_exp2f(-dl);
            l *= alpha;
#pragma unroll
            for (int r = 0; r < 16; ++r) { o0[r] *= alpha; o1[r] *= alpha; }
            if constexpr (IMPA) { if (hi == 0) { for (int c = 0; c < 64; ++c) improw[c] = (_Float16)((float)improw[c] * alpha); } asm volatile("" ::: "memory"); }
        }
    }
    const LAS unsigned char* vb = vbuf + ((lane >> 4) & 1) * 32 + (lane & 3) * 8 + (4 * hi + ((lane & 15) >> 2)) * 64;
    s16x4 vlo[8], vhi[8];
    qkt_v(p0, p1, vlo, vhi, kbuf, vb, qr, hi, r32);
    const float NEG = -INFINITY;
    if (need_mask) {
        int hl = hi_lim - 4 * hi, ll = lo_lim - 4 * hi;
        asm volatile("" : "+v"(hl), "+v"(ll));
#pragma unroll
        for (int r = 0; r < 16; ++r) { const int c = (r & 3) + 8 * (r >> 2); if (!(c <= hl && (!HAS_LO || c > ll))) p0[r] = NEG; if (!(c + 32 <= hl && (!HAS_LO || c + 32 > ll))) p1[r] = NEG; }
    }
    if (first) {
        float mxa = max3f(p0[0], p0[1], p1[0]), mxb = max3f(p0[2], p0[3], p1[1]);
        mxa = max3f(mxa, p1[2], p1[3]);
#pragma unroll
        for (int r = 4; r < 16; r += 4) { mxa = max3f(mxa, p0[r], p0[r + 1]); mxb = max3f(mxb, p0[r + 2], p0[r + 3]); mxa = max3f(mxa, p1[r], p1[r + 1]); mxb = max3f(mxb, p1[r + 2], p1[r + 3]); }
        const float mx = swapmax(max2f(mxa, mxb));
        if (sel && mx > NEG) mref = mx;
    }
    const float msub = sel ? mref : INFINITY;
    float sum = 0.f;
#pragma unroll
    for (int r = 0; r < 16; ++r) { p0[r] = __builtin_amdgcn_exp2f(p0[r] - msub); p1[r] = __builtin_amdgcn_exp2f(p1[r] - msub); sum += p0[r] + p1[r]; }
    l += sum;
    if constexpr (IMPA) {
        LAS _Float16* c0 = improw + jbase + hi;
#pragma unroll
        for (int gq = 0; gq < 4; ++gq) { c0[2 * gq] = c0[2 * gq] + (_Float16)((p0[4 * gq] + p0[4 * gq + 1]) + (p0[4 * gq + 2] + p0[4 * gq + 3]));
                                          c0[8 + 2 * gq] = c0[8 + 2 * gq] + (_Float16)((p1[4 * gq] + p1[4 * gq + 1]) + (p1[4 * gq + 2] + p1[4 * gq + 3])); }
        asm volatile("" ::: "memory");
#pragma unroll
        for (int gq = 0; gq < 4; ++gq) { c0[2 * gq + 1] = c0[2 * gq + 1] + (_Float16)p0[4 * gq + 3];
                                          if (jbase + hi + 8 + 2 * gq + 1 < 64) c0[8 + 2 * gq + 1] = c0[8 + 2 * gq + 1] + (_Float16)p1[4 * gq + 3]; }
        asm volatile("" ::: "memory");
    }
    bf16x8 pf[4];
    { v4u w;
      w.x = cvtpk(p0[0], p0[1]); w.y = cvtpk(p0[2], p0[3]); w.z = cvtpk(p0[4], p0[5]); w.w = cvtpk(p0[6], p0[7]); pf[0] = __builtin_bit_cast(bf16x8, w);
      w.x = cvtpk(p0[8], p0[9]); w.y = cvtpk(p0[10], p0[11]); w.z = cvtpk(p0[12], p0[13]); w.w = cvtpk(p0[14], p0[15]); pf[1] = __builtin_bit_cast(bf16x8, w);
      w.x = cvtpk(p1[0], p1[1]); w.y = cvtpk(p1[2], p1[3]); w.z = cvtpk(p1[4], p1[5]); w.w = cvtpk(p1[6], p1[7]); pf[2] = __builtin_bit_cast(bf16x8, w);
      w.x = cvtpk(p1[8], p1[9]); w.y = cvtpk(p1[10], p1[11]); w.z = cvtpk(p1[12], p1[13]); w.w = cvtpk(p1[14], p1[15]); pf[3] = __builtin_bit_cast(bf16x8, w); }
#pragma unroll
    for (int s = 0; s < 4; ++s) {
        const bf16x8 va = (bf16x8){vlo[s][0], vlo[s][1], vlo[s][2], vlo[s][3], vhi[s][0], vhi[s][1], vhi[s][2], vhi[s][3]};
        const bf16x8 vb8 = (bf16x8){vlo[4 + s][0], vlo[4 + s][1], vlo[4 + s][2], vlo[4 + s][3], vhi[4 + s][0], vhi[4 + s][1], vhi[4 + s][2], vhi[4 + s][3]};
        o0 = __builtin_amdgcn_mfma_f32_32x32x16_bf16(va, pf[s], o0, 0, 0, 0);
        o1 = __builtin_amdgcn_mfma_f32_32x32x16_bf16(vb8, pf[s], o1, 0, 0, 0);
    }
#ifdef DUP_PV
    { f32x16 d0, d1;
#pragma unroll
      for (int r = 0; r < 16; ++r) { d0[r] = 0.f; d1[r] = 0.f; }
      s16x4 ulo[8], uhi[8];
#pragma unroll
      for (int s = 0; s < 4; ++s) { ulo[s] = vtr(vb + s * 1024); uhi[s] = vtr(vb + s * 1024 + 512); ulo[4 + s] = vtr(vb + 4096 + s * 1024); uhi[4 + s] = vtr(vb + 4096 + s * 1024 + 512); }
#pragma unroll
      for (int s = 0; s < 4; ++s) {
          const bf16x8 va = (bf16x8){ulo[s][0], ulo[s][1], ulo[s][2], ulo[s][3], uhi[s][0], uhi[s][1], uhi[s][2], uhi[s][3]};
          const bf16x8 vb8 = (bf16x8){ulo[4 + s][0], ulo[4 + s][1], ulo[4 + s][2], ulo[4 + s][3], uhi[4 + s][0], uhi[4 + s][1], uhi[4 + s][2], uhi[4 + s][3]};
          d0 = __builtin_amdgcn_mfma_f32_32x32x16_bf16(va, pf[s], d0, 0, 0, 0);
          d1 = __builtin_amdgcn_mfma_f32_32x32x16_bf16(vb8, pf[s], d1, 0, 0, 0);
      }
      asm volatile("" :: "v"(d0), "v"(d1)); }
#endif
}
__device__ __forceinline__ void imp_step(const LAS unsigned char* kbuf, const bf16x8 (&qr)[4], float mfin, float linv, int hi_lim, int hi, int r32, LAS float* improw, int jbase) {
    f32x16 p0, p1;
    qkt(p0, p1, kbuf, qr, 0.f, hi, r32);
    int hl = hi_lim - 4 * hi; asm volatile("" : "+v"(hl));
#pragma unroll
    for (int r = 0; r < 16; ++r) { const int c = (r & 3) + 8 * (r >> 2);
        p0[r] = (c <= hl) ? __builtin_amdgcn_exp2f(p0[r] - mfin) * linv : 0.f;
        p1[r] = (c + 32 <= hl) ? __builtin_amdgcn_exp2f(p1[r] - mfin) * linv : 0.f; }
#pragma unroll
    for (int gq = 0; gq < 4; ++gq) {
        { const float G = (p0[4 * gq] + p0[4 * gq + 1]) + (p0[4 * gq + 2] + p0[4 * gq + 3]); const int j = jbase + 2 * gq + hi;
          __hip_atomic_fetch_add(improw + j, G, __ATOMIC_RELAXED, __HIP_MEMORY_SCOPE_WORKGROUP);
          if (j + 1 < 64) __hip_atomic_fetch_add(improw + j + 1, p0[4 * gq + 3], __ATOMIC_RELAXED, __HIP_MEMORY_SCOPE_WORKGROUP); }
        { const float G = (p1[4 * gq] + p1[4 * gq + 1]) + (p1[4 * gq + 2] + p1[4 * gq + 3]); const int j = jbase + 8 + 2 * gq + hi;
          __hip_atomic_fetch_add(improw + j, G, __ATOMIC_RELAXED, __HIP_MEMORY_SCOPE_WORKGROUP);
          if (j + 1 < 64) __hip_atomic_fetch_add(improw + j + 1, p1[4 * gq + 3], __ATOMIC_RELAXED, __HIP_MEMORY_SCOPE_WORKGROUP); }
    }
}
__device__ __forceinline__ void ost_acc(LAS unsigned char* orow, const f32x16& o0, const f32x16& o1, float sc, bool first, int hi) {
#pragma unroll
    for (int rg = 0; rg < 4; ++rg) {
        const int d = 8 * rg + 4 * hi;
        float a[4], c[4];
#pragma unroll
        for (int e = 0; e < 4; ++e) { a[e] = o0[4 * rg + e] * sc; c[e] = o1[4 * rg + e] * sc; }
        if (!first) { const v2u w0 = *(const LAS v2u*)(orow + d * 2), w1 = *(const LAS v2u*)(orow + (32 + d) * 2);
            a[0] += bflo(w0.x); a[1] += bfhi(w0.x); a[2] += bflo(w0.y); a[3] += bfhi(w0.y); c[0] += bflo(w1.x); c[1] += bfhi(w1.x); c[2] += bflo(w1.y); c[3] += bfhi(w1.y); }
        v2u w0; w0.x = cvtpk(a[0], a[1]); w0.y = cvtpk(a[2], a[3]); *(LAS v2u*)(orow + d * 2) = w0;
        v2u w1; w1.x = cvtpk(c[0], c[1]); w1.y = cvtpk(c[2], c[3]); *(LAS v2u*)(orow + (32 + d) * 2) = w1;
    }
}
}

#define ATT_PRE(T0, KP, VP, RS) do { const int t_ = (T0); att::tile_load(sA_, (KP), (VP), (RS), tid); } while (0)
#define ATT_PASS(T0, NTL, KP, VP, RS, BODY) do { \
    const int tend_ = (T0) + (NTL); int t_ = (T0), cur_ = 0; \
    { att::tile_store(sA_, L + att::KBUF, L + att::VBUF, tid); } \
    if (t_ + 1 < tend_) { ++t_; att::tile_load(sB_, (KP), (VP), (RS), tid); --t_; } \
    __syncthreads(); \
    for (;;) { \
        if (t_ + 2 < tend_) { t_ += 2; att::tile_load(sA_, (KP), (VP), (RS), tid); t_ -= 2; } \
        { const LAS unsigned char* kb_ = L + att::KBUF + cur_ * 8192; const LAS unsigned char* vb_ = L + att::VBUF + cur_ * 8192; BODY; } \
        if (t_ + 1 >= tend_) break; \
        att::tile_store(sB_, L + att::KBUF + (cur_ ^ 1) * 8192, L + att::VBUF + (cur_ ^ 1) * 8192, tid); \
        __syncthreads(); cur_ ^= 1; ++t_; \
        if (t_ + 2 < tend_) { t_ += 2; att::tile_load(sB_, (KP), (VP), (RS), tid); t_ -= 2; } \
        { const LAS unsigned char* kb_ = L + att::KBUF + cur_ * 8192; const LAS unsigned char* vb_ = L + att::VBUF + cur_ * 8192; BODY; } \
        if (t_ + 1 >= tend_) break; \
        att::tile_store(sA_, L + att::KBUF + (cur_ ^ 1) * 8192, L + att::VBUF + (cur_ ^ 1) * 8192, tid); \
        __syncthreads(); cur_ ^= 1; ++t_; } \
    __syncthreads(); } while (0)

__device__ __forceinline__ void p3_unit(Frame& F, int b, int i) {
    LAS unsigned char* L = F.lds + RING_OFF;
    const int tid = F.tid, lane = F.lane, w = F.wave, hi = lane >> 5, r32 = lane & 31;
    LAS float* LINV = (LAS float*)(L + att::LINV_OFF);
    LAS unsigned long long* SELM = (LAS unsigned long long*)(L + att::SELM_OFF);
    LAS float* SSQ = (LAS float*)(L + att::SSQ_OFF);
    const int q = (w & 1) * 32 + r32;
    const int t = 64 * i + q;
    const size_t bt = (size_t)b * SEQ + t;
    const float NEG = -INFINITY;
    if (tid < 64) SSQ[tid] = 0.f;
    att::Stg sA_, sB_;
#define ATT_CMP_K(G) (F_KCC + ((size_t)(b * 256 + 64 * t_) * 2 + (G)) * 64)
#define ATT_CMP_V(G) (F_VCC + ((size_t)(b * 256 + 64 * t_) * 2 + (G)) * 64)
    ATT_PRE(0, ATT_CMP_K(0), ATT_CMP_V(0), 128);
    for (int g = 0; g < 2; ++g) {
        const int H = g * 4 + (w >> 1);
        for (int z = tid; z < 6144; z += NWAVES * 64) ((LAS unsigned*)(L + att::IMP_OFF))[z] = 0u;
        for (int z = tid; z < 2048; z += NWAVES * 64) ((LAS unsigned*)(L + att::IMP3_OFF))[z] = 0u;
        bf16x8 qr[4];
#pragma unroll
        for (int s = 0; s < 4; ++s) qr[s] = *(const GAS bf16x8*)(F_PROJ + bt * NPROJ + C_Q + H * 64 + 16 * s + 8 * hi);
        LAS float* gslot = (LAS float*)(L + att::GATE_OFF + tid * 16);
        { const bf16* gp = F_PROJ + bt * NPROJ + C_G + H * 3; const float g0 = bf2f(gp[0]), g1 = bf2f(gp[1]), g2 = bf2f(gp[2]);
          gslot[0] = 1.f / (1.f + __expf(-g0)); gslot[1] = 1.f / (1.f + __expf(-g1)); gslot[2] = 1.f / (1.f + __expf(-g2)); }
#define ATT_GATE(k) (gslot[k])
        LAS unsigned char* orow = L + att::OST_OFF + q * att::OST_ROW + (H * 64) * 2;
        const int nlim = (t - 31) >> 4;
        const int nmaxb = (4 * i + 2 < 254) ? 4 * i + 2 : 254;
        const int nct = (nmaxb >> 6) + 1;
        float m = 0.f, l = 0.f; f32x16 o0, o1;
#pragma unroll
        for (int r = 0; r < 16; ++r) { o0[r] = 0.f; o1[r] = 0.f; }
        bool first = true;
        ATT_PASS(0, nct, ATT_CMP_K(g), ATT_CMP_V(g), 128,
                 { (att::tile_step<false, true>)(kb_, vb_, qr, m, l, o0, o1, true, first, true, nlim - 64 * t_, -1, hi, r32, lane, att::imp_plane(L, w >> 1) + q * 64, 16 * t_); first = false; });
        ATT_PRE(0, F_PROJ + ((size_t)b * SEQ + 64 * t_) * NPROJ + C_KS + g * 64, F_PROJ + ((size_t)b * SEQ + 64 * t_) * NPROJ + C_VS + g * 64, NPROJ);
        { const float lt = att::swapsum(l); const float linv = lt > 0.f ? 1.f / lt : 0.f; if (hi == 0) LINV[(w >> 1) * 64 + q] = linv; att::ost_acc(orow, o0, o1, ATT_GATE(0) * linv, true, hi); }
        __syncthreads();
        { const int j = lane; const bool forced = (j == 0) || (j == i) || (j == i - 1);
          for (int qq = 0; qq < 8; qq += 4) {
              unsigned key[4]; int rank[4];
#pragma unroll
              for (int u = 0; u < 4; ++u) { const int qx = 8 * w + qq + u;
                  const float v0 = ((float)att::imp_plane(L, 0)[qx * 64 + lane] * LINV[qx] + (float)att::imp_plane(L, 1)[qx * 64 + lane] * LINV[64 + qx]) + ((float)att::imp_plane(L, 2)[qx * 64 + lane] * LINV[128 + qx] + (float)att::imp_plane(L, 3)[qx * 64 + lane] * LINV[192 + qx]);
                  key[u] = (j > i) ? (unsigned)(63 - j) : (((__builtin_bit_cast(unsigned, v0) & ~63u) | (unsigned)(63 - j)) | (forced ? 0x80000000u : 0u)); rank[u] = 0; }
#pragma unroll
              for (int jc = 0; jc < 4; ++jc) {
                  if (16 * jc <= i) {
#pragma unroll
                      for (int jj = 16 * jc; jj < 16 * jc + 16; ++jj) {
#pragma unroll
                          for (int u = 0; u < 4; ++u) { const unsigned o = (unsigned)__builtin_amdgcn_readlane((int)key[u], jj); rank[u] += (o > key[u]) ? 1 : 0; } } } }
#pragma unroll
              for (int u = 0; u < 4; ++u) { const unsigned long long msk = __ballot(rank[u] < 16); if (lane == 0) SELM[8 * w + qq + u] = msk; } } }
        __syncthreads();
        m = 0.f; l = 0.f; first = true;
#pragma unroll
        for (int r = 0; r < 16; ++r) { o0[r] = 0.f; o1[r] = 0.f; }
        ATT_PASS(0, i + 1, F_PROJ + ((size_t)b * SEQ + 64 * t_) * NPROJ + C_KS + g * 64, F_PROJ + ((size_t)b * SEQ + 64 * t_) * NPROJ + C_VS + g * 64, NPROJ,
                 { att::tile_step<false>(kb_, vb_, qr, m, l, o0, o1, ((SELM[q] >> t_) & 1ull) != 0ull, first, t_ == i, (t_ == i) ? q : 63, -1, hi, r32, lane); first = false; });
        const int wlo = (i >= 8) ? i - 8 : 0;
        ATT_PRE(wlo, F_PROJ + ((size_t)b * SEQ + 64 * t_) * NPROJ + C_KW + g * 64, F_PROJ + ((size_t)b * SEQ + 64 * t_) * NPROJ + C_VW + g * 64, NPROJ);
        { const float lt = att::swapsum(l); att::ost_acc(orow, o0, o1, lt > 0.f ? ATT_GATE(1) / lt : 0.f, false, hi); }
        m = 0.f; l = 0.f; first = true;
#pragma unroll
        for (int r = 0; r < 16; ++r) { o0[r] = 0.f; o1[r] = 0.f; }
        ATT_PASS(wlo, i - wlo + 1, F_PROJ + ((size_t)b * SEQ + 64 * t_) * NPROJ + C_KW + g * 64, F_PROJ + ((size_t)b * SEQ + 64 * t_) * NPROJ + C_VW + g * 64, NPROJ,
                 { att::tile_step<true>(kb_, vb_, qr, m, l, o0, o1, true, first, (t_ == i) || (t_ == i - 8), (t_ == i) ? q : 63, (t_ == i - 8) ? q : -1, hi, r32, lane); first = false; });
        if (g == 0) ATT_PRE(0, ATT_CMP_K(1), ATT_CMP_V(1), 128);
        { const float lt = att::swapsum(l); att::ost_acc(orow, o0, o1, lt > 0.f ? ATT_GATE(2) / lt : 0.f, false, hi); }
        { float ss = 0.f;
#pragma unroll
          for (int rg = 0; rg < 4; ++rg) { const int d = 8 * rg + 4 * hi; const v2u w0 = *(const LAS v2u*)(orow + d * 2), w1 = *(const LAS v2u*)(orow + (32 + d) * 2);
              const float a0 = bflo(w0.x), a1 = bfhi(w0.x), a2 = bflo(w0.y), a3 = bfhi(w0.y), c0 = bflo(w1.x), c1 = bfhi(w1.x), c2 = bflo(w1.y), c3 = bfhi(w1.y);
              ss += (a0 * a0 + a1 * a1) + (a2 * a2 + a3 * a3) + (c0 * c0 + c1 * c1) + (c2 * c2 + c3 * c3); }
          __hip_atomic_fetch_add(SSQ + q, ss, __ATOMIC_RELAXED, __HIP_MEMORY_SCOPE_WORKGROUP); }
        __syncthreads();
    }
    { const int qx = tid >> 3, part = tid & 7; const float rs = 1.f / sqrtf(SSQ[qx] * (1.f / 512.f) + RMS_EPS);
      const LAS unsigned char* orow = L + att::OST_OFF + qx * att::OST_ROW + part * 128; bf16* dst = F_MIXA + ((size_t)b * SEQ + 64 * i + qx) * 1024 + 512 + part * 64;
#pragma unroll
      for (int c = 0; c < 8; ++c) { float f[8]; up8(*(const LAS v4u*)(orow + c * 16), f); const f32x4 g0 = *(const GAS f32x4*)(F_gn_attn + part * 64 + c * 8), g1 = *(const GAS f32x4*)(F_gn_attn + part * 64 + c * 8 + 4);
          v4u o; o.x = pk2(f[0] * rs * g0[0], f[1] * rs * g0[1]); o.y = pk2(f[2] * rs * g0[2], f[3] * rs * g0[3]); o.z = pk2(f[4] * rs * g1[0], f[5] * rs * g1[1]); o.w = pk2(f[6] * rs * g1[2], f[7] * rs * g1[3]);
          *(GAS v4u*)(dst + c * 8) = o; } }
    __syncthreads();
}
__device__ __forceinline__ void p3_attention(Frame& F) {
    for (int u = F.vcu; u < 512; u += F.G) { const int k = u >> 8, v = u & 255; const int b = v >> 5, s = v & 31; p3_unit(F, b, k ? 63 - s : s); }
}

namespace peer {
constexpr int IDX_OFF = 0, W6_OFF = 16384;
__device__ __forceinline__ unsigned f2key(float f) { const unsigned u = __builtin_bit_cast(unsigned, f); return u ^ ((unsigned)((int)u >> 31) | 0x80000000u); }
__device__ __forceinline__ float key2f(unsigned k) { return __builtin_bit_cast(float, k ^ ((k & 0x80000000u) ? 0x80000000u : 0xFFFFFFFFu)); }
__device__ __forceinline__ unsigned umax(unsigned a, unsigned b) { return a > b ? a : b; }
__device__ __forceinline__ unsigned umin(unsigned a, unsigned b) { return a < b ? a : b; }
__device__ __forceinline__ void sort16_desc(unsigned (&a)[16]) {
#pragma unroll
    for (int k = 2; k <= 16; k <<= 1) {
#pragma unroll
        for (int j = k >> 1; j > 0; j >>= 1) {
#pragma unroll
            for (int i = 0; i < 16; ++i) { const int l = i ^ j; if (l > i) { const bool up = ((i & k) == 0); const unsigned mx = umax(a[i], a[l]), mn = umin(a[i], a[l]); a[i] = up ? mx : mn; a[l] = up ? mn : mx; } }
        }
    }
}
__device__ __forceinline__ void merge16_desc(unsigned (&A)[16], const unsigned (&B)[16]) {
#pragma unroll
    for (int i = 0; i < 16; ++i) A[i] = umax(A[i], B[15 - i]);
#pragma unroll
    for (int j = 8; j > 0; j >>= 1) {
#pragma unroll
        for (int i = 0; i < 16; ++i) { const int l = i ^ j; if (l > i) { const unsigned mx = umax(A[i], A[l]), mn = umin(A[i], A[l]); A[i] = mx; A[l] = mn; } }
    }
}
template <int GQ> __device__ __forceinline__ void fill_cands(unsigned (&g)[16], const float (&f0)[16], const float (&f1)[16]) {
    if constexpr (GQ == 0) {
        g[0] = (f2key(f0[0] + f1[0]) & ~255u) | 255u;
        g[1] = (f2key(f0[0] + f1[1]) & ~255u) | 254u;
        g[2] = (f2key(f0[0] + f1[2]) & ~255u) | 253u;
        g[3] = (f2key(f0[0] + f1[3]) & ~255u) | 252u;
        g[4] = (f2key(f0[0] + f1[4]) & ~255u) | 251u;
        g[5] = (f2key(f0[0] + f1[5]) & ~255u) | 250u;
        g[6] = (f2key(f0[0] + f1[6]) & ~255u) | 249u;
        g[7] = (f2key(f0[0] + f1[7]) & ~255u) | 248u;
        g[8] = (f2key(f0[0] + f1[8]) & ~255u) | 247u;
        g[9] = (f2key(f0[0] + f1[9]) & ~255u) | 246u;
        g[10] = (f2key(f0[0] + f1[10]) & ~255u) | 245u;
        g[11] = (f2key(f0[0] + f1[11]) & ~255u) | 244u;
        g[12] = (f2key(f0[0] + f1[12]) & ~255u) | 243u;
        g[13] = (f2key(f0[0] + f1[13]) & ~255u) | 242u;
        g[14] = (f2key(f0[0] + f1[14]) & ~255u) | 241u;
        g[15] = (f2key(f0[0] + f1[15]) & ~255u) | 240u;
    }
    if constexpr (GQ == 1) {
        g[0] = (f2key(f0[1] + f1[0]) & ~255u) | 239u;
        g[1] = (f2key(f0[1] + f1[1]) & ~255u) | 238u;
        g[2] = (f2key(f0[1] + f1[2]) & ~255u) | 237u;
        g[3] = (f2key(f0[1] + f1[3]) & ~255u) | 236u;
        g[4] = (f2key(f0[1] + f1[4]) & ~255u) | 235u;
        g[5] = (f2key(f0[1] + f1[5]) & ~255u) | 234u;
        g[6] = (f2key(f0[1] + f1[6]) & ~255u) | 233u;
        g[7] = (f2key(f0[1] + f1[7]) & ~255u) | 232u;
        g[8] = (f2key(f0[2] + f1[0]) & ~255u) | 223u;
        g[9] = (f2key(f0[2] + f1[1]) & ~255u) | 222u;
        g[10] = (f2key(f0[2] + f1[2]) & ~255u) | 221u;
        g[11] = (f2key(f0[2] + f1[3]) & ~255u) | 220u;
        g[12] = (f2key(f0[2] + f1[4]) & ~255u) | 219u;
        g[13] = (f2key(f0[3] + f1[0]) & ~255u) | 207u;
        g[14] = (f2key(f0[3] + f1[1]) & ~255u) | 206u;
        g[15] = (f2key(f0[3] + f1[2]) & ~255u) | 205u;
    }
    if constexpr (GQ == 2) {
        g[0] = (f2key(f0[3] + f1[3]) & ~255u) | 204u;
        g[1] = (f2key(f0[4] + f1[0]) & ~255u) | 191u;
        g[2] = (f2key(f0[4] + f1[1]) & ~255u) | 190u;
        g[3] = (f2key(f0[4] + f1[2]) & ~255u) | 189u;
        g[4] = (f2key(f0[5] + f1[0]) & ~255u) | 175u;
        g[5] = (f2key(f0[5] + f1[1]) & ~255u) | 174u;
        g[6] = (f2key(f0[6] + f1[0]) & ~255u) | 159u;
        g[7] = (f2key(f0[6] + f1[1]) & ~255u) | 158u;
        g[8] = (f2key(f0[7] + f1[0]) & ~255u) | 143u;
        g[9] = (f2key(f0[7] + f1[1]) & ~255u) | 142u;
        g[10] = (f2key(f0[8] + f1[0]) & ~255u) | 127u;
        g[11] = (f2key(f0[9] + f1[0]) & ~255u) | 111u;
        g[12] = (f2key(f0[10] + f1[0]) & ~255u) | 95u;
        g[13] = (f2key(f0[11] + f1[0]) & ~255u) | 79u;
        g[14] = (f2key(f0[12] + f1[0]) & ~255u) | 63u;
        g[15] = (f2key(f0[13] + f1[0]) & ~255u) | 47u;
    }
    if constexpr (GQ == 3) {
        g[0] = (f2key(f0[14] + f1[0]) & ~255u) | 31u;
        g[1] = (f2key(f0[15] + f1[0]) & ~255u) | 15u;
        g[2] = 0u;
        g[3] = 0u;
        g[4] = 0u;
        g[5] = 0u;
        g[6] = 0u;
        g[7] = 0u;
        g[8] = 0u;
        g[9] = 0u;
        g[10] = 0u;
        g[11] = 0u;
        g[12] = 0u;
        g[13] = 0u;
        g[14] = 0u;
        g[15] = 0u;
    }
}
__device__ __forceinline__ float dot2bf(unsigned a, unsigned b, float c) { return __builtin_amdgcn_fdot2_f32_bf16(__builtin_bit_cast(bf16x2v, a), __builtin_bit_cast(bf16x2v, b), c, false); }
__device__ __forceinline__ float dot8(const v4u a, const v4u b, float c) { c = dot2bf(a.x, b.x, c); c = dot2bf(a.y, b.y, c); c = dot2bf(a.z, b.z, c); return dot2bf(a.w, b.w, c); }
__device__ __forceinline__ float dot32b(const v4u u, const unsigned (&h)[16]) {
    float s0 = 0.f, s1 = 0.f, s2 = 0.f, s3 = 0.f;
#define P6_D2(W, bs, hi_, acc_) acc_ = __builtin_amdgcn_fdot2_f32_bf16(__builtin_amdgcn_cvt_scalef32_pk_bf16_fp4((W), 1.0f, (bs)), __builtin_bit_cast(bf16x2v, h[hi_]), acc_, false)
    P6_D2(u.x, 0, 0, s0); P6_D2(u.x, 1, 1, s1); P6_D2(u.x, 2, 2, s2); P6_D2(u.x, 3, 3, s3);
    P6_D2(u.y, 0, 4, s0); P6_D2(u.y, 1, 5, s1); P6_D2(u.y, 2, 6, s2); P6_D2(u.y, 3, 7, s3);
    P6_D2(u.z, 0, 8, s0); P6_D2(u.z, 1, 9, s1); P6_D2(u.z, 2, 10, s2); P6_D2(u.z, 3, 11, s3);
    P6_D2(u.w, 0, 12, s0); P6_D2(u.w, 1, 13, s1); P6_D2(u.w, 2, 14, s2); P6_D2(u.w, 3, 15, s3);
#undef P6_D2
    return (s0 + s1) + (s2 + s3);
}
typedef _Float16 h16x2 __attribute__((ext_vector_type(2)));
template <int BS> __device__ __forceinline__ h16x2 cvt4h(unsigned w) { return __builtin_bit_cast(h16x2, __builtin_amdgcn_cvt_scalef32_pk_f16_fp4(w, 1.0f, BS)); }
__device__ __forceinline__ void axpy32h(h16x2 (&acc)[16], const v4u v, _Float16 a) {
    const h16x2 a2 = (h16x2){a, a};
    acc[0] = __builtin_elementwise_fma(cvt4h<0>(v.x), a2, acc[0]); acc[1] = __builtin_elementwise_fma(cvt4h<1>(v.x), a2, acc[1]); acc[2] = __builtin_elementwise_fma(cvt4h<2>(v.x), a2, acc[2]); acc[3] = __builtin_elementwise_fma(cvt4h<3>(v.x), a2, acc[3]);
    acc[4] = __builtin_elementwise_fma(cvt4h<0>(v.y), a2, acc[4]); acc[5] = __builtin_elementwise_fma(cvt4h<1>(v.y), a2, acc[5]); acc[6] = __builtin_elementwise_fma(cvt4h<2>(v.y), a2, acc[6]); acc[7] = __builtin_elementwise_fma(cvt4h<3>(v.y), a2, acc[7]);
    acc[8] = __builtin_elementwise_fma(cvt4h<0>(v.z), a2, acc[8]); acc[9] = __builtin_elementwise_fma(cvt4h<1>(v.z), a2, acc[9]); acc[10] = __builtin_elementwise_fma(cvt4h<2>(v.z), a2, acc[10]); acc[11] = __builtin_elementwise_fma(cvt4h<3>(v.z), a2, acc[11]);
    acc[12] = __builtin_elementwise_fma(cvt4h<0>(v.w), a2, acc[12]); acc[13] = __builtin_elementwise_fma(cvt4h<1>(v.w), a2, acc[13]); acc[14] = __builtin_elementwise_fma(cvt4h<2>(v.w), a2, acc[14]); acc[15] = __builtin_elementwise_fma(cvt4h<3>(v.w), a2, acc[15]);
}
__device__ __forceinline__ float dot32(const v4u u, const f32x2 (&h)[16]) {
    f32x2 s = __builtin_amdgcn_cvt_scalef32_pk_f32_fp4(u.x, 1.0f, 0) * h[0];
    s += __builtin_amdgcn_cvt_scalef32_pk_f32_fp4(u.x, 1.0f, 1) * h[1]; s += __builtin_amdgcn_cvt_scalef32_pk_f32_fp4(u.x, 1.0f, 2) * h[2]; s += __builtin_amdgcn_cvt_scalef32_pk_f32_fp4(u.x, 1.0f, 3) * h[3];
    s += __builtin_amdgcn_cvt_scalef32_pk_f32_fp4(u.y, 1.0f, 0) * h[4]; s += __builtin_amdgcn_cvt_scalef32_pk_f32_fp4(u.y, 1.0f, 1) * h[5]; s += __builtin_amdgcn_cvt_scalef32_pk_f32_fp4(u.y, 1.0f, 2) * h[6]; s += __builtin_amdgcn_cvt_scalef32_pk_f32_fp4(u.y, 1.0f, 3) * h[7];
    s += __builtin_amdgcn_cvt_scalef32_pk_f32_fp4(u.z, 1.0f, 0) * h[8]; s += __builtin_amdgcn_cvt_scalef32_pk_f32_fp4(u.z, 1.0f, 1) * h[9]; s += __builtin_amdgcn_cvt_scalef32_pk_f32_fp4(u.z, 1.0f, 2) * h[10]; s += __builtin_amdgcn_cvt_scalef32_pk_f32_fp4(u.z, 1.0f, 3) * h[11];
    s += __builtin_amdgcn_cvt_scalef32_pk_f32_fp4(u.w, 1.0f, 0) * h[12]; s += __builtin_amdgcn_cvt_scalef32_pk_f32_fp4(u.w, 1.0f, 1) * h[13]; s += __builtin_amdgcn_cvt_scalef32_pk_f32_fp4(u.w, 1.0f, 2) * h[14]; s += __builtin_amdgcn_cvt_scalef32_pk_f32_fp4(u.w, 1.0f, 3) * h[15];
    return s.x + s.y;
}
__device__ __forceinline__ void axpy32(f32x2 (&acc)[16], const v4u v, float a) {
    const f32x2 a2 = (f32x2){a, a};
    acc[0] += __builtin_amdgcn_cvt_scalef32_pk_f32_fp4(v.x, 1.0f, 0) * a2; acc[1] += __builtin_amdgcn_cvt_scalef32_pk_f32_fp4(v.x, 1.0f, 1) * a2; acc[2] += __builtin_amdgcn_cvt_scalef32_pk_f32_fp4(v.x, 1.0f, 2) * a2; acc[3] += __builtin_amdgcn_cvt_scalef32_pk_f32_fp4(v.x, 1.0f, 3) * a2;
    acc[4] += __builtin_amdgcn_cvt_scalef32_pk_f32_fp4(v.y, 1.0f, 0) * a2; acc[5] += __builtin_amdgcn_cvt_scalef32_pk_f32_fp4(v.y, 1.0f, 1) * a2; acc[6] += __builtin_amdgcn_cvt_scalef32_pk_f32_fp4(v.y, 1.0f, 2) * a2; acc[7] += __builtin_amdgcn_cvt_scalef32_pk_f32_fp4(v.y, 1.0f, 3) * a2;
    acc[8] += __builtin_amdgcn_cvt_scalef32_pk_f32_fp4(v.z, 1.0f, 0) * a2; acc[9] += __builtin_amdgcn_cvt_scalef32_pk_f32_fp4(v.z, 1.0f, 1) * a2; acc[10] += __builtin_amdgcn_cvt_scalef32_pk_f32_fp4(v.z, 1.0f, 2) * a2; acc[11] += __builtin_amdgcn_cvt_scalef32_pk_f32_fp4(v.z, 1.0f, 3) * a2;
    acc[12] += __builtin_amdgcn_cvt_scalef32_pk_f32_fp4(v.w, 1.0f, 0) * a2; acc[13] += __builtin_amdgcn_cvt_scalef32_pk_f32_fp4(v.w, 1.0f, 1) * a2; acc[14] += __builtin_amdgcn_cvt_scalef32_pk_f32_fp4(v.w, 1.0f, 2) * a2; acc[15] += __builtin_amdgcn_cvt_scalef32_pk_f32_fp4(v.w, 1.0f, 3) * a2;
}
__device__ __forceinline__ float dot16(const v4u u, const f32x2 (&h)[8]) {
    f32x2 s = __builtin_amdgcn_cvt_pk_f32_fp8((int)u.x, false) * h[0];
    s += __builtin_amdgcn_cvt_pk_f32_fp8((int)u.x, true) * h[1];
    s += __builtin_amdgcn_cvt_pk_f32_fp8((int)u.y, false) * h[2]; s += __builtin_amdgcn_cvt_pk_f32_fp8((int)u.y, true) * h[3];
    s += __builtin_amdgcn_cvt_pk_f32_fp8((int)u.z, false) * h[4]; s += __builtin_amdgcn_cvt_pk_f32_fp8((int)u.z, true) * h[5];
    s += __builtin_amdgcn_cvt_pk_f32_fp8((int)u.w, false) * h[6]; s += __builtin_amdgcn_cvt_pk_f32_fp8((int)u.w, true) * h[7];
    return s.x + s.y;
}
__device__ __forceinline__ void axpy16(f32x2 (&acc)[8], const v4u v, float a) {
    const f32x2 a2 = (f32x2){a, a};
    acc[0] += __builtin_amdgcn_cvt_pk_f32_fp8((int)v.x, false) * a2; acc[1] += __builtin_amdgcn_cvt_pk_f32_fp8((int)v.x, true) * a2;
    acc[2] += __builtin_amdgcn_cvt_pk_f32_fp8((int)v.y, false) * a2; acc[3] += __builtin_amdgcn_cvt_pk_f32_fp8((int)v.y, true) * a2;
    acc[4] += __builtin_amdgcn_cvt_pk_f32_fp8((int)v.z, false) * a2; acc[5] += __builtin_amdgcn_cvt_pk_f32_fp8((int)v.z, true) * a2;
    acc[6] += __builtin_amdgcn_cvt_pk_f32_fp8((int)v.w, false) * a2; acc[7] += __builtin_amdgcn_cvt_pk_f32_fp8((int)v.w, true) * a2;
}
__device__ __forceinline__ float xsum32(float a, float b) { auto r = __builtin_amdgcn_permlane32_swap(__float_as_uint(a), __float_as_uint(b), false, false); return __uint_as_float(r[0]) + __uint_as_float(r[1]); }
__device__ __forceinline__ float xsum16(float a, float b) { auto r = __builtin_amdgcn_permlane16_swap(__float_as_uint(a), __float_as_uint(b), false, false); return __uint_as_float(r[0]) + __uint_as_float(r[1]); }
template <int CTRL> __device__ __forceinline__ float dppf(float v) { return __builtin_bit_cast(float, __builtin_amdgcn_update_dpp(0, __builtin_bit_cast(int, v), CTRL, 0xF, 0xF, true)); }
__device__ __forceinline__ float transpose_reduce8_dc(const float (&p)[8], int lane) {
    float x4[4], x2[2];
    { const bool bt = (lane & 4) != 0;
#pragma unroll
      for (int k = 0; k < 4; ++k) { const float keep = bt ? p[k + 4] : p[k], send = bt ? p[k] : p[k + 4]; x4[k] = keep + dppf<0x141>(send); } }
    { const bool bt = (lane & 2) != 0;
#pragma unroll
      for (int k = 0; k < 2; ++k) { const float keep = bt ? x4[k + 2] : x4[k], send = bt ? x4[k] : x4[k + 2]; x2[k] = keep + dppf<0x4E>(send); } }
    const bool bt = (lane & 1) != 0; const float keep = bt ? x2[1] : x2[0], send = bt ? x2[0] : x2[1]; return keep + dppf<0xB1>(send);
}
__device__ __forceinline__ float transpose_reduce8(const float (&p)[8], int lane) {
    float x4[4], x2[2];
    { const bool bt = (lane & 4) != 0;
#pragma unroll
      for (int k = 0; k < 4; ++k) { const float keep = bt ? p[k + 4] : p[k], send = bt ? p[k] : p[k + 4]; x4[k] = keep + __shfl_xor(send, 4); } }
    { const bool bt = (lane & 2) != 0;
#pragma unroll
      for (int k = 0; k < 2; ++k) { const float keep = bt ? x4[k + 2] : x4[k], send = bt ? x4[k] : x4[k + 2]; x2[k] = keep + __shfl_xor(send, 2); } }
    float r;
    { const bool bt = (lane & 1) != 0; const float keep = bt ? x2[1] : x2[0], send = bt ? x2[0] : x2[1]; r = keep + __shfl_xor(send, 1); }
    r += __shfl_xor(r, 8); r += __shfl_xor(r, 16); r += __shfl_xor(r, 32);
    return r;
}
__device__ __forceinline__ void cexf(float& a, float& b) { float mx, mn; asm("v_max_f32 %0, %1, %2" : "=v"(mx) : "v"(a), "v"(b)); asm("v_min_f32 %0, %1, %2" : "=v"(mn) : "v"(a), "v"(b)); a = mx; b = mn; }
__device__ __forceinline__ float fmaxr(float a, float b) { float mx; asm("v_max_f32 %0, %1, %2" : "=v"(mx) : "v"(a), "v"(b)); return mx; }
__device__ __forceinline__ void sort16f(float (&a)[16]) {
#define CX(i, j) cexf(a[i], a[j]);
    CX(0,1) CX(2,3) CX(4,5) CX(6,7) CX(8,9) CX(10,11) CX(12,13) CX(14,15) CX(0,2) CX(1,3) CX(4,6) CX(5,7) CX(8,10) CX(9,11) CX(12,14) CX(13,15) CX(1,2) CX(5,6) CX(9,10) CX(13,14) CX(0,4) CX(1,5) CX(2,6) CX(3,7) CX(8,12) CX(9,13) CX(10,14) CX(11,15) CX(2,4) CX(3,5) CX(10,12) CX(11,13) CX(1,2) CX(3,4) CX(5,6) CX(9,10) CX(11,12) CX(13,14) CX(0,8) CX(1,9) CX(2,10) CX(3,11) CX(4,12) CX(5,13) CX(6,14) CX(7,15) CX(4,8) CX(5,9) CX(6,10) CX(7,11) CX(2,4) CX(3,5) CX(6,8) CX(7,9) CX(10,12) CX(11,13) CX(1,2) CX(3,4) CX(5,6) CX(7,8) CX(9,10) CX(11,12) CX(13,14)
#undef CX
}
__device__ __forceinline__ void merge16f(float (&A)[16], const float (&B)[16]) {
#pragma unroll
    for (int i = 0; i < 16; ++i) A[i] = fmaxr(A[i], B[15 - i]);
#pragma unroll
    for (int j = 8; j > 0; j >>= 1) {
#pragma unroll
        for (int i = 0; i < 16; ++i) { const int l = i ^ j; if (l > i) cexf(A[i], A[l]); }
    }
}
__device__ __forceinline__ float keyf(float v, unsigned mask, unsigned code) { return __builtin_bit_cast(float, (__builtin_bit_cast(unsigned, v) & mask) | code); }
}

__device__ __forceinline__ void p6a_ldq(const bf16* QP, int tg32, int h, int c, int ln, bf16x8 (&bq)[8]) {
    const bf16* base = QP + ((size_t)(tg32 * 16 + (h * 2 + c)) * 8) * 512 + ln * 8;
#pragma unroll
    for (int s = 0; s < 8; ++s) bq[s] = *(const GAS bf16x8*)(base + 512 * s);
}
template <bool LOADQ, bool PREQ> __device__ __forceinline__ void p6a_top(Frame& F, const bf16* QP, int tg32, int h, int c, int hn, int cn, int hi, int r32, bf16x8 (&bq)[8], bf16x8 (&bqn)[8], float (&top)[16]) {
    int ln = hi * 32 + r32; asm volatile("" : "+v"(ln));
    if (LOADQ) p6a_ldq(QP, tg32, h, c, ln, bq);
    const bf16* ap0 = F_SUBK + (size_t)((h * 2 + c) * 32) * 512 + ln * 8;
    bf16x8 af[8];
#pragma unroll
    for (int s = 0; s < 8; ++s) af[s] = *(const GAS bf16x8*)(ap0 + 512 * s);
    unsigned km = ~127u; asm volatile("" : "+s"(km));
#pragma unroll
    for (int kt = 0; kt < 4; ++kt) {
        f32x16 acc;
#pragma unroll
        for (int r = 0; r < 16; ++r) acc[r] = 0.f;
#pragma unroll
        for (int s = 0; s < 8; ++s) acc = __builtin_amdgcn_mfma_f32_32x32x16_bf16(af[s], bq[s], acc, 0, 0, 0);
        if (kt < 3) {
#pragma unroll
            for (int s = 0; s < 8; ++s) af[s] = *(const GAS bf16x8*)(ap0 + 512 * (8 * (kt + 1) + s));
        }
        if (PREQ && kt == 3) p6a_ldq(QP, tg32, hn, cn, ln, bqn);
        __builtin_amdgcn_sched_group_barrier(0x008, 8, 0);
        if (kt < 3 || PREQ) __builtin_amdgcn_sched_group_barrier(0x020, 8, 0);
        float g[16];
#pragma unroll
        for (int r = 0; r < 16; ++r) g[r] = peer::keyf(acc[r], km, 63u - (unsigned)(16 * kt + r));
        peer::sort16f(g);
        if (kt == 0) {
#pragma unroll
            for (int r = 0; r < 16; ++r) top[r] = g[r];
        } else peer::merge16f(top, g);
    }
    const unsigned hb = hi ? 0u : 64u;
#pragma unroll
    for (int r = 0; r < 16; ++r) top[r] = __builtin_bit_cast(float, __builtin_bit_cast(unsigned, top[r]) | hb);
}
__device__ __forceinline__ void p6a_unit(Frame& F, int unit) {
    LAS unsigned char* L = F.lds + RING_OFF;
    const int lane = F.lane, w = F.wave, hi = lane >> 5, r32 = lane & 31;
    const bf16* QP = F_PROJ;
    const int tg = w & 3, hs = w >> 2;
    const size_t tokrow = (size_t)unit * 128 + tg * 32 + r32;
    LAS unsigned char* myidx = L + peer::IDX_OFF + (w * 64 + lane) * 32;
    const int tg32 = unit * 4 + tg;
    bf16x8 bqa[8], bqb[8];
    { int ln0 = lane; asm volatile("" : "+v"(ln0)); p6a_ldq(QP, tg32, hs * 4, 0, ln0, bqa); }
    for (int hp = 0; hp < 2; ++hp) {
        const int h0 = hs * 4 + 2 * hp, h = h0 + hi;
        const int hnx = hp ? h0 : h0 + 2;
        float s01[2][16];
#define P6A_XMERGE(C) do { \
            _Pragma("unroll") for (int r = 0; r < 16; ++r) { auto rr = __builtin_amdgcn_permlane32_swap(__builtin_bit_cast(unsigned, T0[r]), __builtin_bit_cast(unsigned, T1[r]), false, false); \
                T0[r] = __builtin_bit_cast(float, (unsigned)rr[0]); T1[r] = __builtin_bit_cast(float, (unsigned)rr[1]); }     \
            peer::merge16f(T0, T1); \
            _Pragma("unroll") for (int r = 0; r < 16; ++r) s01[C][r] = T0[r]; } while (0)
        { float T0[16], T1[16];
          p6a_top<false, true>(F, QP, tg32, h0, 0, h0 + 1, 0, hi, r32, bqa, bqb, T0); p6a_top<false, true>(F, QP, tg32, h0 + 1, 0, h0, 1, hi, r32, bqb, bqa, T1);
          P6A_XMERGE(0); }
        { float T0[16], T1[16];
          p6a_top<false, true>(F, QP, tg32, h0, 1, h0 + 1, 1, hi, r32, bqa, bqb, T0); p6a_top<false, true>(F, QP, tg32, h0 + 1, 1, hnx, 0, hi, r32, bqb, bqa, T1);
          P6A_XMERGE(1); }
#undef P6A_XMERGE
        { v4u i0, i1;
#define IDX4(S, o) ((127u - (__builtin_bit_cast(unsigned, (S)[o]) & 127u)) | ((127u - (__builtin_bit_cast(unsigned, (S)[o + 1]) & 127u)) << 8) | ((127u - (__builtin_bit_cast(unsigned, (S)[o + 2]) & 127u)) << 16) | ((127u - (__builtin_bit_cast(unsigned, (S)[o + 3]) & 127u)) << 24))
          i0.x = IDX4(s01[0], 0); i0.y = IDX4(s01[0], 4); i0.z = IDX4(s01[0], 8); i0.w = IDX4(s01[0], 12);
          i1.x = IDX4(s01[1], 0); i1.y = IDX4(s01[1], 4); i1.z = IDX4(s01[1], 8); i1.w = IDX4(s01[1], 12);
#undef IDX4
          *(LAS v4u*)(myidx) = i0; *(LAS v4u*)(myidx + 16) = i1; }
        const float NEG = __builtin_bit_cast(float, 0xFF800000u);
        const float (&f0)[16] = s01[0]; const float (&f1)[16] = s01[1];
#define CK(a, b) peer::keyf(f0[a] + f1[b], ~255u, 255u - (unsigned)(16 * (a) + (b)))
        float best[16], g[16];
#pragma unroll
        for (int b = 0; b < 16; ++b) best[b] = CK(0, b);
#pragma unroll
        for (int a = 1; a < 16; ++a) g[a - 1] = CK(a, 0);
        g[15] = NEG;
        peer::merge16f(best, g);
        g[0] = CK(1, 1); g[1] = CK(1, 2); g[2] = CK(1, 3); g[3] = CK(1, 4); g[4] = CK(1, 5); g[5] = CK(1, 6); g[6] = CK(1, 7);
        g[7] = CK(2, 1); g[8] = CK(2, 2); g[9] = CK(2, 3); g[10] = CK(2, 4); g[11] = CK(3, 1); g[12] = CK(3, 2); g[13] = CK(3, 3); g[14] = CK(4, 1); g[15] = CK(4, 2);
        peer::sort16f(g); peer::merge16f(best, g);
        g[0] = CK(5, 1); g[1] = CK(6, 1); g[2] = CK(7, 1);
#pragma unroll
        for (int r = 3; r < 16; ++r) g[r] = NEG;
        peer::merge16f(best, g);
#undef CK
        float ev[16]; float esum = 0.f; const float vmax = best[0];
#pragma unroll
        for (int k = 0; k < 16; ++k) { ev[k] = __expf(best[k] - vmax); esum += ev[k]; }
        const float einv = 1.f / esum;
        unsigned ent[16];
#pragma unroll
        for (int k = 0; k < 16; ++k) { const unsigned ab = 255u - (__builtin_bit_cast(unsigned, best[k]) & 255u); const unsigned ia = *(const LAS unsigned char*)(myidx + (ab >> 4)), ib = *(const LAS unsigned char*)(myidx + 16 + (ab & 15u));
            ent[k] = (ia * 128u + ib) | (f2bf(ev[k] * einv) << 16); }
        GAS v4u* dst = (GAS v4u*)((GAS unsigned*)(FWS(unsigned, WS_EXPG)) + tokrow * 128 + h * 16);
#pragma unroll
        for (int k = 0; k < 4; ++k) { v4u o; o.x = ent[4 * k]; o.y = ent[4 * k + 1]; o.z = ent[4 * k + 2]; o.w = ent[4 * k + 3]; dst[k] = o; }
    }
}
template <bool DUMMY> __device__ __forceinline__ void p6b_phase(Frame& F) {
    LAS unsigned char* L = F.lds + RING_OFF;
    const int lane = F.lane, w = F.wave;
    const unsigned* EXPG = FWS(unsigned, WS_EXPG);
    LAS unsigned* EW = (LAS unsigned*)(L + peer::W6_OFF + w * 6144);
    LAS _Float16* AH = (LAS _Float16*)(L + peer::W6_OFF + w * 6144 + 4096);
    const int gw = F.vcu * NWAVES + w, NGW = F.G * NWAVES;
    for (int tok0 = gw * 8; tok0 < TT; tok0 += NGW * 8) {
        int ln = lane; asm volatile("" : "+v"(ln));
        const int ts = ln >> 3, dc = ln & 7;
        const unsigned char* ubase = F_U + dc * 16;
        const unsigned char* vbase = F_V + dc * 16;
        const size_t tok = (size_t)tok0 + ts;
#pragma unroll
        for (int i = 0; i < 16; ++i) EW[i * 64 + ln] = EXPG[(size_t)tok0 * 128 + i * 64 + ln];
        float rstd;
        { const float* sq = F_SSQ + tok * 16 + 2 * dc; float ssp = sq[0] + sq[1]; ssp += __shfl_xor(ssp, 1); ssp += __shfl_xor(ssp, 2); ssp += __shfl_xor(ssp, 4);
          rstd = 1.f / sqrtf(ssp * (1.f / 1024.f) + RMS_EPS); }
        unsigned hq[16];
        { const float qs = rstd * (1.f / QSTEP);
#pragma unroll
          for (int q = 0; q < 16; ++q) { float g8[8]; up8(*(const GAS v4u*)(F_XN + tok * 1024 + 64 * q + 8 * dc), g8); unsigned wq = 0u;
#pragma unroll
              for (int e2 = 0; e2 < 8; ++e2) { const int qv = (int)__builtin_rintf(__builtin_fminf(__builtin_fmaxf(g8[e2] * qs, -8.f), 7.f)); wq |= ((unsigned)qv & 15u) << (4 * e2); }
              hq[q] = wq; } }
        const float dscale = QSTEP * QSTEP * (1.f / 32.f);
        LDS_WAIT(); asm volatile("" ::: "memory");
#define P6_ROWLD(R, base_, st_) do { const unsigned e0_ = EW[ts * 128 + 2 * (st_)] & 0xffffu, e1_ = EW[ts * 128 + 2 * (st_) + 1] & 0xffffu; \
            _Pragma("unroll") for (int c = 0; c < 4; ++c) { R[c] = *(const GAS v4u*)((base_) + (size_t)e0_ * 512 + 128 * c); R[4 + c] = *(const GAS v4u*)((base_) + (size_t)e1_ * 512 + 128 * c); } } while (0)
#define P6_IDOT(V4, hq4_, acc_) do { acc_ = __builtin_amdgcn_sdot8((int)(V4).x, (int)hq[(hq4_)], acc_, false); acc_ = __builtin_amdgcn_sdot8((int)(V4).y, (int)hq[(hq4_) + 1], acc_, false); \
            acc_ = __builtin_amdgcn_sdot8((int)(V4).z, (int)hq[(hq4_) + 2], acc_, false); acc_ = __builtin_amdgcn_sdot8((int)(V4).w, (int)hq[(hq4_) + 3], acc_, false); } while (0)
#define P6_DOT2(R, P, j0_) do { int i0_ = 0, i1_ = 0, i2_ = 0, i3_ = 0; \
            P6_IDOT(R[0], 0, i0_); P6_IDOT(R[1], 4, i1_); P6_IDOT(R[2], 8, i0_); P6_IDOT(R[3], 12, i1_); \
            P6_IDOT(R[4], 0, i2_); P6_IDOT(R[5], 4, i3_); P6_IDOT(R[6], 8, i2_); P6_IDOT(R[7], 12, i3_); \
            P[j0_] = (float)(i0_ + i1_); P[(j0_) + 1] = (float)(i2_ + i3_); } while (0)
        {
            v4u ra[8], rb[8];
            P6_ROWLD(ra, ubase, 0);
#pragma unroll 1
            for (int gq = 0; gq < 16; ++gq) {
                float p8[8];
                const int st = 4 * gq;
                P6_ROWLD(rb, ubase, st + 1); P6_DOT2(ra, p8, 0);
                P6_ROWLD(ra, ubase, st + 2); P6_DOT2(rb, p8, 2);
                P6_ROWLD(rb, ubase, st + 3); P6_DOT2(ra, p8, 4);
                if (gq < 15) P6_ROWLD(ra, ubase, st + 4);
                P6_DOT2(rb, p8, 6);
                const float d = peer::transpose_reduce8_dc(p8, lane);
                const unsigned ent = EW[ts * 128 + 8 * gq + dc];
                AH[ts * 128 + 8 * gq + dc] = (_Float16)(__builtin_bit_cast(float, ent & 0xffff0000u) * gelu_tanh(d * dscale));
            }
        }
        LDS_WAIT(); asm volatile("" ::: "memory");
        peer::h16x2 acc[64];
#pragma unroll
        for (int j = 0; j < 64; ++j) acc[j] = (peer::h16x2){(_Float16)0.f, (_Float16)0.f};
#define P6_AXPY2(R, st_) do { const _Float16 a0_ = AH[ts * 128 + 2 * (st_)], a1_ = AH[ts * 128 + 2 * (st_) + 1]; \
            _Pragma("unroll") for (int c = 0; c < 4; ++c) { peer::axpy32h(*(peer::h16x2 (*)[16])(acc + 16 * c), R[c], a0_); peer::axpy32h(*(peer::h16x2 (*)[16])(acc + 16 * c), R[4 + c], a1_); } } while (0)
        {
            v4u ra[8], rb[8];
            P6_ROWLD(ra, vbase, 0);
#pragma unroll 1
            for (int st = 0; st < 64; st += 2) {
                P6_ROWLD(rb, vbase, st + 1); P6_AXPY2(ra, st);
                if (st + 2 < 64) P6_ROWLD(ra, vbase, st + 2);
                P6_AXPY2(rb, st + 1);
            }
        }
#undef P6_ROWLD
#undef P6_DOT2
#undef P6_IDOT
#undef P6_AXPY2
        const float vs = 1.f / VSCALE; float ss = 0.f;
        int ln2 = lane; asm volatile("" : "+v"(ln2));
        const int ts2 = ln2 >> 3, dc2 = ln2 & 7; const size_t tok2 = (size_t)tok0 + ts2;
#pragma unroll
        for (int q = 0; q < 16; ++q) { float g8[8]; up8(*(const GAS v4u*)(F_XN + tok2 * 1024 + 64 * q + 8 * dc2), g8);
#pragma unroll
            for (int e2 = 0; e2 < 4; ++e2) { const peer::h16x2 av = acc[4 * q + e2]; g8[2 * e2] += (float)av.x * vs; g8[2 * e2 + 1] += (float)av.y * vs; }
#pragma unroll
            for (int e2 = 0; e2 < 8; ++e2) ss += g8[e2] * g8[e2]; }
        ss += __shfl_xor(ss, 1); ss += __shfl_xor(ss, 2); ss += __shfl_xor(ss, 4);
        const float rs = 1.f / sqrtf(ss * (1.f / 1024.f) + RMS_EPS);
        int zo = 0; asm volatile("" : "+v"(zo));
#pragma unroll
        for (int q = 0; q < 16; ++q) { const bf16* hp = F_XN + tok2 * 1024 + 64 * q + 8 * dc2 + zo; float* op = (DUMMY ? FWS(float, 160 * MiB) : F_out) + tok2 * 1024 + 64 * q + 8 * dc2; const float* gp = F_lnf + 64 * q + 8 * dc2;
            float g8[8]; up8(*(const GAS v4u*)hp, g8);
#pragma unroll
            for (int e2 = 0; e2 < 4; ++e2) { const peer::h16x2 av = acc[4 * q + e2]; g8[2 * e2] += (float)av.x * vs; g8[2 * e2 + 1] += (float)av.y * vs; }
            const f32x4 ga = *(const GAS f32x4*)gp, gb = *(const GAS f32x4*)(gp + 4);
            *(GAS f32x4*)op = (f32x4){g8[0], g8[1], g8[2], g8[3]} * rs * ga; *(GAS f32x4*)(op + 4) = (f32x4){g8[4], g8[5], g8[6], g8[7]} * rs * gb; }
        LDS_WAIT(); asm volatile("" ::: "memory");
    }
}
__device__ __forceinline__ void p6a_phase(Frame& F) { for (int u = F.vcu; u < TT / 128; u += F.G) p6a_unit(F, u); }
#ifndef HYB
#define HYB 7
#endif
__global__ void __launch_bounds__(NWAVES * 64, 2) mk_fwd(Args args) {
    extern __shared__ __attribute__((aligned(16))) unsigned char lds[];
    Frame F;
    F.lds = (LAS unsigned char*)lds;
    F.MISC = (volatile LAS unsigned*)(F.lds + MISC_OFF);
    F.tid = threadIdx.x; F.lane = F.tid & 63; F.wave = __builtin_amdgcn_readfirstlane(F.tid >> 6);
    F.G = gridDim.x; { const int bx = blockIdx.x; F.vcu = (F.G % 8 == 0) ? (bx % 8) * (F.G / 8) + bx / 8 : bx; }
    F.a = &args;
    F.ctl = (gu32*)(args.ws + WS_CTL);
    for (int u = F.tid; u < (LDS_BYTES - LDSCTL_OFF) / 4; u += NWAVES * 64) ((LAS unsigned*)(F.lds + LDSCTL_OFF))[u] = 0u;
    __syncthreads();
    XcdBarrier bar = xcd_barrier_post((unsigned*)(F.ctl + CW_BAR), F.MISC + 8);
    const int lo = args.ph_lo, hi = args.ph_hi;
#define IN(k) (lo <= (k) && (k) < hi)
#define BOTH(k) (IN(k) && IN((k) + 1))
    if (IN(0)) { p0_prologue(F);
#ifdef DUP_P0
        p0_prologue(F);
#endif
        if (BOTH(0)) xcd_barrier(bar); }
    if (IN(1)) {
        pg8::Gemm g{F_XN, F_WinT, TT, NPROJ, DM}; pg8::StaticOrder S; S.init(TT, NPROJ, F.G, (int)blockIdx.x);
        pg8::EpiProj E{F_PROJ, NPROJ, C_Q / 256, C_KC / 256, QSCALE};
        pg8::gemm_phase<pg8::EpiProj, pg8::StaticOrder, true, true>(F.lds + RING_OFF, g, S, E);
#ifdef DUP_P1
        pg8::gemm_phase<pg8::EpiProj, pg8::StaticOrder, true, true>(F.lds + RING_OFF, g, S, E);
#endif
        if (BOTH(1)) xcd_barrier(bar);
    }
#ifdef DUP_BAR
    if (IN(2)) { for (int zz = 0; zz < 10; ++zz) xcd_barrier(bar); }
#endif
    if (IN(2)) { p2_phase(F);
#ifdef DUP_P2
        p2_phase(F);
#endif
        if (BOTH(2)) xcd_barrier(bar); }
#if HYB >= 4
    if (IN(3)) { p3_attention(F);
#ifdef DUP_P3
        p3_attention(F);
#endif
        if (BOTH(3)) xcd_barrier(bar); }
#endif
#if HYB >= 5
    if (IN(4)) {
        pg8::Gemm g{F_MIXA, F_WoutT, TT, DM, DM}; pg8::StaticOrder S; S.init(TT, DM, F.G, (int)blockIdx.x);
        pg8::EpiResid E{F_x, F_XN, F_SSQ, DM};
        pg8::gemm_phase<pg8::EpiResid, pg8::StaticOrder, true, true>(F.lds + RING_OFF, g, S, E);
#ifdef DUP_P4
        pg8::gemm_phase<pg8::EpiResid, pg8::StaticOrder, true, true>(F.lds + RING_OFF, g, S, E);
#endif
        if (BOTH(4)) xcd_barrier(bar);
    }
#endif
#if HYB >= 6
    if (IN(5)) {
        pg8::Gemm g{F_XN, F_WqT, TT, NQP, DM}; pg8::StaticOrder S; S.init(TT, NQP, F.G, (int)blockIdx.x);
        pg8::EpiScaleRow E{F_PROJ, NQP, F_SSQ, RMS_EPS};
        pg8::gemm_phase<pg8::EpiScaleRow, pg8::StaticOrder, true, true>(F.lds + RING_OFF, g, S, E);
#ifdef DUP_P5
        pg8::gemm_phase<pg8::EpiScaleRow, pg8::StaticOrder, true, true>(F.lds + RING_OFF, g, S, E);
#endif
        if (BOTH(5)) xcd_barrier(bar);
    }
#endif
#if HYB >= 7
    if (IN(6)) { p6a_phase(F);
#ifdef DUP_6A
        p6a_phase(F);
#endif
        xcd_barrier(bar);
#ifdef DUP_6B
        p6b_phase<true>(F);
#endif
        p6b_phase<false>(F); }
#endif
#undef IN
#undef BOTH
}

extern "C" void kernel_launch(void* const* d_in, const int* in_sizes, int n_in, void* d_out, int out_size, void* d_ws, size_t ws_size, hipStream_t stream) {
    static int grid = 0;
    if (grid == 0) {
        if (n_in != 19 || in_sizes[0] != TT * DM || out_size != TT * DM || ws_size < 512 * MiB) { fprintf(stderr, "kernel_launch: unexpected shapes (n_in %d, in0 %d, out %d, ws %zu); nothing launched\n", n_in, n_in > 0 ? in_sizes[0] : -1, out_size, ws_size); grid = -1; return; }
        int dev = 0, cus = 0, per_cu = 0;
        if (hipGetDevice(&dev) != hipSuccess || hipDeviceGetAttribute(&cus, hipDeviceAttributeMultiprocessorCount, dev) != hipSuccess) { grid = -1; return; }
        if (hipFuncSetAttribute((const void*)mk_fwd, hipFuncAttributeMaxDynamicSharedMemorySize, LDS_BYTES) != hipSuccess) { fprintf(stderr, "kernel_launch: hipFuncSetAttribute failed\n"); grid = -1; return; }
        if (hipOccupancyMaxActiveBlocksPerMultiprocessor(&per_cu, (const void*)mk_fwd, NWAVES * 64, LDS_BYTES) != hipSuccess || per_cu < 1) fprintf(stderr, "kernel_launch: note: occupancy query reports %d workgroups per CU\n", per_cu);
        (void)hipGetLastError();
        grid = cus;
    }
    if (grid < 0) return;
    if (hipMemsetAsync((char*)d_ws + WS_CTL, 0, CTL_ZERO_BYTES, stream) != hipSuccess) return;
    Args a{};
    for (int i = 0; i < 19; ++i) a.in[i] = (const float*)d_in[i];
    a.out = (float*)d_out; a.ws = (unsigned char*)d_ws; a.ph_lo = 0; a.ph_hi = HYB;
    hipLaunchKernelGGL(mk_fwd, dim3(grid), dim3(NWAVES * 64), LDS_BYTES, stream, a);
#if HYB < 7
    using namespace nv;
    char* ws = (char*)d_ws;
    const float* x = a.in[0]; const float* conv_w = a.in[3]; const float* pos_k = a.in[4]; const float* pos_v = a.in[5]; const float* k_w1 = a.in[6]; const float* k_w2 = a.in[7]; const float* v_w1 = a.in[8]; const float* v_w2 = a.in[9];
    const float* gn_conv = a.in[10]; const float* gn_attn = a.in[11]; const float* w_out = a.in[12]; const float* ln2 = a.in[13]; const float* wq = a.in[14]; const float* subkeys = a.in[15]; const float* pu = a.in[16]; const float* pv = a.in[17]; const float* lnf = a.in[18];
    float* out = (float*)d_out;
    const bf16* PROJ = (const bf16*)(ws + WS_PROJ); const bf16* MIXA = (const bf16*)(ws + WS_MIXA); const bf16* KCC = (const bf16*)(ws + WS_KCC); const bf16* VCC = (const bf16*)(ws + WS_VCC);
    float* MIXF = (float*)(ws + 32 * MiB);
    float* KCF = (float*)(ws + 420 * MiB); float* VCF = (float*)(ws + 422 * MiB);
    float* QPF = (float*)(ws + 160 * MiB);
    int* EIDX = (int*)(ws + 424 * MiB); float* EGATE = (float*)(ws + 440 * MiB);
#if HYB <= 2
    conv_kernel<bf16><<<TT / 4, 256, 0, stream>>>(PROJ, NPROJ, conv_w, gn_conv, MIXF);
    (void)hipMemsetAsync(KCF, 0, 4 * MiB, stream);
    compress_kernel<bf16><<<BATCH * N_CMP * 2, 256, 0, stream>>>(PROJ, NPROJ, C_KC, pos_k, k_w1, k_w2, KCF);
    compress_kernel<bf16><<<BATCH * N_CMP * 2, 256, 0, stream>>>(PROJ, NPROJ, C_VC, pos_v, v_w1, v_w2, VCF);
    nsa_naive<bf16, float, true><<<TT * 2, 256, 0, stream>>>(PROJ, NPROJ, KCF, VCF, MIXF);
    attn_norm<<<TT / 4, 256, 0, stream>>>(MIXF, gn_attn);
#elif HYB == 3
    cvt_bf16_f32<<<4096, 256, 0, stream>>>(MIXA, 1024, MIXF, 1024, TT, 512);
    nsa_naive<bf16, bf16, true><<<TT * 2, 256, 0, stream>>>(PROJ, NPROJ, KCC, VCC, MIXF);
    attn_norm<<<TT / 4, 256, 0, stream>>>(MIXF, gn_attn);
#elif HYB == 4
    cvt_bf16_f32<<<4096, 256, 0, stream>>>(MIXA, 1024, MIXF, 1024, TT, 1024);
#endif
#if HYB <= 4
    gemm_f32<float, true><<<dim3(1024 / 64, TT / 64), 256, 0, stream>>>(MIXF, 1024, w_out, out, x, TT, 1024, 1024);
#endif
    rmsnorm1024<<<TT / 4, 256, 0, stream>>>(out, ln2, MIXF, TT);
#if HYB <= 5
    gemm_f32<float, false><<<dim3(2048 / 64, TT / 64), 256, 0, stream>>>(MIXF, 1024, wq, QPF, nullptr, TT, 2048, 1024);
    peer_topk<float><<<TT * 8, 128, 0, stream>>>(QPF, subkeys, EIDX, EGATE);
#else
    peer_topk<bf16><<<TT * 8, 128, 0, stream>>>(PROJ, subkeys, EIDX, EGATE);
#endif
    peer_experts<<<TT, 256, 0, stream>>>(MIXF, EIDX, EGATE, pu, pv, lnf, out);
    (void)ln2; (void)KCC; (void)VCC; (void)MIXA;
#endif
}
```

```cpp
#include <hip/hip_runtime.h>
#include <cstdio>
#include <cstdint>
namespace pg8 {
#define PG8_LAS __attribute__((address_space(3)))
typedef unsigned short bf16_t;
typedef short bf16x8 __attribute__((ext_vector_type(8)));
typedef float f32x4 __attribute__((ext_vector_type(4)));
typedef unsigned u32x4 __attribute__((ext_vector_type(4)));
constexpr int BM = 256, BK = 64, HALF = 128, HTB = HALF * BK * 2  , STAGE_BYTES = 8 * HTB, NXCD = 8, WGM = 8;

__host__ __device__ __forceinline__ int lds_byte(int r, int c) { const int st = (r >> 4) * 2 + (c >> 5), rr = r & 15, cc = c & 31, ob = rr * 64 + cc * 2; return st * 1024 + (ob ^ (((ob >> 9) & 1) << 5)); }
__host__ __device__ __forceinline__ void stage_rc(int b, int& R, int& C) { const int st = b / 1024, sb = b % 1024, swz = sb ^ (((sb >> 9) & 1) << 5); R = (st >> 1) * 16 + swz / 64; C = (st & 1) * 32 + (swz % 64) / 2; }
__host__ __device__ __forceinline__ int perm32(int rho) { const int n = rho >> 4, i = rho & 15; return 8 * (i >> 2) + 4 * n + (i & 3); }

struct Unit { int pm, pn; };
struct Gemm { const bf16_t* A; const bf16_t* Bt; int M, N, K; };

struct StaticOrder {
    int nM, nN, nwg, G, c;
    __host__ __device__ void init(int M, int N, int G_, int c_) { nM = M / BM; nN = N / BM; nwg = nM * nN; G = G_; c = c_; }
    __host__ __device__ bool next(int i, Unit& u) const {
        const long L = (long)i * G + c; if (L >= nwg) return false;
        int wgid = (int)L; { const int q = nwg / NXCD, r = nwg % NXCD, xcd = wgid % NXCD, off = wgid / NXCD; wgid = (xcd < r ? xcd * (q + 1) : r * (q + 1) + (xcd - r) * q) + off; }
        const int nig = WGM * nN, gid = wgid / nig, fm = gid * WGM, gsz = (nM - fm) < WGM ? (nM - fm) : WGM;
        u.pm = fm + ((wgid % nig) % gsz); u.pn = (wgid % nig) / gsz; return true;
    }
    __device__ __forceinline__ void a_ready(const Unit&) const {}
    __device__ __forceinline__ void done(const Unit&) const {}
};

__device__ __forceinline__ unsigned cvt_pk_bf16(float lo, float hi) { unsigned r; asm volatile("v_cvt_pk_bf16_f32 %0, %1, %2" : "=v"(r) : "v"(lo), "v"(hi)); return r; }
typedef float f32x2 __attribute__((ext_vector_type(2)));
__device__ __forceinline__ f32x2 gelu_pk(f32x2 v) {
    const f32x2 av = __builtin_elementwise_abs(v), d = av * 0.2316418882f + 1.0f;
    f32x2 t; t.x = __builtin_amdgcn_rcpf(d.x); t.y = __builtin_amdgcn_rcpf(d.y);
    f32x2 q = t * 0.5307027145f + (-0.7265760135f); q = q * t + 0.7107068705f; q = q * t + (-0.142248368f); q = q * t + 0.127414796f; q = q * t;
    const f32x2 s = (v * v) * (-0.72134752044f);
    f32x2 e; e.x = __builtin_amdgcn_exp2f(s.x); e.y = __builtin_amdgcn_exp2f(s.y);
    const f32x2 m = v * (q * e), r = v - m;
    f32x2 o; o.x = v.x < 0.f ? m.x : r.x; o.y = v.y < 0.f ? m.y : r.y; return o;
}

template <int ACT  > struct EpiBf16 {
    static constexpr bool PERM = true, AFTER_DRAIN = false, PRE = false; static_assert(ACT == 0 || ACT == 1, "EpiBf16: ACT is 0 (none) or 1 (gelu_pk)");
    bf16_t* O; int ldc; const float* bias; int split_cols; size_t split_stride; float scale0;
    __device__ __forceinline__ void operator()(const f32x4 (&acc)[2][2][4][2], const Unit& u, int wr, int wc, int fr, int fq) const {
        const int row0 = u.pm * BM + wr * 64 + fr; int colt = u.pn * BM; bf16_t* base = O;
        float sc = 1.f; if (split_cols) { const int t = colt / split_cols; base += (size_t)t * split_stride; colt -= t * split_cols; if (t == 0) sc = scale0; }
        const int col0 = colt + wc * 32 + 8 * fq, bcol0 = u.pn * BM + wc * 32 + 8 * fq;
        f32x4 bv[2][2];
#pragma unroll
        for (int bj = 0; bj < 2; ++bj)
#pragma unroll
            for (int n = 0; n < 2; ++n) bv[bj][n] = bias ? *(const f32x4*)(bias + bcol0 + bj * HALF + 4 * n) : (f32x4){0.f, 0.f, 0.f, 0.f};
#pragma unroll
        for (int ai = 0; ai < 2; ++ai)
#pragma unroll
            for (int m = 0; m < 4; ++m) { bf16_t* rowp = base + (size_t)(row0 + ai * HALF + m * 16) * ldc + col0;
#pragma unroll
                for (int bj = 0; bj < 2; ++bj) { f32x4 v0 = acc[ai][bj][m][0] + bv[bj][0], v1 = acc[ai][bj][m][1] + bv[bj][1];
                    if (ACT == 1) { f32x2 a = gelu_pk((f32x2){v0[0], v0[1]}), b = gelu_pk((f32x2){v0[2], v0[3]}), c = gelu_pk((f32x2){v1[0], v1[1]}), d = gelu_pk((f32x2){v1[2], v1[3]});
                        v0 = (f32x4){a.x, a.y, b.x, b.y}; v1 = (f32x4){c.x, c.y, d.x, d.y}; }
                    v0 = v0 * sc; v1 = v1 * sc; u32x4 w; w.x = cvt_pk_bf16(v0[0], v0[1]); w.y = cvt_pk_bf16(v0[2], v0[3]); w.z = cvt_pk_bf16(v1[0], v1[1]); w.w = cvt_pk_bf16(v1[2], v1[3]);
                    *(u32x4*)(rowp + bj * HALF) = w; } }
    }
};
typedef unsigned u32x2e __attribute__((ext_vector_type(2)));
struct EpiProj {
    static constexpr bool PERM = true, AFTER_DRAIN = false, PRE = false;
    bf16_t* O; int ldc; int qt0, qt1; float qscale;
    __device__ __forceinline__ void operator()(const f32x4 (&acc)[2][2][4][2], const Unit& u, int wr, int wc, int fr, int fq) const {
        const int row0 = u.pm * BM + wr * 64 + fr; const int col0 = u.pn * BM + wc * 32 + 8 * fq;
        const float sc = (u.pn >= qt0 && u.pn < qt1) ? qscale : 1.f;
#pragma unroll
        for (int ai = 0; ai < 2; ++ai)
#pragma unroll
            for (int m = 0; m < 4; ++m) { bf16_t* rowp = O + (size_t)(row0 + ai * HALF + m * 16) * ldc + col0;
#pragma unroll
                for (int bj = 0; bj < 2; ++bj) { const f32x4 v0 = acc[ai][bj][m][0] * sc, v1 = acc[ai][bj][m][1] * sc;
                    u32x4 w; w.x = cvt_pk_bf16(v0[0], v0[1]); w.y = cvt_pk_bf16(v0[2], v0[3]); w.z = cvt_pk_bf16(v1[0], v1[1]); w.w = cvt_pk_bf16(v1[2], v1[3]);
                    *(u32x4*)(rowp + bj * HALF) = w; } }
    }
};
struct EpiResid {
    static constexpr bool PERM = false, AFTER_DRAIN = false, PRE = false;
    const float* base; bf16_t* hb; float* ssq; int ldc;
    __device__ __forceinline__ void operator()(const f32x4 (&acc)[2][2][4][2], const Unit& u, int wr, int wc, int fr, int fq) const {
        const int col0 = u.pn * BM + wc * 32 + 4 * fq;
#pragma unroll
        for (int ai = 0; ai < 2; ++ai)
#pragma unroll
            for (int m = 0; m < 4; ++m) { const int r = u.pm * BM + ai * HALF + wr * 64 + m * 16 + fr; const size_t off = (size_t)r * ldc + col0; float s = 0.f;
#pragma unroll
                for (int bj = 0; bj < 2; ++bj)
#pragma unroll
                    for (int n = 0; n < 2; ++n) { const f32x4 bs = *(const f32x4*)(base + off + bj * HALF + n * 16); const f32x4 o = bs + acc[ai][bj][m][n];
                        s += (o[0] * o[0] + o[1] * o[1]) + (o[2] * o[2] + o[3] * o[3]);
                        u32x2e w; w.x = cvt_pk_bf16(o[0], o[1]); w.y = cvt_pk_bf16(o[2], o[3]); *(u32x2e*)(hb + off + bj * HALF + n * 16) = w; }
                s += __shfl_xor(s, 16); s += __shfl_xor(s, 32);
                if (fq == 0) ssq[(size_t)r * 16 + u.pn * 4 + wc] = s;
                if (m & 1) asm volatile("" ::: "memory"); }
    }
};
struct EpiScaleRow {
    static constexpr bool PERM = true, AFTER_DRAIN = false, PRE = true;
    bf16_t* O; int ldc; const float* ssq; float eps;
    __device__ __forceinline__ void pre(const Unit& u, int wr, int fr, int fq, f32x4 (&pq)[8]) const {
        const int row0 = u.pm * BM + wr * 64 + fr;
#pragma unroll
        for (int m = 0; m < 4; ++m) pq[m] = *(const f32x4*)(ssq + (size_t)(row0 + m * 16) * 16 + 4 * fq);
    }
    __device__ __forceinline__ void operator()(const f32x4 (&acc)[2][2][4][2], const Unit& u, int wr, int wc, int fr, int fq, const f32x4 (&pq)[8]) const {
        const int row0 = u.pm * BM + wr * 64 + fr;
        f32x4 p2[4];
#pragma unroll
        for (int m = 0; m < 4; ++m) p2[m] = *(const f32x4*)(ssq + (size_t)(row0 + HALF + m * 16) * 16 + 4 * fq);
#pragma unroll
        for (int ai = 0; ai < 2; ++ai)
#pragma unroll
            for (int m = 0; m < 4; ++m) { const int r = row0 + ai * HALF + m * 16; const f32x4 t4 = ai ? p2[m] : pq[m]; float tot = (t4[0] + t4[1]) + (t4[2] + t4[3]);
                tot += __shfl_xor(tot, 16); tot += __shfl_xor(tot, 32);
                const float rs = 1.0f / sqrtf(tot * (1.0f / 1024.0f) + eps);
#pragma unroll
                for (int bj = 0; bj < 2; ++bj) { const f32x4 v0 = acc[ai][bj][m][0] * rs, v1 = acc[ai][bj][m][1] * rs;
                    u32x4 w; w.x = cvt_pk_bf16(v0[0], v0[1]); w.y = cvt_pk_bf16(v0[2], v0[3]); w.z = cvt_pk_bf16(v1[0], v1[1]); w.w = cvt_pk_bf16(v1[2], v1[3]);
                    const size_t blk = ((size_t)(r >> 5) * 16 + (u.pn * 2 + bj)) * 8 + (2 * wc + (fq >> 1));
                    *(u32x4*)(O + blk * 512 + ((fq & 1) * 32 + (r & 31)) * 8) = w; } }
    }
};

template <class Epi, class Sched, bool ALIGN_EPI = false, bool SP2 = false>
__device__ __forceinline__ void gemm_phase(PG8_LAS unsigned char* lds, const Gemm g, const Sched& S, const Epi& E) {
    const int tid = threadIdx.x, wid = __builtin_amdgcn_readfirstlane(tid >> 6), lane = tid & 63, wr = wid >> 2, wc = wid & 3, fr = lane & 15, fq = lane >> 4;
    const int K = g.K, nt = K / BK;
    unsigned voffA[2], voffB[2];
#pragma unroll
    for (int i = 0; i < 2; ++i) { int R, C; stage_rc(tid * 16 + i * 8192, R, C); const int Rb = Epi::PERM ? ((R & ~31) + perm32(R & 31)) : R;
        voffA[i] = (unsigned)(R * K + C) * 2u; voffB[i] = (unsigned)(Rb * K + C) * 2u; }
    const size_t kstep = (size_t)(BK * 2);
    const size_t hstep = (size_t)HALF * K * 2;
    const size_t tstep = 2 * hstep;
    const unsigned ldsw = (unsigned)wid * 1024u;
    const int aoff = lds_byte(wr * 64 + fr, fq * 8), boff = lds_byte(wc * 32 + fr, fq * 8);
#define PG8_SA(b, h) (((b) * 2 + (h)) * HTB)
#define PG8_SB(b, h) ((4 + (b) * 2 + (h)) * HTB)
#define PG8_STAGE(bufoff, gbase, voff) do { _Pragma("unroll") for (int _i = 0; _i < 2; ++_i) \
        __builtin_amdgcn_global_load_lds((const unsigned*)((const char*)(gbase) + (voff)[_i]), (PG8_LAS unsigned*)(lds + (bufoff) + ldsw + _i * 8192), 16, 0, 0); } while (0)
#define PG8_LDA(dst, b, h) do { _Pragma("unroll") for (int m = 0; m < 4; ++m) _Pragma("unroll") for (int k = 0; k < 2; ++k) dst[m][k] = *(const PG8_LAS bf16x8*)(lds + PG8_SA(b, h) + aoff + m * 2048 + k * 1024); } while (0)
#define PG8_LDB(dst, b, h) do { _Pragma("unroll") for (int n = 0; n < 2; ++n) _Pragma("unroll") for (int k = 0; k < 2; ++k) dst[n][k] = *(const PG8_LAS bf16x8*)(lds + PG8_SB(b, h) + boff + n * 2048 + k * 1024); } while (0)
#define PG8_MMA(ai, bj, At, Bt) do { __builtin_amdgcn_s_setprio(1); _Pragma("unroll") for (int m = 0; m < 4; ++m) _Pragma("unroll") for (int n = 0; n < 2; ++n) _Pragma("unroll") for (int k = 0; k < 2; ++k) \
        acc[ai][bj][m][n] = __builtin_amdgcn_mfma_f32_16x16x32_bf16(Bt[n][k], At[m][k], acc[ai][bj][m][n], 0, 0, 0); __builtin_amdgcn_s_setprio(0); } while (0)
#define PG8_WAIT_V(n) asm volatile("s_waitcnt vmcnt(" #n ")" ::: "memory")
#define PG8_WAIT_L(n) asm volatile("s_waitcnt lgkmcnt(" #n ")" ::: "memory")
#define PG8_BAR __builtin_amdgcn_s_barrier()
#define PG8_SCHED __builtin_amdgcn_sched_barrier(0)
    Unit cur, nxt; int ui = 0;
    if (!S.next(0, cur)) return;
    f32x4 acc[2][2][4][2];
#pragma unroll
    for (int a = 0; a < 2; ++a)
#pragma unroll
        for (int b = 0; b < 2; ++b)
#pragma unroll
            for (int m = 0; m < 4; ++m)
#pragma unroll
                for (int n = 0; n < 2; ++n) acc[a][b][m][n] = (f32x4){0.f, 0.f, 0.f, 0.f};
    bf16x8 At[4][2], B0[2][2], B1[2][2];
    const char* cA = (const char*)g.A + (size_t)cur.pm * tstep; const char* cB = (const char*)g.Bt + (size_t)cur.pn * tstep;
    S.a_ready(cur);
    if constexpr (SP2) {
        PG8_STAGE(PG8_SB(0, 0), cB, voffB); PG8_STAGE(PG8_SB(0, 1), cB + hstep, voffB); PG8_STAGE(PG8_SA(0, 0), cA, voffA); PG8_STAGE(PG8_SA(0, 1), cA + hstep, voffA);
        if (wr == 1) PG8_BAR;
        PG8_WAIT_V(2); PG8_BAR;
        PG8_STAGE(PG8_SB(1, 0), cB + kstep, voffB); PG8_STAGE(PG8_SA(1, 0), cA + kstep, voffA); PG8_STAGE(PG8_SB(1, 1), cB + hstep + kstep, voffB);
        PG8_WAIT_V(6); PG8_BAR;
    } else {
        PG8_STAGE(PG8_SB(0, 0), cB, voffB); PG8_STAGE(PG8_SA(0, 0), cA, voffA); PG8_STAGE(PG8_SB(0, 1), cB + hstep, voffB); PG8_STAGE(PG8_SA(0, 1), cA + hstep, voffA);
        if (wr == 1) PG8_BAR;
        PG8_WAIT_V(4); PG8_BAR;
        PG8_STAGE(PG8_SB(1, 0), cB + kstep, voffB); PG8_STAGE(PG8_SA(1, 0), cA + kstep, voffA); PG8_STAGE(PG8_SB(1, 1), cB + hstep + kstep, voffB);
        PG8_WAIT_V(6); PG8_BAR;
    }
    for (;;) {
        const bool has_next = S.next(ui + 1, nxt);
        const char* nA = has_next ? (const char*)g.A + (size_t)nxt.pm * tstep : cA; const char* nB = has_next ? (const char*)g.Bt + (size_t)nxt.pn * tstep : cB;
        f32x4 epre[8]; if constexpr (Epi::PRE) E.pre(cur, wr, fr, fq, epre);
        for (int t = 0; t < nt; t += 2) {
            const bool last = (t == nt - 2);
            const char* a1 = cA + (size_t)(t + 1) * kstep;
            const char* a2 = last ? nA : cA + (size_t)(t + 2) * kstep; const char* b2 = last ? nB : cB + (size_t)(t + 2) * kstep;
            const char* a3 = a2 + kstep; const char* b3 = b2 + kstep;
            if (last && has_next) S.a_ready(nxt);
            if constexpr (SP2) {
            PG8_LDB(B0, 0, 0); PG8_LDB(B1, 0, 1); PG8_SCHED; PG8_LDA(At, 0, 0); PG8_STAGE(PG8_SA(1, 1), a1 + hstep, voffA);
            PG8_WAIT_V(8); PG8_WAIT_L(0); PG8_BAR; PG8_MMA(0, 0, At, B0); PG8_MMA(0, 1, At, B1); PG8_BAR; PG8_SCHED;
            PG8_LDA(At, 0, 1); PG8_STAGE(PG8_SB(0, 0), b2, voffB); PG8_STAGE(PG8_SB(0, 1), b2 + hstep, voffB); PG8_STAGE(PG8_SA(0, 0), a2, voffA);
            PG8_WAIT_V(8); PG8_WAIT_L(0); PG8_BAR; PG8_MMA(1, 0, At, B0); PG8_MMA(1, 1, At, B1); PG8_BAR; PG8_SCHED;
            PG8_LDB(B0, 1, 0); PG8_LDB(B1, 1, 1); PG8_SCHED; PG8_LDA(At, 1, 0); PG8_STAGE(PG8_SA(0, 1), a2 + hstep, voffA);
            PG8_WAIT_V(8); PG8_WAIT_L(0); PG8_BAR; PG8_MMA(0, 0, At, B0); PG8_MMA(0, 1, At, B1); PG8_BAR; PG8_SCHED;
            PG8_LDA(At, 1, 1); PG8_STAGE(PG8_SB(1, 0), b3, voffB); PG8_STAGE(PG8_SB(1, 1), b3 + hstep, voffB); PG8_STAGE(PG8_SA(1, 0), a3, voffA);
            PG8_WAIT_V(8); PG8_WAIT_L(0); PG8_BAR; PG8_MMA(1, 0, At, B0); PG8_MMA(1, 1, At, B1); PG8_BAR; PG8_SCHED;
            } else {
            PG8_LDB(B0, 0, 0); PG8_SCHED; PG8_LDA(At, 0, 0); PG8_STAGE(PG8_SA(1, 1), a1 + hstep, voffA);
            PG8_WAIT_L(8); PG8_BAR; PG8_WAIT_L(0); PG8_MMA(0, 0, At, B0); PG8_BAR; PG8_SCHED;
            PG8_LDB(B1, 0, 1); PG8_STAGE(PG8_SB(0, 0), b2, voffB);
            PG8_BAR; PG8_WAIT_L(0); PG8_MMA(0, 1, At, B1); PG8_BAR;
            PG8_LDA(At, 0, 1); PG8_STAGE(PG8_SA(0, 0), a2, voffA);
            PG8_BAR; PG8_WAIT_L(0); PG8_MMA(1, 0, At, B0); PG8_BAR; PG8_SCHED;
            PG8_STAGE(PG8_SB(0, 1), b2 + hstep, voffB);
            PG8_WAIT_V(6); PG8_BAR; PG8_MMA(1, 1, At, B1); PG8_BAR;
            PG8_LDB(B0, 1, 0); PG8_SCHED; PG8_LDA(At, 1, 0); PG8_STAGE(PG8_SA(0, 1), a2 + hstep, voffA);
            PG8_WAIT_L(8); PG8_BAR; PG8_WAIT_L(0); PG8_MMA(0, 0, At, B0); PG8_BAR; PG8_SCHED;
            PG8_LDB(B1, 1, 1); PG8_STAGE(PG8_SB(1, 0), b3, voffB);
            PG8_BAR; PG8_WAIT_L(0); PG8_MMA(0, 1, At, B1); PG8_BAR;
            PG8_LDA(At, 1, 1); PG8_STAGE(PG8_SA(1, 0), a3, voffA);
            PG8_BAR; PG8_WAIT_L(0); PG8_MMA(1, 0, At, B0); PG8_BAR; PG8_SCHED;
            PG8_STAGE(PG8_SB(1, 1), b3 + hstep, voffB);
            PG8_WAIT_V(6); PG8_BAR; PG8_MMA(1, 1, At, B1); PG8_BAR;
            }
        }
        if constexpr (ALIGN_EPI) { if (wr == 0) PG8_BAR; }
        if constexpr (!Epi::AFTER_DRAIN) { if constexpr (Epi::PRE) E(acc, cur, wr, wc, fr, fq, epre); else E(acc, cur, wr, wc, fr, fq); S.done(cur); }
        if (!has_next) break;
#pragma unroll
        for (int a = 0; a < 2; ++a)
#pragma unroll
            for (int b = 0; b < 2; ++b)
#pragma unroll
                for (int m = 0; m < 4; ++m)
#pragma unroll
                    for (int n = 0; n < 2; ++n) acc[a][b][m][n] = (f32x4){0.f, 0.f, 0.f, 0.f};
        cur = nxt; cA = nA; cB = nB; ++ui;
        if constexpr (ALIGN_EPI) { if (wr == 1) PG8_BAR; }
    }
    PG8_WAIT_V(0);
    if constexpr (!ALIGN_EPI) { if (wr == 0) PG8_BAR; }
    PG8_BAR;
    if constexpr (Epi::AFTER_DRAIN) { E.fused(acc, cur, wr, wc, fr, fq, lds, wid, lane); S.done(cur); }
#undef PG8_SA
#undef PG8_SB
#undef PG8_STAGE
#undef PG8_LDA
#undef PG8_LDB
#undef PG8_MMA
#undef PG8_WAIT_V
#undef PG8_WAIT_L
#undef PG8_BAR
#undef PG8_SCHED
}
}
#define GAS __attribute__((address_space(1)))
#define LAS __attribute__((address_space(3)))
typedef unsigned short bf16;
typedef unsigned v4u __attribute__((ext_vector_type(4)));
typedef unsigned v2u __attribute__((ext_vector_type(2)));
typedef float f32x4 __attribute__((ext_vector_type(4)));
typedef float f32x16 __attribute__((ext_vector_type(16)));
typedef float f32x2 __attribute__((ext_vector_type(2)));
typedef short bf16x8 __attribute__((ext_vector_type(8)));
typedef short s16x4 __attribute__((ext_vector_type(4)));
typedef __bf16 bf16x2v __attribute__((ext_vector_type(2)));
typedef GAS unsigned gu32;
typedef GAS unsigned long long gu64;
#define RLX_AGENT __ATOMIC_RELAXED, __HIP_MEMORY_SCOPE_AGENT
#define LDS_WAIT() asm volatile("s_waitcnt lgkmcnt(0)" ::: "memory")
#define VM_WAIT() asm volatile("s_waitcnt vmcnt(0)" ::: "memory")
__device__ __forceinline__ unsigned f2bf(float f) { unsigned u = __builtin_bit_cast(unsigned, f); return (u + 0x7fffu + ((u >> 16) & 1u)) >> 16; }
__device__ __forceinline__ unsigned pk2(float lo, float hi) { return f2bf(lo) | (f2bf(hi) << 16); }
__device__ __forceinline__ float bf2f(unsigned short b) { return __builtin_bit_cast(float, (unsigned)b << 16); }
__device__ __forceinline__ float bflo(unsigned w) { return __builtin_bit_cast(float, w << 16); }
__device__ __forceinline__ float bfhi(unsigned w) { return __builtin_bit_cast(float, w & 0xffff0000u); }
__device__ __forceinline__ float wave_sum(float v) {
#pragma unroll
    for (int o = 1; o < 64; o <<= 1) v += __shfl_xor(v, o);
    return v;
}
__device__ __forceinline__ float wave_max(float v) {
#pragma unroll
    for (int o = 1; o < 64; o <<= 1) v = fmaxf(v, __shfl_xor(v, o));
    return v;
}
__device__ __forceinline__ float gelu_tanh(float x) {
    const float u = 0.7978845608028654f * (x + 0.044715f * x * x * x);
    const float e = __expf(2.f * u);
    const float th = 1.f - 2.f / (e + 1.f);
    return 0.5f * x * (1.f + th);
}

#define XB_TMO      128
#define XB_XCNT(j)  (256  + 64 * (j))
#define XB_XSUB(j)  (1280 + 64 * (j))
#define XB_XGEN(j)  (2304 + 64 * (j))
#define XB_TOP      3328
#define XB_TOPGEN   3392
#define XCD_BAR_WORDS 3456
#define XB_SPIN_CAP (1u << 18)

__device__ __forceinline__ unsigned xb_ld(unsigned* p)              { return __hip_atomic_load(p, __ATOMIC_RELAXED, __HIP_MEMORY_SCOPE_AGENT); }
__device__ __forceinline__ unsigned xb_add(unsigned* p, unsigned v) { return __hip_atomic_fetch_add(p, v, __ATOMIC_RELAXED, __HIP_MEMORY_SCOPE_AGENT); }
__device__ __forceinline__ unsigned xb_xcc_id() { return (unsigned)__builtin_amdgcn_s_getreg((3 << 11) | 20) & 0xFu; }
#define XB_SPIN(cond, bar) do { unsigned _sp = 0; while (cond) { __builtin_amdgcn_s_sleep(1); \
    if ((++_sp & 255u) == 0u) { if (xb_ld(&(bar)[XB_TMO])) break; if (_sp > XB_SPIN_CAP) { atomicAdd(&(bar)[XB_TMO], 1u); break; } } } } while (0)

struct XcdBarrier {
    unsigned* bar; unsigned x;
    volatile LAS unsigned* st;
};

__device__ __forceinline__ XcdBarrier xcd_barrier_post(unsigned* bar, volatile LAS unsigned* st) {
    XcdBarrier b; b.bar = bar; b.x = xb_xcc_id(); b.st = st;
    if (threadIdx.x == 0) (void)xb_add(&bar[XB_XCNT(b.x)], 1u);
    return b;
}
__device__ __forceinline__ void xcd_barrier_complete(unsigned* bar, unsigned x, unsigned& nloc, unsigned& nx) {
    const unsigned G = gridDim.x * gridDim.y * gridDim.z;
    unsigned sum, cnt, mine, sp = 0u;
    for (;;) {
        sum = 0u; cnt = 0u; mine = 0u;
#pragma unroll
        for (unsigned j = 0; j < 16; ++j) { const unsigned c = xb_ld(&bar[XB_XCNT(j)]); sum += c; cnt += (c > 0u) ? 1u : 0u; mine = (j == x) ? c : mine; }
        if (sum == G) break;
        __builtin_amdgcn_s_sleep(1);
        if ((++sp & 255u) == 0u) { if (xb_ld(&bar[XB_TMO])) break; if (sp > XB_SPIN_CAP) { atomicAdd(&bar[XB_TMO], 1u); break; } }
    }
    nloc = mine > 0u ? mine : 1u; nx = cnt > 0u ? cnt : 1u;
}

__device__ __forceinline__ void xcd_barrier(const XcdBarrier& b) {
    asm volatile("s_waitcnt vmcnt(0)" ::: "memory");
    __syncthreads();
    if (threadIdx.x == 0) {
        unsigned* bar = b.bar;
        __builtin_amdgcn_s_waitcnt(0);
        unsigned nloc = b.st[0], nx = b.st[1];
        if (nloc == 0u) { xcd_barrier_complete(bar, b.x, nloc, nx); b.st[0] = nloc; b.st[1] = nx; }
        const unsigned old = xb_add(&bar[XB_XSUB(b.x)], 1u);
        const unsigned gen = old / nloc;
        if (old + 1u == (gen + 1u) * nloc) {
            __builtin_amdgcn_fence(__ATOMIC_RELEASE, "agent");
            asm volatile("s_waitcnt vmcnt(0)" ::: "memory");
            const unsigned og = xb_add(&bar[XB_TOP], 1u);
            const unsigned tg = og / nx;
            if (og + 1u == (tg + 1u) * nx) xb_add(&bar[XB_TOPGEN], 1u);
            else XB_SPIN(xb_ld(&bar[XB_TOPGEN]) == tg, bar);
            __builtin_amdgcn_fence(__ATOMIC_ACQUIRE, "agent");
            xb_add(&bar[XB_XGEN(b.x)], 1u);
            asm volatile("s_waitcnt vmcnt(0)" ::: "memory");
        } else {
            XB_SPIN(xb_ld(&bar[XB_XGEN(b.x)]) == gen, bar);
            __builtin_amdgcn_fence(__ATOMIC_ACQUIRE, "agent");
            asm volatile("s_waitcnt vmcnt(0)" ::: "memory");
        }
    }
    __syncthreads();
}
constexpr int NWAVES = 8;
constexpr int BATCH = 8, SEQ = 4096, TT = BATCH * SEQ, DM = 1024;
constexpr int NPROJ = 3072, IN_COLS = 2840;
constexpr int C_H = 0, C_B = 512, C_C = 1024, C_Q = 1536, C_KC = 2048, C_VC = 2176, C_KS = 2304, C_VS = 2432, C_KW = 2560, C_VW = 2688, C_G = 2816;
constexpr int NQP = 2048;
constexpr float RMS_EPS = 1e-6f;
constexpr float QSCALE = 0.125f * 1.4426950408889634f;
constexpr size_t MiB = 1u << 20;
constexpr size_t WS_CTL = 0, CTL_ZERO_BYTES = 32768;
constexpr size_t WS_WIN = 2 * MiB, WS_WOUT = 8 * MiB, WS_WQ = 10 * MiB, WS_KW1 = 14 * MiB, WS_VW1 = 15 * MiB, WS_KW2 = 16 * MiB, WS_VW2 = 16 * MiB + 65536, WS_B1 = 16 * MiB + 131072, WS_SUBK = 17 * MiB;
constexpr size_t WS_U = 32 * MiB, WS_V = 48 * MiB;
constexpr float QSTEP = 0.3352f;
constexpr float USCALE = 32.f / QSTEP, VSCALE = 4.f;
constexpr int NSL = 4;
constexpr size_t WS_XN = 96 * MiB;
constexpr size_t WS_PROJ = 160 * MiB;
constexpr size_t WS_MIXA = 352 * MiB;
constexpr size_t WS_KCC = 416 * MiB, WS_VCC = 417 * MiB;
constexpr size_t WS_SSQ = 418 * MiB;
constexpr size_t WS_EXPG = 64 * MiB, WS_AG = 80 * MiB, WS_DGP = 288 * MiB, WS_SSQF = 420 * MiB;
constexpr size_t WS_END = 421 * MiB;
constexpr int CW_BAR = 4096;
constexpr int RING_OFF = 0, RING_BYTES = 131072;
constexpr int LDSCTL_OFF = RING_BYTES, MISC_OFF = LDSCTL_OFF + 320;
constexpr int LDS_BYTES = 155648;

struct Args { const float* in[19]; float* out; unsigned char* ws; int ph_lo, ph_hi; };
struct Frame {
    LAS unsigned char* lds;
    volatile LAS unsigned* MISC;
    gu32* ctl;
    int tid, lane, wave;
    int vcu, G;
    const Args* a;
};
#define FIN(k) (F.a->in[k])
#define FWS(T, off) ((T*)(F.a->ws + (off)))
#define F_x FIN(0)
#define F_ln1 FIN(1)
#define F_w_in FIN(2)
#define F_conv_w FIN(3)
#define F_pos_k FIN(4)
#define F_pos_v FIN(5)
#define F_k_w1 FIN(6)
#define F_k_w2 FIN(7)
#define F_v_w1 FIN(8)
#define F_v_w2 FIN(9)
#define F_gn_conv FIN(10)
#define F_gn_attn FIN(11)
#define F_w_out FIN(12)
#define F_ln2 FIN(13)
#define F_wq FIN(14)
#define F_subkeys FIN(15)
#define F_pu FIN(16)
#define F_pv FIN(17)
#define F_lnf FIN(18)
#define F_out (F.a->out)
#define F_WinT FWS(bf16, WS_WIN)
#define F_WoutT FWS(bf16, WS_WOUT)
#define F_WqT FWS(bf16, WS_WQ)
#define F_KW1T FWS(bf16, WS_KW1)
#define F_VW1T FWS(bf16, WS_VW1)
#define F_KW2T FWS(bf16, WS_KW2)
#define F_VW2T FWS(bf16, WS_VW2)
#define F_SUBK FWS(bf16, WS_SUBK)
#define F_U FWS(unsigned char, WS_U)
#define F_V FWS(unsigned char, WS_V)
#define F_XN FWS(bf16, WS_XN)
#define F_PROJ FWS(bf16, WS_PROJ)
#define F_MIXA FWS(bf16, WS_MIXA)
#define F_KCC FWS(bf16, WS_KCC)
#define F_VCC FWS(bf16, WS_VCC)
#define F_B1 FWS(float, WS_B1)
#define F_SSQ FWS(float, WS_SSQ)

__device__ __forceinline__ void p0_transpose_item(const float* W, int K, int N, bf16* WT, const float* kscale, LAS float* scr, int item, int nblk, int lane, bool frag = false) {
    const int kb = item / nblk, nb = item % nblk, k0 = 64 * kb, n0 = 32 * nb;
#pragma unroll
    for (int i = 0; i < 32; ++i) { const int kk = 2 * i + (lane >> 5); const int n = n0 + (lane & 31); float v = (n < N) ? W[(size_t)(k0 + kk) * N + n] : 0.f; if (kscale) v *= kscale[k0 + kk]; scr[kk * 33 + (lane & 31)] = v; }
    LDS_WAIT(); asm volatile("" ::: "memory");
    const int c = lane & 7;
#pragma unroll
    for (int j = 0; j < 4; ++j) { const int n = (lane >> 3) + 8 * j; const LAS float* s = scr + (8 * c) * 33 + n;
        v4u o; o.x = pk2(s[0 * 33], s[1 * 33]); o.y = pk2(s[2 * 33], s[3 * 33]); o.z = pk2(s[4 * 33], s[5 * 33]); o.w = pk2(s[6 * 33], s[7 * 33]);
        const int na = n0 + n, ka = k0 + 8 * c;
        const size_t off = frag ? ((size_t)((na >> 4) * 64 + (ka >> 5)) * 64 + (((ka >> 3) & 3) * 16 + (na & 15))) * 8 : (size_t)na * K + ka;
        *(GAS v4u*)(WT + off) = o; }
    LDS_WAIT(); asm volatile("" ::: "memory");
}
__device__ __forceinline__ void p0_cvt_item(const float* src, bf16* dst, const float* cscale, size_t item, int lane) {
    const size_t idx = item * 512 + (size_t)lane * 8;
    f32x4 a = *(const GAS f32x4*)(src + idx), b = *(const GAS f32x4*)(src + idx + 4);
    if (cscale) { const int d = (int)(idx & 1023); const f32x4 sa = *(const GAS f32x4*)(cscale + d), sb = *(const GAS f32x4*)(cscale + d + 4); a = a * sa; b = b * sb; }
    v4u o; o.x = pk2(a[0], a[1]); o.y = pk2(a[2], a[3]); o.z = pk2(b[0], b[1]); o.w = pk2(b[2], b[3]);
    *(GAS v4u*)(dst + idx) = o;
}
__device__ __forceinline__ void p0_cvt4_load(const float* src, size_t item0, int lane, f32x4 (&a)[4], f32x4 (&b)[4]) {
#pragma unroll
    for (int u = 0; u < 4; ++u) { const size_t idx = (item0 + u) * 512 + (size_t)lane * 8; a[u] = *(const GAS f32x4*)(src + idx); b[u] = *(const GAS f32x4*)(src + idx + 4); }
}
__device__ __forceinline__ void p0_cvt4_conv(const f32x4 (&a)[4], const f32x4 (&b)[4], unsigned char* dst, const float* cscale, float scale, bool as_int4, size_t item0, int lane) {
#pragma unroll
    for (int u = 0; u < 4; ++u) {
        const size_t idx = (item0 + u) * 512 + (size_t)lane * 8; const int col = (int)(idx & 1023);
        f32x4 x = a[u] * scale, y = b[u] * scale;
        if (cscale) { const f32x4 sa = *(const GAS f32x4*)(cscale + col), sb = *(const GAS f32x4*)(cscale + col + 4); x = x * sa; y = y * sb; }
        unsigned w = 0u;
        if (as_int4) {
#pragma unroll
            for (int e4 = 0; e4 < 4; ++e4) { const int qa = (int)__builtin_rintf(__builtin_fminf(__builtin_fmaxf(x[e4], -8.f), 7.f)), qb = (int)__builtin_rintf(__builtin_fminf(__builtin_fmaxf(y[e4], -8.f), 7.f));
                w |= ((unsigned)qa & 15u) << (4 * e4); w |= ((unsigned)qb & 15u) << (16 + 4 * e4); }
        } else {
        w = __builtin_amdgcn_cvt_scalef32_pk_fp4_f32(w, x[0], x[1], 1.0f, 0); w = __builtin_amdgcn_cvt_scalef32_pk_fp4_f32(w, x[2], x[3], 1.0f, 1);
        w = __builtin_amdgcn_cvt_scalef32_pk_fp4_f32(w, y[0], y[1], 1.0f, 2); w = __builtin_amdgcn_cvt_scalef32_pk_fp4_f32(w, y[2], y[3], 1.0f, 3);
        }
        const size_t e = idx >> 10; const int q = col >> 6, dc = (col >> 3) & 7;
        *(GAS unsigned*)(dst + e * 512 + 128 * (q >> 2) + 16 * dc + 4 * (q & 3)) = w;
    }
}
__device__ __forceinline__ void rms_row_load(const float* xrow, int lane, f32x4 (&v)[4]) {
    const GAS f32x4* xr = (const GAS f32x4*)xrow + lane;
#pragma unroll
    for (int j = 0; j < 4; ++j) v[j] = xr[64 * j];
}
__device__ __forceinline__ void rms_row_finish(const f32x4 (&v)[4], const f32x4 (&g)[4], bf16* orow, int lane) {
    float s = 0.f;
#pragma unroll
    for (int j = 0; j < 4; ++j) s += (v[j].x * v[j].x + v[j].y * v[j].y) + (v[j].z * v[j].z + v[j].w * v[j].w);
    const float rstd = 1.f / sqrtf(wave_sum(s) * (1.f / DM) + RMS_EPS);
    GAS v2u* o8 = (GAS v2u*)orow + lane;
#pragma unroll
    for (int j = 0; j < 4; ++j) { v2u w; w.x = pk2(v[j].x * rstd * g[j].x, v[j].y * rstd * g[j].y); w.y = pk2(v[j].z * rstd * g[j].z, v[j].w * rstd * g[j].w); o8[64 * j] = w; }
}
__device__ __forceinline__ void p0_prologue(Frame& F) {
    LAS float* scr = (LAS float*)(F.lds + RING_OFF + F.wave * 16384);
    const int gw = F.vcu * NWAVES + F.wave, NGW = F.G * NWAVES, lane = F.lane;
    constexpr int I_IN = 16 * 96, I_OUT = 16 * 32, I_Q = 16 * 64, I_W1 = 32 * 8, I_W2 = 4 * 2;
    constexpr int NTR = I_IN + I_OUT + I_Q + 2 * I_W1 + 2 * I_W2;
    for (int it = gw; it < NTR; it += NGW) {
        int r = it;
        if (r < I_IN) { p0_transpose_item(F_w_in, 1024, IN_COLS, F_WinT, nullptr, scr, r, 96, lane); continue; } r -= I_IN;
        if (r < I_OUT) { p0_transpose_item(F_w_out, 1024, 1024, F_WoutT, nullptr, scr, r, 32, lane); continue; } r -= I_OUT;
        if (r < I_Q) { p0_transpose_item(F_wq, 1024, NQP, F_WqT, F_ln2, scr, r, 64, lane); continue; } r -= I_Q;
        if (r < I_W1) { p0_transpose_item(F_k_w1, 2048, 256, F_KW1T, nullptr, scr, r, 8, lane, true); continue; } r -= I_W1;
        if (r < I_W1) { p0_transpose_item(F_v_w1, 2048, 256, F_VW1T, nullptr, scr, r, 8, lane, true); continue; } r -= I_W1;
        if (r < I_W2) { p0_transpose_item(F_k_w2, 256, 64, F_KW2T, nullptr, scr, r, 2, lane); continue; } r -= I_W2;
        p0_transpose_item(F_v_w2, 256, 64, F_VW2T, nullptr, scr, r, 2, lane);
    }
    for (int it = (gw + 512) % NGW; it < 512; it += NGW) { const int mat = it >> 8, j = it & 255; const float* pos = mat ? F_pos_v : F_pos_k; const float* w1 = mat ? F_v_w1 : F_k_w1;
        float a = 0.f; for (int i = lane; i < 2048; i += 64) a += pos[i] * w1[(size_t)i * 256 + j];
        a = wave_sum(a); if (lane == 0) F_B1[it] = a; }
    for (int it = gw; it < 512; it += NGW) { const int s8 = it & 7, kt = (it >> 3) & 3, hc = it >> 5, hi = lane >> 5, r32 = lane & 31; const int key = 16 * kt + (r32 & 3) + 4 * (r32 >> 3) + 64 * ((r32 >> 2) & 1);
        const float* src = F_subkeys + ((size_t)(hc * 128 + key) * 128 + 16 * s8 + 8 * hi); const f32x4 a = *(const GAS f32x4*)src, b = *(const GAS f32x4*)(src + 4);
        v4u o; o.x = pk2(a[0], a[1]); o.y = pk2(a[2], a[3]); o.z = pk2(b[0], b[1]); o.w = pk2(b[2], b[3]); *(GAS v4u*)(F_SUBK + (size_t)it * 512 + lane * 8) = o; }
    {
        f32x4 ua0[4], ub0[4], va0[4], vb0[4], ua1[4], ub1[4], va1[4], vb1[4];
        int it = gw;
        if (it < 8192) { p0_cvt4_load(F_pu, (size_t)it * 4, lane, ua0, ub0); p0_cvt4_load(F_pv, (size_t)it * 4, lane, va0, vb0); }
        for (; it < 8192; it += 2 * NGW) {
            const int i1 = it + NGW, i2 = it + 2 * NGW;
            if (i1 < 8192) { p0_cvt4_load(F_pu, (size_t)i1 * 4, lane, ua1, ub1); p0_cvt4_load(F_pv, (size_t)i1 * 4, lane, va1, vb1); }
            p0_cvt4_conv(ua0, ub0, F_U, F_ln2, USCALE, true, (size_t)it * 4, lane); p0_cvt4_conv(va0, vb0, F_V, nullptr, VSCALE, false, (size_t)it * 4, lane);
            if (i1 < 8192) {
                if (i2 < 8192) { p0_cvt4_load(F_pu, (size_t)i2 * 4, lane, ua0, ub0); p0_cvt4_load(F_pv, (size_t)i2 * 4, lane, va0, vb0); }
                p0_cvt4_conv(ua1, ub1, F_U, F_ln2, USCALE, true, (size_t)i1 * 4, lane); p0_cvt4_conv(va1, vb1, F_V, nullptr, VSCALE, false, (size_t)i1 * 4, lane);
            }
        }
    }
    {
        f32x4 g[4];
#pragma unroll
        for (int j = 0; j < 4; ++j) g[j] = ((const GAS f32x4*)F_ln1)[lane + 64 * j];
        f32x4 xa0[4], xb0[4], xa1[4], xb1[4];
        int m = gw;
        if (m < TT) rms_row_load(F_x + (size_t)m * DM, lane, xa0); if (m + NGW < TT) rms_row_load(F_x + (size_t)(m + NGW) * DM, lane, xb0);
        for (; m < TT; m += 4 * NGW) {
            const int m1 = m + NGW, m2 = m + 2 * NGW, m3 = m + 3 * NGW, m4 = m + 4 * NGW, m5 = m + 5 * NGW;
            if (m2 < TT) rms_row_load(F_x + (size_t)m2 * DM, lane, xa1); if (m3 < TT) rms_row_load(F_x + (size_t)m3 * DM, lane, xb1);
            rms_row_finish(xa0, g, F_XN + (size_t)m * DM, lane); if (m1 < TT) rms_row_finish(xb0, g, F_XN + (size_t)m1 * DM, lane);
            if (m4 < TT) rms_row_load(F_x + (size_t)m4 * DM, lane, xa0); if (m5 < TT) rms_row_load(F_x + (size_t)m5 * DM, lane, xb0);
            if (m2 < TT) rms_row_finish(xa1, g, F_XN + (size_t)m2 * DM, lane); if (m3 < TT) rms_row_finish(xb1, g, F_XN + (size_t)m3 * DM, lane);
        }
    }
}

__device__ __forceinline__ void up8(const v4u w, float (&f)[8]) { f[0] = bflo(w.x); f[1] = bfhi(w.x); f[2] = bflo(w.y); f[3] = bfhi(w.y); f[4] = bflo(w.z); f[5] = bfhi(w.z); f[6] = bflo(w.w); f[7] = bfhi(w.w); }
struct P2Rows { v4u cc[4], ch[4], cb[4]; };
__device__ __forceinline__ void p2_conv_load(Frame& F, P2Rows& R, int bt0, int lane) {
#pragma unroll
    for (int j = 0; j < 4; ++j) { const bf16* pr = F_PROJ + (size_t)(bt0 + j) * NPROJ + 8 * lane; R.cc[j] = *(const GAS v4u*)(pr + C_C); R.ch[j] = *(const GAS v4u*)(pr + C_H); R.cb[j] = *(const GAS v4u*)(pr + C_B); }
}
__device__ __forceinline__ void p2_conv_four(Frame& F, const P2Rows& R, int bt0, int lane, float (&g1)[8], float (&g2)[8], const float (&w)[3][8], const float (&gn)[8]) {
#pragma unroll
    for (int j = 0; j < 4; ++j) {
        float cc[8], ch[8], cb[8], y[8]; up8(R.cc[j], cc); up8(R.ch[j], ch); up8(R.cb[j], cb);
        float ss = 0.f;
#pragma unroll
        for (int e = 0; e < 8; ++e) { const float g0 = cc[e] * ch[e]; y[e] = (w[0][e] * g2[e] + w[1][e] * g1[e] + w[2][e] * g0) * cb[e]; ss += y[e] * y[e]; g2[e] = g1[e]; g1[e] = g0; }
        const float rs = 1.f / sqrtf(wave_sum(ss) * (1.f / 512.f) + RMS_EPS);
        v4u o; o.x = pk2(y[0] * rs * gn[0], y[1] * rs * gn[1]); o.y = pk2(y[2] * rs * gn[2], y[3] * rs * gn[3]); o.z = pk2(y[4] * rs * gn[4], y[5] * rs * gn[5]); o.w = pk2(y[6] * rs * gn[6], y[7] * rs * gn[7]);
        *(GAS v4u*)(F_MIXA + (size_t)(bt0 + j) * 1024 + 8 * lane) = o;
    }
}
__device__ __forceinline__ void p2_conv_run(Frame& F, int run) {
    const int lane = F.lane; const int bt0 = 16 * run; const int t0 = bt0 & (SEQ - 1);
    P2Rows A, B;
    p2_conv_load(F, A, bt0, lane);
    float w[3][8], gn[8], g1[8], g2[8];
#pragma unroll
    for (int k = 0; k < 3; ++k) { const f32x4 w0 = *(const GAS f32x4*)(F_conv_w + k * 512 + 8 * lane), w1 = *(const GAS f32x4*)(F_conv_w + k * 512 + 8 * lane + 4);
#pragma unroll
        for (int e = 0; e < 4; ++e) { w[k][e] = w0[e]; w[k][4 + e] = w1[e]; } }
    { const f32x4 a0 = *(const GAS f32x4*)(F_gn_conv + 8 * lane), a1 = *(const GAS f32x4*)(F_gn_conv + 8 * lane + 4);
#pragma unroll
      for (int e = 0; e < 4; ++e) { gn[e] = a0[e]; gn[4 + e] = a1[e]; } }
#pragma unroll
    for (int e = 0; e < 8; ++e) { g1[e] = 0.f; g2[e] = 0.f; }
    if (t0 > 0) {
        const bf16* pr = F_PROJ + (size_t)(bt0 - 2) * NPROJ + 8 * lane; float c2[8], h2[8], c1[8], h1[8];
        up8(*(const GAS v4u*)(pr + C_C), c2); up8(*(const GAS v4u*)(pr + C_H), h2); up8(*(const GAS v4u*)(pr + NPROJ + C_C), c1); up8(*(const GAS v4u*)(pr + NPROJ + C_H), h1);
#pragma unroll
        for (int e = 0; e < 8; ++e) { g2[e] = c2[e] * h2[e]; g1[e] = c1[e] * h1[e]; }
    }
    p2_conv_load(F, B, bt0 + 4, lane);  p2_conv_four(F, A, bt0, lane, g1, g2, w, gn);
    p2_conv_load(F, A, bt0 + 8, lane);  p2_conv_four(F, B, bt0 + 4, lane, g1, g2, w, gn);
    p2_conv_load(F, B, bt0 + 12, lane); p2_conv_four(F, A, bt0 + 8, lane, g1, g2, w, gn);
    p2_conv_four(F, B, bt0 + 12, lane, g1, g2, w, gn);
}
__device__ __forceinline__ void p2_compress_unit(Frame& F, int u) {
    const int b = u >> 5, g = (u >> 4) & 1, nb = u & 15; const int tid = F.tid, lane = F.lane, w = F.wave;
    LAS unsigned char* AST = F.lds + RING_OFF;
    LAS unsigned char* HID = F.lds + RING_OFF + 36864;
    const int nrow = lane & 15, kq = lane >> 4;
    for (int mat = 0; mat < 2; ++mat) {
        const int col0 = (mat ? C_VC : C_KC) + g * 64; const bf16* W1T = mat ? F_VW1T : F_KW1T; const bf16* W2T = mat ? F_VW2T : F_KW2T; const float* B1 = F_B1 + mat * 256; bf16* OUT = mat ? F_VCC : F_KCC;
        for (int idx = tid; idx < 272 * 8; idx += NWAVES * 64) { const int pos = idx >> 3, ch = idx & 7; const int p = 256 * nb + pos;
            v4u v = (v4u){0u, 0u, 0u, 0u}; if (p < SEQ) v = *(const GAS v4u*)(F_PROJ + (size_t)(b * SEQ + p) * NPROJ + col0 + 8 * ch);
            *(LAS v4u*)(AST + pos * 128 + ch * 16) = v; }
        __syncthreads();
        f32x4 acc0 = (f32x4){0.f, 0.f, 0.f, 0.f}, acc1 = acc0;
        const bf16* b0p = W1T + (size_t)(2 * w) * 64 * 512 + lane * 8; const bf16* b1p = b0p + (size_t)64 * 512;
#define P2_LOADB(S0, S1, bb) do { _Pragma("unroll") for (int k8 = 0; k8 < 8; ++k8) { S0[k8] = *(const GAS bf16x8*)(b0p + 512 * (8 * (bb) + k8)); S1[k8] = *(const GAS bf16x8*)(b1p + 512 * (8 * (bb) + k8)); } } while (0)
#define P2_MMA(S0, S1, bb) do { _Pragma("unroll") for (int k8 = 0; k8 < 8; ++k8) { const int k0 = 32 * (8 * (bb) + k8) + 8 * kq; const int l = k0 >> 6, d = k0 & 63; \
            const bf16x8 a = *(const LAS bf16x8*)(AST + (16 * nrow + l) * 128 + d * 2); \
            acc0 = __builtin_amdgcn_mfma_f32_16x16x32_bf16(a, S0[k8], acc0, 0, 0, 0); acc1 = __builtin_amdgcn_mfma_f32_16x16x32_bf16(a, S1[k8], acc1, 0, 0, 0); } } while (0)
        { bf16x8 pa0[8], pa1[8], pb0[8], pb1[8];
          P2_LOADB(pa0, pa1, 0);
#pragma unroll 1
          for (int bb = 0; bb < 8; bb += 2) {
              P2_LOADB(pb0, pb1, bb + 1);
              P2_MMA(pa0, pa1, bb);
              if (bb + 2 < 8) P2_LOADB(pa0, pa1, bb + 2);
              P2_MMA(pb0, pb1, bb + 1);
          } }
#undef P2_LOADB
#undef P2_MMA
        { const int j0 = 32 * w + nrow, j1 = j0 + 16; const float bj0 = B1[j0], bj1 = B1[j1];
#pragma unroll
            for (int r = 0; r < 4; ++r) { const int n = 4 * kq + r;
                *(LAS unsigned short*)(HID + n * 528 + j0 * 2) = (unsigned short)f2bf(gelu_tanh(acc0[r] + bj0));
                *(LAS unsigned short*)(HID + n * 528 + j1 * 2) = (unsigned short)f2bf(gelu_tanh(acc1[r] + bj1)); } }
        __syncthreads();
        if (w < 4) { f32x4 acc = (f32x4){0.f, 0.f, 0.f, 0.f}; const bf16* bp = W2T + (size_t)(16 * w + nrow) * 256 + 8 * kq;
#pragma unroll
            for (int kk = 0; kk < 8; ++kk) { const bf16x8 a = *(const LAS bf16x8*)(HID + nrow * 528 + (32 * kk + 8 * kq) * 2); const bf16x8 bb = *(const GAS bf16x8*)(bp + 32 * kk);
                acc = __builtin_amdgcn_mfma_f32_16x16x32_bf16(a, bb, acc, 0, 0, 0); }
            const int d = 16 * w + nrow;
#pragma unroll
            for (int r = 0; r < 4; ++r) { const int n = 16 * nb + 4 * kq + r; OUT[((size_t)(b * 256 + n) * 2 + g) * 64 + d] = (bf16)f2bf(acc[r]); } }
        __syncthreads();
    }
}
__device__ __forceinline__ void p2_phase(Frame& F) {
    const int gw = F.vcu * NWAVES + F.wave, NGW = F.G * NWAVES;
    for (int u = F.vcu; u < 256; u += F.G) p2_compress_unit(F, u);
    for (int run = gw; run < TT / 16; run += NGW) p2_conv_run(F, run);
}

namespace att {
constexpr int IMP_ROW = 66  , IMP_PLANE = 64 * IMP_ROW * 2;
constexpr int KBUF = 0, VBUF = 16384, IMP_OFF = 32768  , OST_OFF = IMP_OFF + 3 * IMP_PLANE, OST_ROW = 1040, SELM_OFF = OST_OFF + 64 * OST_ROW, ANYW_OFF = SELM_OFF + 512, SSQ_OFF = ANYW_OFF + 64, LINV_OFF = SSQ_OFF + 256  ;
constexpr int GATE_OFF = RING_BYTES + 1024  , IMP3_OFF = GATE_OFF + 8192  ;
static_assert(OST_OFF % 16 == 0 && LINV_OFF + 1024 <= RING_BYTES && IMP3_OFF + IMP_PLANE <= LDS_BYTES, "attention LDS map");
__device__ __forceinline__ LAS _Float16* imp_plane(LAS unsigned char* L, int h) { return (LAS _Float16*)(L + (h < 3 ? IMP_OFF + h * IMP_PLANE : IMP3_OFF)); }
__device__ __forceinline__ int crow(int r, int hi) { return (r & 3) + 8 * (r >> 2) + 4 * hi; }
__device__ __forceinline__ float max3f(float a, float b, float c) { float r; asm("v_max3_f32 %0, %1, %2, %3" : "=v"(r) : "v"(a), "v"(b), "v"(c)); return r; }
__device__ __forceinline__ float max2f(float a, float b) { float r; asm("v_max_f32_e32 %0, %1, %2" : "=v"(r) : "v"(a), "v"(b)); return r; }
__device__ __forceinline__ float swapmax(float v) { auto rr = __builtin_amdgcn_permlane32_swap(__float_as_uint(v), __float_as_uint(v), false, false); return max2f(__uint_as_float(rr[0]), __uint_as_float(rr[1])); }
__device__ __forceinline__ float swapsum(float v) { auto rr = __builtin_amdgcn_permlane32_swap(__float_as_uint(v), __float_as_uint(v), false, false); return __uint_as_float(rr[0]) + __uint_as_float(rr[1]); }
__device__ __forceinline__ unsigned cvtpk(float lo, float hi) { typedef float f2 __attribute__((ext_vector_type(2))); f2 v = {lo, hi}; bf16x2v b = __builtin_convertvector(v, bf16x2v); return __builtin_bit_cast(unsigned, b); }
__device__ __forceinline__ s16x4 vtr(const LAS unsigned char* p) { typedef short v4i16_t __attribute__((ext_vector_type(4))); return __builtin_bit_cast(s16x4, __builtin_amdgcn_ds_read_tr16_b64_v4i16((LAS v4i16_t*)p)); }

struct Stg { v4u k, v; };
__device__ __forceinline__ void tile_load(Stg& s, const bf16* kbase, const bf16* vbase, int rs, int tid) {
    const unsigned ov = (unsigned)((tid >> 3) * rs + (tid & 7) * 8) * 2u, ok = ov;
    s.k = *(const GAS v4u*)((const GAS unsigned char*)kbase + ok);
    s.v = *(const GAS v4u*)((const GAS unsigned char*)vbase + ov);
}
__device__ __forceinline__ void tile_store(const Stg& s, LAS unsigned char* kbuf, LAS unsigned char* vbuf, int tid) {
    const int key = tid >> 3, c = tid & 7;
    *(LAS v4u*)(kbuf + c * 1024 + ((((key + c) & 7) | (key & ~7)) * 16)) = s.k;
    *(LAS v4u*)(vbuf + (c >> 2) * 4096 + (key >> 3) * 512 + (key & 7) * 64 + (c & 3) * 16) = s.v;
}
__device__ __forceinline__ void qkt(f32x16& p0, f32x16& p1, const LAS unsigned char* kbuf, const bf16x8 (&qr)[4], float cinit, int hi, int r32) {
#pragma unroll
    for (int r = 0; r < 16; ++r) { p0[r] = cinit; p1[r] = cinit; }
    bf16x8 kf[8];
#pragma unroll
    for (int s = 0; s < 4; ++s) { const int ch = 2 * s + hi; const LAS unsigned char* kb = kbuf + ch * 1024 + ((((r32 + ch) & 7) | (r32 & ~7)) * 16);
        kf[2 * s] = *(const LAS bf16x8*)(kb); kf[2 * s + 1] = *(const LAS bf16x8*)(kb + 512); }
#pragma unroll
    for (int s = 0; s < 4; ++s) {
        p0 = __builtin_amdgcn_mfma_f32_32x32x16_bf16(kf[2 * s], qr[s], p0, 0, 0, 0);
        p1 = __builtin_amdgcn_mfma_f32_32x32x16_bf16(kf[2 * s + 1], qr[s], p1, 0, 0, 0);
    }
    __builtin_amdgcn_sched_group_barrier(0x100, 8, 0);
    __builtin_amdgcn_sched_group_barrier(0x008, 8, 0);
}
__device__ __forceinline__ void qkt_v(f32x16& p0, f32x16& p1, s16x4 (&vlo)[8], s16x4 (&vhi)[8], const LAS unsigned char* kbuf, const LAS unsigned char* vb, const bf16x8 (&qr)[4], int hi, int r32) {
#pragma unroll
    for (int r = 0; r < 16; ++r) { p0[r] = 0.f; p1[r] = 0.f; }
    bf16x8 kf[8];
#pragma unroll
    for (int s = 0; s < 4; ++s) { const int ch = 2 * s + hi; const LAS unsigned char* kb = kbuf + ch * 1024 + ((((r32 + ch) & 7) | (r32 & ~7)) * 16);
        kf[2 * s] = *(const LAS bf16x8*)(kb); kf[2 * s + 1] = *(const LAS bf16x8*)(kb + 512); }
#pragma unroll
    for (int s = 0; s < 4; ++s) {
        p0 = __builtin_amdgcn_mfma_f32_32x32x16_bf16(kf[2 * s], qr[s], p0, 0, 0, 0);
        vlo[s] = vtr(vb + s * 1024); vhi[s] = vtr(vb + s * 1024 + 512);
        p1 = __builtin_amdgcn_mfma_f32_32x32x16_bf16(kf[2 * s + 1], qr[s], p1, 0, 0, 0);
        vlo[4 + s] = vtr(vb + 4096 + s * 1024); vhi[4 + s] = vtr(vb + 4096 + s * 1024 + 512);
    }
    __builtin_amdgcn_sched_group_barrier(0x100, 8, 0);
#pragma unroll
    for (int s = 0; s < 8; ++s) { __builtin_amdgcn_sched_group_barrier(0x008, 1, 0); __builtin_amdgcn_sched_group_barrier(0x100, 2, 0); }
}
constexpr float ATT_THR = 6.f;
template <bool HAS_LO, bool IMPA = false> __device__ __forceinline__ void tile_step(const LAS unsigned char* kbuf, const LAS unsigned char* vbuf, const bf16x8 (&qr)[4], float& mref, float& l, f32x16& o0, f32x16& o1,
                                          bool sel, bool first, bool need_mask, int hi_lim, int lo_lim, int hi, int r32, int lane, LAS _Float16* improw = nullptr, int jbase = 0) {
    f32x16 p0, p1;
#ifdef DUP_QK
    { f32x16 d0, d1; qkt(d0, d1, kbuf, qr, 0.f, hi, r32); float dm = fmaxf(d0[0], d1[0]);
#pragma unroll
      for (int r = 1; r < 16; ++r) dm = fmaxf(dm, fmaxf(d0[r], d1[r]));
      dm = swapmax(dm); float ds = 0.f;
#pragma unroll
      for (int r = 0; r < 16; ++r) { d0[r] = __builtin_amdgcn_exp2f(d0[r] - dm); d1[r] = __builtin_amdgcn_exp2f(d1[r] - dm); ds += d0[r] + d1[r]; }
      unsigned dk = 0;
#pragma unroll
      for (int r = 0; r < 16; r += 2) dk ^= cvtpk(d0[r], d0[r + 1]) ^ cvtpk(d1[r], d1[r + 1]);
      asm volatile("" :: "v"(ds), "v"(dk)); }
#endif
    if (!first) {
        const float l2 = swapsum(l);
        const bool big = l2 > 1048576.f;
        if (__any(big)) {
            const float dl = big ? __builtin_amdgcn_logf(l2) : 0.f;
            mref += dl;
            const float alpha = __builtin_amdgcn_exp2f(-dl);
            l *= alpha;
#pragma unroll
            for (int r = 0; r < 16; ++r) { o0[r] *= alpha; o1[r] *= alpha; }
            if constexpr (IMPA) { if (hi == 0) { for (int c = 0; c < 64; ++c) improw[c] = (_Float16)((float)improw[c] * alpha); } asm volatile("" ::: "memory"); }
        }
    }
    const LAS unsigned char* vb = vbuf + ((lane >> 4) & 1) * 32 + (lane & 3) * 8 + (4 * hi + ((lane & 15) >> 2)) * 64;
    s16x4 vlo[8], vhi[8];
    qkt_v(p0, p1, vlo, vhi, kbuf, vb, qr, hi, r32);
    const float NEG = -INFINITY;
    if (need_mask) {
        int hl = hi_lim - 4 * hi, ll = lo_lim - 4 * hi;
        asm volatile("" : "+v"(hl), "+v"(ll));
#pragma unroll
        for (int r = 0; r < 16; ++r) { const int c = (r & 3) + 8 * (r >> 2); if (!(c <= hl && (!HAS_LO || c > ll))) p0[r] = NEG; if (!(c + 32 <= hl && (!HAS_LO || c + 32 > ll))) p1[r] = NEG; }
    }
    if (first) {
        float mxa = max3f(p0[0], p0[1], p1[0]), mxb = max3f(p0[2], p0[3], p1[1]);
        mxa = max3f(mxa, p1[2], p1[3]);
#pragma unroll
        for (int r = 4; r < 16; r += 4) { mxa = max3f(mxa, p0[r], p0[r + 1]); mxb = max3f(mxb, p0[r + 2], p0[r + 3]); mxa = max3f(mxa, p1[r], p1[r + 1]); mxb = max3f(mxb, p1[r + 2], p1[r + 3]); }
        const float mx = swapmax(max2f(mxa, mxb));
        if (sel && mx > NEG) mref = mx;
    }
    const float msub = sel ? mref : INFINITY;
    float sum = 0.f;
#pragma unroll
    for (int r = 0; r < 16; ++r) { p0[r] = __builtin_amdgcn_exp2f(p0[r] - msub); p1[r] = __builtin_amdgcn_exp2f(p1[r] - msub); sum += p0[r] + p1[r]; }
    l += sum;
    if constexpr (IMPA) {
        LAS _Float16* c0 = improw + jbase + hi;
#pragma unroll
        for (int gq = 0; gq < 4; ++gq) { c0[2 * gq] = c0[2 * gq] + (_Float16)((p0[4 * gq] + p0[4 * gq + 1]) + (p0[4 * gq + 2] + p0[4 * gq + 3]));
                                          c0[8 + 2 * gq] = c0[8 + 2 * gq] + (_Float16)((p1[4 * gq] + p1[4 * gq + 1]) + (p1[4 * gq + 2] + p1[4 * gq + 3])); }
        asm volatile("" ::: "memory");
#pragma unroll
        for (int gq = 0; gq < 4; ++gq) { c0[2 * gq + 1] = c0[2 * gq + 1] + (_Float16)p0[4 * gq + 3];
                                          if (jbase + hi + 8 + 2 * gq + 1 < 64) c0[8 + 2 * gq + 1] = c0[8 + 2 * gq + 1] + (_Float16)p1[4 * gq + 3]; }
        asm volatile("" ::: "memory");
    }
    bf16x8 pf[4];
    { v4u w;
      w.x = cvtpk(p0[0], p0[1]); w.y = cvtpk(p0[2], p0[3]); w.z = cvtpk(p0[4], p0[5]); w.w = cvtpk(p0[6], p0[7]); pf[0] = __builtin_bit_cast(bf16x8, w);
      w.x = cvtpk(p0[8], p0[9]); w.y = cvtpk(p0[10], p0[11]); w.z = cvtpk(p0[12], p0[13]); w.w = cvtpk(p0[14], p0[15]); pf[1] = __builtin_bit_cast(bf16x8, w);
      w.x = cvtpk(p1[0], p1[1]); w.y = cvtpk(p1[2], p1[3]); w.z = cvtpk(p1[4], p1[5]); w.w = cvtpk(p1[6], p1[7]); pf[2] = __builtin_bit_cast(bf16x8, w);
      w.x = cvtpk(p1[8], p1[9]); w.y = cvtpk(p1[10], p1[11]); w.z = cvtpk(p1[12], p1[13]); w.w = cvtpk(p1[14], p1[15]); pf[3] = __builtin_bit_cast(bf16x8, w); }
#pragma unroll
    for (int s = 0; s < 4; ++s) {
        const bf16x8 va = (bf16x8){vlo[s][0], vlo[s][1], vlo[s][2], vlo[s][3], vhi[s][0], vhi[s][1], vhi[s][2], vhi[s][3]};
        const bf16x8 vb8 = (bf16x8){vlo[4 + s][0], vlo[4 + s][1], vlo[4 + s][2], vlo[4 + s][3], vhi[4 + s][0], vhi[4 + s][1], vhi[4 + s][2], vhi[4 + s][3]};
        o0 = __builtin_amdgcn_mfma_f32_32x32x16_bf16(va, pf[s], o0, 0, 0, 0);
        o1 = __builtin_amdgcn_mfma_f32_32x32x16_bf16(vb8, pf[s], o1, 0, 0, 0);
    }
#ifdef DUP_PV
    { f32x16 d0, d1;
#pragma unroll
      for (int r = 0; r < 16; ++r) { d0[r] = 0.f; d1[r] = 0.f; }
      s16x4 ulo[8], uhi[8];
#pragma unroll
      for (int s = 0; s < 4; ++s) { ulo[s] = vtr(vb + s * 1024); uhi[s] = vtr(vb + s * 1024 + 512); ulo[4 + s] = vtr(vb + 4096 + s * 1024); uhi[4 + s] = vtr(vb + 4096 + s * 1024 + 512); }
#pragma unroll
      for (int s = 0; s < 4; ++s) {
          const bf16x8 va = (bf16x8){ulo[s][0], ulo[s][1], ulo[s][2], ulo[s][3], uhi[s][0], uhi[s][1], uhi[s][2], uhi[s][3]};
          const bf16x8 vb8 = (bf16x8){ulo[4 + s][0], ulo[4 + s][1], ulo[4 + s][2], ulo[4 + s][3], uhi[4 + s][0], uhi[4 + s][1], uhi[4 + s][2], uhi[4 + s][3]};
          d0 = __builtin_amdgcn_mfma_f32_32x32x16_bf16(va, pf[s], d0, 0, 0, 0);
          d1 = __builtin_amdgcn_mfma_f32_32x32x16_bf16(vb8, pf[s], d1, 0, 0, 0);
      }
      asm volatile("" :: "v"(d0), "v"(d1)); }
#endif
}
__device__ __forceinline__ void imp_step(const LAS unsigned char* kbuf, const bf16x8 (&qr)[4], float mfin, float linv, int hi_lim, int hi, int r32, LAS float* improw, int jbase) {
    f32x16 p0, p1;
    qkt(p0, p1, kbuf, qr, 0.f, hi, r32);
    int hl = hi_lim - 4 * hi; asm volatile("" : "+v"(hl));
#pragma unroll
    for (int r = 0; r < 16; ++r) { const int c = (r & 3) + 8 * (r >> 2);
        p0[r] = (c <= hl) ? __builtin_amdgcn_exp2f(p0[r] - mfin) * linv : 0.f;
        p1[r] = (c + 32 <= hl) ? __builtin_amdgcn_exp2f(p1[r] - mfin) * linv : 0.f; }
#pragma unroll
    for (int gq = 0; gq < 4; ++gq) {
        { const float G = (p0[4 * gq] + p0[4 * gq + 1]) + (p0[4 * gq + 2] + p0[4 * gq + 3]); const int j = jbase + 2 * gq + hi;
          __hip_atomic_fetch_add(improw + j, G, __ATOMIC_RELAXED, __HIP_MEMORY_SCOPE_WORKGROUP);
          if (j + 1 < 64) __hip_atomic_fetch_add(improw + j + 1, p0[4 * gq + 3], __ATOMIC_RELAXED, __HIP_MEMORY_SCOPE_WORKGROUP); }
        { const float G = (p1[4 * gq] + p1[4 * gq + 1]) + (p1[4 * gq + 2] + p1[4 * gq + 3]); const int j = jbase + 8 + 2 * gq + hi;
          __hip_atomic_fetch_add(improw + j, G, __ATOMIC_RELAXED, __HIP_MEMORY_SCOPE_WORKGROUP);
          if (j + 1 < 64) __hip_atomic_fetch_add(improw + j + 1, p1[4 * gq + 3], __ATOMIC_RELAXED, __HIP_MEMORY_SCOPE_WORKGROUP); }
    }
}
__device__ __forceinline__ void ost_acc(LAS unsigned char* orow, const f32x16& o0, const f32x16& o1, float sc, bool first, int hi) {
#pragma unroll
    for (int rg = 0; rg < 4; ++rg) {
        const int d = 8 * rg + 4 * hi;
        float a[4], c[4];
#pragma unroll
        for (int e = 0; e < 4; ++e) { a[e] = o0[4 * rg + e] * sc; c[e] = o1[4 * rg + e] * sc; }
        if (!first) { const v2u w0 = *(const LAS v2u*)(orow + d * 2), w1 = *(const LAS v2u*)(orow + (32 + d) * 2);
            a[0] += bflo(w0.x); a[1] += bfhi(w0.x); a[2] += bflo(w0.y); a[3] += bfhi(w0.y); c[0] += bflo(w1.x); c[1] += bfhi(w1.x); c[2] += bflo(w1.y); c[3] += bfhi(w1.y); }
        v2u w0; w0.x = cvtpk(a[0], a[1]); w0.y = cvtpk(a[2], a[3]); *(LAS v2u*)(orow + d * 2) = w0;
        v2u w1; w1.x = cvtpk(c[0], c[1]); w1.y = cvtpk(c[2], c[3]); *(LAS v2u*)(orow + (32 + d) * 2) = w1;
    }
}
}

#define ATT_PRE(T0, KP, VP, RS) do { const int t_ = (T0); att::tile_load(sA_, (KP), (VP), (RS), tid); } while (0)
#define ATT_PASS(T0, NTL, KP, VP, RS, BODY) do { \
    const int tend_ = (T0) + (NTL); int t_ = (T0), cur_ = 0; \
    { att::tile_store(sA_, L + att::KBUF, L + att::VBUF, tid); } \
    if (t_ + 1 < tend_) { ++t_; att::tile_load(sB_, (KP), (VP), (RS), tid); --t_; } \
    __syncthreads(); \
    for (;;) { \
        if (t_ + 2 < tend_) { t_ += 2; att::tile_load(sA_, (KP), (VP), (RS), tid); t_ -= 2; } \
        { const LAS unsigned char* kb_ = L + att::KBUF + cur_ * 8192; const LAS unsigned char* vb_ = L + att::VBUF + cur_ * 8192; BODY; } \
        if (t_ + 1 >= tend_) break; \
        att::tile_store(sB_, L + att::KBUF + (cur_ ^ 1) * 8192, L + att::VBUF + (cur_ ^ 1) * 8192, tid); \
        __syncthreads(); cur_ ^= 1; ++t_; \
        if (t_ + 2 < tend_) { t_ += 2; att::tile_load(sB_, (KP), (VP), (RS), tid); t_ -= 2; } \
        { const LAS unsigned char* kb_ = L + att::KBUF + cur_ * 8192; const LAS unsigned char* vb_ = L + att::VBUF + cur_ * 8192; BODY; } \
        if (t_ + 1 >= tend_) break; \
        att::tile_store(sA_, L + att::KBUF + (cur_ ^ 1) * 8192, L + att::VBUF + (cur_ ^ 1) * 8192, tid); \
        __syncthreads(); cur_ ^= 1; ++t_; } \
    __syncthreads(); } while (0)

__device__ __forceinline__ void p3_unit(Frame& F, int b, int i) {
    LAS unsigned char* L = F.lds + RING_OFF;
    const int tid = F.tid, lane = F.lane, w = F.wave, hi = lane >> 5, r32 = lane & 31;
    LAS float* LINV = (LAS float*)(L + att::LINV_OFF);
    LAS unsigned long long* SELM = (LAS unsigned long long*)(L + att::SELM_OFF);
    LAS float* SSQ = (LAS float*)(L + att::SSQ_OFF);
    const int q = (w & 1) * 32 + r32;
    const int t = 64 * i + q;
    const size_t bt = (size_t)b * SEQ + t;
    const float NEG = -INFINITY;
    if (tid < 64) SSQ[tid] = 0.f;
    att::Stg sA_, sB_;
#define ATT_CMP_K(G) (F_KCC + ((size_t)(b * 256 + 64 * t_) * 2 + (G)) * 64)
#define ATT_CMP_V(G) (F_VCC + ((size_t)(b * 256 + 64 * t_) * 2 + (G)) * 64)
    ATT_PRE(0, ATT_CMP_K(0), ATT_CMP_V(0), 128);
    for (int g = 0; g < 2; ++g) {
        const int H = g * 4 + (w >> 1);
        for (int z = tid; z < 3 * att::IMP_PLANE / 4; z += NWAVES * 64) ((LAS unsigned*)(L + att::IMP_OFF))[z] = 0u;
        for (int z = tid; z < att::IMP_PLANE / 4; z += NWAVES * 64) ((LAS unsigned*)(L + att::IMP3_OFF))[z] = 0u;
        bf16x8 qr[4];
#pragma unroll
        for (int s = 0; s < 4; ++s) qr[s] = *(const GAS bf16x8*)(F_PROJ + bt * NPROJ + C_Q + H * 64 + 16 * s + 8 * hi);
        LAS float* gslot = (LAS float*)(L + att::GATE_OFF + tid * 16);
        { const bf16* gp = F_PROJ + bt * NPROJ + C_G + H * 3; const float g0 = bf2f(gp[0]), g1 = bf2f(gp[1]), g2 = bf2f(gp[2]);
          gslot[0] = 1.f / (1.f + __expf(-g0)); gslot[1] = 1.f / (1.f + __expf(-g1)); gslot[2] = 1.f / (1.f + __expf(-g2)); }
#define ATT_GATE(k) (gslot[k])
        LAS unsigned char* orow = L + att::OST_OFF + q * att::OST_ROW + (H * 64) * 2;
        const int nlim = (t - 31) >> 4;
        const int nmaxb = (4 * i + 2 < 254) ? 4 * i + 2 : 254;
        const int nct = (nmaxb >> 6) + 1;
        float m = 0.f, l = 0.f; f32x16 o0, o1;
#pragma unroll
        for (int r = 0; r < 16; ++r) { o0[r] = 0.f; o1[r] = 0.f; }
        bool first = true;
        ATT_PASS(0, nct, ATT_CMP_K(g), ATT_CMP_V(g), 128,
                 { (att::tile_step<false, true>)(kb_, vb_, qr, m, l, o0, o1, true, first, true, nlim - 64 * t_, -1, hi, r32, lane, att::imp_plane(L, w >> 1) + q * att::IMP_ROW, 16 * t_); first = false; });
        ATT_PRE(0, F_PROJ + ((size_t)b * SEQ + 64 * t_) * NPROJ + C_KS + g * 64, F_PROJ + ((size_t)b * SEQ + 64 * t_) * NPROJ + C_VS + g * 64, NPROJ);
        { const float lt = att::swapsum(l); const float linv = lt > 0.f ? 1.f / lt : 0.f; if (hi == 0) LINV[(w >> 1) * 64 + q] = linv; att::ost_acc(orow, o0, o1, ATT_GATE(0) * linv, true, hi); }
        __syncthreads();
        { const int j = lane; const bool forced = (j == 0) || (j == i) || (j == i - 1);
          for (int qq = 0; qq < 8; qq += 4) {
              unsigned key[4]; int rank[4];
#pragma unroll
              for (int u = 0; u < 4; ++u) { const int qx = 8 * w + qq + u;
                  const int co = qx * att::IMP_ROW + lane;
                  const float v0 = ((float)att::imp_plane(L, 0)[co] * LINV[qx] + (float)att::imp_plane(L, 1)[co] * LINV[64 + qx]) + ((float)att::imp_plane(L, 2)[co] * LINV[128 + qx] + (float)att::imp_plane(L, 3)[co] * LINV[192 + qx]);
                  key[u] = (j > i) ? (unsigned)(63 - j) : (((__builtin_bit_cast(unsigned, v0) & ~63u) | (unsigned)(63 - j)) | (forced ? 0x80000000u : 0u)); rank[u] = 0; }
#pragma unroll
              for (int jc = 0; jc < 4; ++jc) {
                  if (16 * jc <= i) {
#pragma unroll
                      for (int jj = 16 * jc; jj < 16 * jc + 16; ++jj) {
#pragma unroll
                          for (int u = 0; u < 4; ++u) { const unsigned o = (unsigned)__builtin_amdgcn_readlane((int)key[u], jj); rank[u] += (o > key[u]) ? 1 : 0; } } } }
#pragma unroll
              for (int u = 0; u < 4; ++u) { const unsigned long long msk = __ballot(rank[u] < 16); if (lane == 0) SELM[8 * w + qq + u] = msk; } } }
        __syncthreads();
        m = 0.f; l = 0.f; first = true;
#pragma unroll
        for (int r = 0; r < 16; ++r) { o0[r] = 0.f; o1[r] = 0.f; }
        ATT_PASS(0, i + 1, F_PROJ + ((size_t)b * SEQ + 64 * t_) * NPROJ + C_KS + g * 64, F_PROJ + ((size_t)b * SEQ + 64 * t_) * NPROJ + C_VS + g * 64, NPROJ,
                 { att::tile_step<false>(kb_, vb_, qr, m, l, o0, o1, ((SELM[q] >> t_) & 1ull) != 0ull, first, t_ == i, (t_ == i) ? q : 63, -1, hi, r32, lane); first = false; });
        const int wlo = (i >= 8) ? i - 8 : 0;
        ATT_PRE(wlo, F_PROJ + ((size_t)b * SEQ + 64 * t_) * NPROJ + C_KW + g * 64, F_PROJ + ((size_t)b * SEQ + 64 * t_) * NPROJ + C_VW + g * 64, NPROJ);
        { const float lt = att::swapsum(l); att::ost_acc(orow, o0, o1, lt > 0.f ? ATT_GATE(1) / lt : 0.f, false, hi); }
        m = 0.f; l = 0.f; first = true;
#pragma unroll
        for (int r = 0; r < 16; ++r) { o0[r] = 0.f; o1[r] = 0.f; }
        ATT_PASS(wlo, i - wlo + 1, F_PROJ + ((size_t)b * SEQ + 64 * t_) * NPROJ + C_KW + g * 64, F_PROJ + ((size_t)b * SEQ + 64 * t_) * NPROJ + C_VW + g * 64, NPROJ,
                 { att::tile_step<true>(kb_, vb_, qr, m, l, o0, o1, true, first, (t_ == i) || (t_ == i - 8), (t_ == i) ? q : 63, (t_ == i - 8) ? q : -1, hi, r32, lane); first = false; });
        if (g == 0) ATT_PRE(0, ATT_CMP_K(1), ATT_CMP_V(1), 128);
        { const float lt = att::swapsum(l); att::ost_acc(orow, o0, o1, lt > 0.f ? ATT_GATE(2) / lt : 0.f, false, hi); }
        { float ss = 0.f;
#pragma unroll
          for (int rg = 0; rg < 4; ++rg) { const int d = 8 * rg + 4 * hi; const v2u w0 = *(const LAS v2u*)(orow + d * 2), w1 = *(const LAS v2u*)(orow + (32 + d) * 2);
              const float a0 = bflo(w0.x), a1 = bfhi(w0.x), a2 = bflo(w0.y), a3 = bfhi(w0.y), c0 = bflo(w1.x), c1 = bfhi(w1.x), c2 = bflo(w1.y), c3 = bfhi(w1.y);
              ss += (a0 * a0 + a1 * a1) + (a2 * a2 + a3 * a3) + (c0 * c0 + c1 * c1) + (c2 * c2 + c3 * c3); }
          __hip_atomic_fetch_add(SSQ + q, ss, __ATOMIC_RELAXED, __HIP_MEMORY_SCOPE_WORKGROUP); }
        __syncthreads();
    }
    { const int qx = tid >> 3, part = tid & 7; const float rs = 1.f / sqrtf(SSQ[qx] * (1.f / 512.f) + RMS_EPS);
      const LAS unsigned char* orow = L + att::OST_OFF + qx * att::OST_ROW + part * 128; bf16* dst = F_MIXA + ((size_t)b * SEQ + 64 * i + qx) * 1024 + 512 + part * 64;
#pragma unroll
      for (int c = 0; c < 8; ++c) { float f[8]; up8(*(const LAS v4u*)(orow + c * 16), f); const f32x4 g0 = *(const GAS f32x4*)(F_gn_attn + part * 64 + c * 8), g1 = *(const GAS f32x4*)(F_gn_attn + part * 64 + c * 8 + 4);
          v4u o; o.x = pk2(f[0] * rs * g0[0], f[1] * rs * g0[1]); o.y = pk2(f[2] * rs * g0[2], f[3] * rs * g0[3]); o.z = pk2(f[4] * rs * g1[0], f[5] * rs * g1[1]); o.w = pk2(f[6] * rs * g1[2], f[7] * rs * g1[3]);
          *(GAS v4u*)(dst + c * 8) = o; } }
    __syncthreads();
}
__device__ __forceinline__ void p3_attention(Frame& F) {
    for (int u = F.vcu; u < 512; u += F.G) { const int k = u >> 8, v = u & 255; const int b = v >> 5, s = v & 31; p3_unit(F, b, k ? 63 - s : s); }
}

namespace peer {
constexpr int IDX_OFF = 0, W6_OFF = 16384;
__device__ __forceinline__ unsigned f2key(float f) { const unsigned u = __builtin_bit_cast(unsigned, f); return u ^ ((unsigned)((int)u >> 31) | 0x80000000u); }
__device__ __forceinline__ float key2f(unsigned k) { return __builtin_bit_cast(float, k ^ ((k & 0x80000000u) ? 0x80000000u : 0xFFFFFFFFu)); }
__device__ __forceinline__ unsigned umax(unsigned a, unsigned b) { return a > b ? a : b; }
__device__ __forceinline__ unsigned umin(unsigned a, unsigned b) { return a < b ? a : b; }
__device__ __forceinline__ void sort16_desc(unsigned (&a)[16]) {
#pragma unroll
    for (int k = 2; k <= 16; k <<= 1) {
#pragma unroll
        for (int j = k >> 1; j > 0; j >>= 1) {
#pragma unroll
            for (int i = 0; i < 16; ++i) { const int l = i ^ j; if (l > i) { const bool up = ((i & k) == 0); const unsigned mx = umax(a[i], a[l]), mn = umin(a[i], a[l]); a[i] = up ? mx : mn; a[l] = up ? mn : mx; } }
        }
    }
}
__device__ __forceinline__ void merge16_desc(unsigned (&A)[16], const unsigned (&B)[16]) {
#pragma unroll
    for (int i = 0; i < 16; ++i) A[i] = umax(A[i], B[15 - i]);
#pragma unroll
    for (int j = 8; j > 0; j >>= 1) {
#pragma unroll
        for (int i = 0; i < 16; ++i) { const int l = i ^ j; if (l > i) { const unsigned mx = umax(A[i], A[l]), mn = umin(A[i], A[l]); A[i] = mx; A[l] = mn; } }
    }
}
template <int GQ> __device__ __forceinline__ void fill_cands(unsigned (&g)[16], const float (&f0)[16], const float (&f1)[16]) {
    if constexpr (GQ == 0) {
        g[0] = (f2key(f0[0] + f1[0]) & ~255u) | 255u;
        g[1] = (f2key(f0[0] + f1[1]) & ~255u) | 254u;
        g[2] = (f2key(f0[0] + f1[2]) & ~255u) | 253u;
        g[3] = (f2key(f0[0] + f1[3]) & ~255u) | 252u;
        g[4] = (f2key(f0[0] + f1[4]) & ~255u) | 251u;
        g[5] = (f2key(f0[0] + f1[5]) & ~255u) | 250u;
        g[6] = (f2key(f0[0] + f1[6]) & ~255u) | 249u;
        g[7] = (f2key(f0[0] + f1[7]) & ~255u) | 248u;
        g[8] = (f2key(f0[0] + f1[8]) & ~255u) | 247u;
        g[9] = (f2key(f0[0] + f1[9]) & ~255u) | 246u;
        g[10] = (f2key(f0[0] + f1[10]) & ~255u) | 245u;
        g[11] = (f2key(f0[0] + f1[11]) & ~255u) | 244u;
        g[12] = (f2key(f0[0] + f1[12]) & ~255u) | 243u;
        g[13] = (f2key(f0[0] + f1[13]) & ~255u) | 242u;
        g[14] = (f2key(f0[0] + f1[14]) & ~255u) | 241u;
        g[15] = (f2key(f0[0] + f1[15]) & ~255u) | 240u;
    }
    if constexpr (GQ == 1) {
        g[0] = (f2key(f0[1] + f1[0]) & ~255u) | 239u;
        g[1] = (f2key(f0[1] + f1[1]) & ~255u) | 238u;
        g[2] = (f2key(f0[1] + f1[2]) & ~255u) | 237u;
        g[3] = (f2key(f0[1] + f1[3]) & ~255u) | 236u;
        g[4] = (f2key(f0[1] + f1[4]) & ~255u) | 235u;
        g[5] = (f2key(f0[1] + f1[5]) & ~255u) | 234u;
        g[6] = (f2key(f0[1] + f1[6]) & ~255u) | 233u;
        g[7] = (f2key(f0[1] + f1[7]) & ~255u) | 232u;
        g[8] = (f2key(f0[2] + f1[0]) & ~255u) | 223u;
        g[9] = (f2key(f0[2] + f1[1]) & ~255u) | 222u;
        g[10] = (f2key(f0[2] + f1[2]) & ~255u) | 221u;
        g[11] = (f2key(f0[2] + f1[3]) & ~255u) | 220u;
        g[12] = (f2key(f0[2] + f1[4]) & ~255u) | 219u;
        g[13] = (f2key(f0[3] + f1[0]) & ~255u) | 207u;
        g[14] = (f2key(f0[3] + f1[1]) & ~255u) | 206u;
        g[15] = (f2key(f0[3] + f1[2]) & ~255u) | 205u;
    }
    if constexpr (GQ == 2) {
        g[0] = (f2key(f0[3] + f1[3]) & ~255u) | 204u;
        g[1] = (f2key(f0[4] + f1[0]) & ~255u) | 191u;
        g[2] = (f2key(f0[4] + f1[1]) & ~255u) | 190u;
        g[3] = (f2key(f0[4] + f1[2]) & ~255u) | 189u;
        g[4] = (f2key(f0[5] + f1[0]) & ~255u) | 175u;
        g[5] = (f2key(f0[5] + f1[1]) & ~255u) | 174u;
        g[6] = (f2key(f0[6] + f1[0]) & ~255u) | 159u;
        g[7] = (f2key(f0[6] + f1[1]) & ~255u) | 158u;
        g[8] = (f2key(f0[7] + f1[0]) & ~255u) | 143u;
        g[9] = (f2key(f0[7] + f1[1]) & ~255u) | 142u;
        g[10] = (f2key(f0[8] + f1[0]) & ~255u) | 127u;
        g[11] = (f2key(f0[9] + f1[0]) & ~255u) | 111u;
        g[12] = (f2key(f0[10] + f1[0]) & ~255u) | 95u;
        g[13] = (f2key(f0[11] + f1[0]) & ~255u) | 79u;
        g[14] = (f2key(f0[12] + f1[0]) & ~255u) | 63u;
        g[15] = (f2key(f0[13] + f1[0]) & ~255u) | 47u;
    }
    if constexpr (GQ == 3) {
        g[0] = (f2key(f0[14] + f1[0]) & ~255u) | 31u;
        g[1] = (f2key(f0[15] + f1[0]) & ~255u) | 15u;
        g[2] = 0u;
        g[3] = 0u;
        g[4] = 0u;
        g[5] = 0u;
        g[6] = 0u;
        g[7] = 0u;
        g[8] = 0u;
        g[9] = 0u;
        g[10] = 0u;
        g[11] = 0u;
        g[12] = 0u;
        g[13] = 0u;
        g[14] = 0u;
        g[15] = 0u;
    }
}
__device__ __forceinline__ float dot2bf(unsigned a, unsigned b, float c) { return __builtin_amdgcn_fdot2_f32_bf16(__builtin_bit_cast(bf16x2v, a), __builtin_bit_cast(bf16x2v, b), c, false); }
__device__ __forceinline__ float dot8(const v4u a, const v4u b, float c) { c = dot2bf(a.x, b.x, c); c = dot2bf(a.y, b.y, c); c = dot2bf(a.z, b.z, c); return dot2bf(a.w, b.w, c); }
__device__ __forceinline__ float dot32b(const v4u u, const unsigned (&h)[16]) {
    float s0 = 0.f, s1 = 0.f, s2 = 0.f, s3 = 0.f;
#define P6_D2(W, bs, hi_, acc_) acc_ = __builtin_amdgcn_fdot2_f32_bf16(__builtin_amdgcn_cvt_scalef32_pk_bf16_fp4((W), 1.0f, (bs)), __builtin_bit_cast(bf16x2v, h[hi_]), acc_, false)
    P6_D2(u.x, 0, 0, s0); P6_D2(u.x, 1, 1, s1); P6_D2(u.x, 2, 2, s2); P6_D2(u.x, 3, 3, s3);
    P6_D2(u.y, 0, 4, s0); P6_D2(u.y, 1, 5, s1); P6_D2(u.y, 2, 6, s2); P6_D2(u.y, 3, 7, s3);
    P6_D2(u.z, 0, 8, s0); P6_D2(u.z, 1, 9, s1); P6_D2(u.z, 2, 10, s2); P6_D2(u.z, 3, 11, s3);
    P6_D2(u.w, 0, 12, s0); P6_D2(u.w, 1, 13, s1); P6_D2(u.w, 2, 14, s2); P6_D2(u.w, 3, 15, s3);
#undef P6_D2
    return (s0 + s1) + (s2 + s3);
}
typedef _Float16 h16x2 __attribute__((ext_vector_type(2)));
template <int BS> __device__ __forceinline__ h16x2 cvt4h(unsigned w) { return __builtin_bit_cast(h16x2, __builtin_amdgcn_cvt_scalef32_pk_f16_fp4(w, 1.0f, BS)); }
__device__ __forceinline__ void axpy32h(h16x2 (&acc)[16], const v4u v, _Float16 a) {
    const h16x2 a2 = (h16x2){a, a};
    acc[0] = __builtin_elementwise_fma(cvt4h<0>(v.x), a2, acc[0]); acc[1] = __builtin_elementwise_fma(cvt4h<1>(v.x), a2, acc[1]); acc[2] = __builtin_elementwise_fma(cvt4h<2>(v.x), a2, acc[2]); acc[3] = __builtin_elementwise_fma(cvt4h<3>(v.x), a2, acc[3]);
    acc[4] = __builtin_elementwise_fma(cvt4h<0>(v.y), a2, acc[4]); acc[5] = __builtin_elementwise_fma(cvt4h<1>(v.y), a2, acc[5]); acc[6] = __builtin_elementwise_fma(cvt4h<2>(v.y), a2, acc[6]); acc[7] = __builtin_elementwise_fma(cvt4h<3>(v.y), a2, acc[7]);
    acc[8] = __builtin_elementwise_fma(cvt4h<0>(v.z), a2, acc[8]); acc[9] = __builtin_elementwise_fma(cvt4h<1>(v.z), a2, acc[9]); acc[10] = __builtin_elementwise_fma(cvt4h<2>(v.z), a2, acc[10]); acc[11] = __builtin_elementwise_fma(cvt4h<3>(v.z), a2, acc[11]);
    acc[12] = __builtin_elementwise_fma(cvt4h<0>(v.w), a2, acc[12]); acc[13] = __builtin_elementwise_fma(cvt4h<1>(v.w), a2, acc[13]); acc[14] = __builtin_elementwise_fma(cvt4h<2>(v.w), a2, acc[14]); acc[15] = __builtin_elementwise_fma(cvt4h<3>(v.w), a2, acc[15]);
}
__device__ __forceinline__ float dot32(const v4u u, const f32x2 (&h)[16]) {
    f32x2 s = __builtin_amdgcn_cvt_scalef32_pk_f32_fp4(u.x, 1.0f, 0) * h[0];
    s += __builtin_amdgcn_cvt_scalef32_pk_f32_fp4(u.x, 1.0f, 1) * h[1]; s += __builtin_amdgcn_cvt_scalef32_pk_f32_fp4(u.x, 1.0f, 2) * h[2]; s += __builtin_amdgcn_cvt_scalef32_pk_f32_fp4(u.x, 1.0f, 3) * h[3];
    s += __builtin_amdgcn_cvt_scalef32_pk_f32_fp4(u.y, 1.0f, 0) * h[4]; s += __builtin_amdgcn_cvt_scalef32_pk_f32_fp4(u.y, 1.0f, 1) * h[5]; s += __builtin_amdgcn_cvt_scalef32_pk_f32_fp4(u.y, 1.0f, 2) * h[6]; s += __builtin_amdgcn_cvt_scalef32_pk_f32_fp4(u.y, 1.0f, 3) * h[7];
    s += __builtin_amdgcn_cvt_scalef32_pk_f32_fp4(u.z, 1.0f, 0) * h[8]; s += __builtin_amdgcn_cvt_scalef32_pk_f32_fp4(u.z, 1.0f, 1) * h[9]; s += __builtin_amdgcn_cvt_scalef32_pk_f32_fp4(u.z, 1.0f, 2) * h[10]; s += __builtin_amdgcn_cvt_scalef32_pk_f32_fp4(u.z, 1.0f, 3) * h[11];
    s += __builtin_amdgcn_cvt_scalef32_pk_f32_fp4(u.w, 1.0f, 0) * h[12]; s += __builtin_amdgcn_cvt_scalef32_pk_f32_fp4(u.w, 1.0f, 1) * h[13]; s += __builtin_amdgcn_cvt_scalef32_pk_f32_fp4(u.w, 1.0f, 2) * h[14]; s += __builtin_amdgcn_cvt_scalef32_pk_f32_fp4(u.w, 1.0f, 3) * h[15];
    return s.x + s.y;
}
__device__ __forceinline__ void axpy32(f32x2 (&acc)[16], const v4u v, float a) {
    const f32x2 a2 = (f32x2){a, a};
    acc[0] += __builtin_amdgcn_cvt_scalef32_pk_f32_fp4(v.x, 1.0f, 0) * a2; acc[1] += __builtin_amdgcn_cvt_scalef32_pk_f32_fp4(v.x, 1.0f, 1) * a2; acc[2] += __builtin_amdgcn_cvt_scalef32_pk_f32_fp4(v.x, 1.0f, 2) * a2; acc[3] += __builtin_amdgcn_cvt_scalef32_pk_f32_fp4(v.x, 1.0f, 3) * a2;
    acc[4] += __builtin_amdgcn_cvt_scalef32_pk_f32_fp4(v.y, 1.0f, 0) * a2; acc[5] += __builtin_amdgcn_cvt_scalef32_pk_f32_fp4(v.y, 1.0f, 1) * a2; acc[6] += __builtin_amdgcn_cvt_scalef32_pk_f32_fp4(v.y, 1.0f, 2) * a2; acc[7] += __builtin_amdgcn_cvt_scalef32_pk_f32_fp4(v.y, 1.0f, 3) * a2;
    acc[8] += __builtin_amdgcn_cvt_scalef32_pk_f32_fp4(v.z, 1.0f, 0) * a2; acc[9] += __builtin_amdgcn_cvt_scalef32_pk_f32_fp4(v.z, 1.0f, 1) * a2; acc[10] += __builtin_amdgcn_cvt_scalef32_pk_f32_fp4(v.z, 1.0f, 2) * a2; acc[11] += __builtin_amdgcn_cvt_scalef32_pk_f32_fp4(v.z, 1.0f, 3) * a2;
    acc[12] += __builtin_amdgcn_cvt_scalef32_pk_f32_fp4(v.w, 1.0f, 0) * a2; acc[13] += __builtin_amdgcn_cvt_scalef32_pk_f32_fp4(v.w, 1.0f, 1) * a2; acc[14] += __builtin_amdgcn_cvt_scalef32_pk_f32_fp4(v.w, 1.0f, 2) * a2; acc[15] += __builtin_amdgcn_cvt_scalef32_pk_f32_fp4(v.w, 1.0f, 3) * a2;
}
__device__ __forceinline__ float dot16(const v4u u, const f32x2 (&h)[8]) {
    f32x2 s = __builtin_amdgcn_cvt_pk_f32_fp8((int)u.x, false) * h[0];
    s += __builtin_amdgcn_cvt_pk_f32_fp8((int)u.x, true) * h[1];
    s += __builtin_amdgcn_cvt_pk_f32_fp8((int)u.y, false) * h[2]; s += __builtin_amdgcn_cvt_pk_f32_fp8((int)u.y, true) * h[3];
    s += __builtin_amdgcn_cvt_pk_f32_fp8((int)u.z, false) * h[4]; s += __builtin_amdgcn_cvt_pk_f32_fp8((int)u.z, true) * h[5];
    s += __builtin_amdgcn_cvt_pk_f32_fp8((int)u.w, false) * h[6]; s += __builtin_amdgcn_cvt_pk_f32_fp8((int)u.w, true) * h[7];
    return s.x + s.y;
}
__device__ __forceinline__ void axpy16(f32x2 (&acc)[8], const v4u v, float a) {
    const f32x2 a2 = (f32x2){a, a};
    acc[0] += __builtin_amdgcn_cvt_pk_f32_fp8((int)v.x, false) * a2; acc[1] += __builtin_amdgcn_cvt_pk_f32_fp8((int)v.x, true) * a2;
    acc[2] += __builtin_amdgcn_cvt_pk_f32_fp8((int)v.y, false) * a2; acc[3] += __builtin_amdgcn_cvt_pk_f32_fp8((int)v.y, true) * a2;
    acc[4] += __builtin_amdgcn_cvt_pk_f32_fp8((int)v.z, false) * a2; acc[5] += __builtin_amdgcn_cvt_pk_f32_fp8((int)v.z, true) * a2;
    acc[6] += __builtin_amdgcn_cvt_pk_f32_fp8((int)v.w, false) * a2; acc[7] += __builtin_amdgcn_cvt_pk_f32_fp8((int)v.w, true) * a2;
}
__device__ __forceinline__ float xsum32(float a, float b) { auto r = __builtin_amdgcn_permlane32_swap(__float_as_uint(a), __float_as_uint(b), false, false); return __uint_as_float(r[0]) + __uint_as_float(r[1]); }
__device__ __forceinline__ float xsum16(float a, float b) { auto r = __builtin_amdgcn_permlane16_swap(__float_as_uint(a), __float_as_uint(b), false, false); return __uint_as_float(r[0]) + __uint_as_float(r[1]); }
template <int CTRL> __device__ __forceinline__ float dppf(float v) { return __builtin_bit_cast(float, __builtin_amdgcn_update_dpp(0, __builtin_bit_cast(int, v), CTRL, 0xF, 0xF, true)); }
__device__ __forceinline__ float transpose_reduce8_dc(const float (&p)[8], int lane) {
    float x4[4], x2[2];
    { const bool bt = (lane & 4) != 0;
#pragma unroll
      for (int k = 0; k < 4; ++k) { const float keep = bt ? p[k + 4] : p[k], send = bt ? p[k] : p[k + 4]; x4[k] = keep + dppf<0x141>(send); } }
    { const bool bt = (lane & 2) != 0;
#pragma unroll
      for (int k = 0; k < 2; ++k) { const float keep = bt ? x4[k + 2] : x4[k], send = bt ? x4[k] : x4[k + 2]; x2[k] = keep + dppf<0x4E>(send); } }
    const bool bt = (lane & 1) != 0; const float keep = bt ? x2[1] : x2[0], send = bt ? x2[0] : x2[1]; return keep + dppf<0xB1>(send);
}
__device__ __forceinline__ float transpose_reduce8(const float (&p)[8], int lane) {
    float x4[4], x2[2];
    { const bool bt = (lane & 4) != 0;
#pragma unroll
      for (int k = 0; k < 4; ++k) { const float keep = bt ? p[k + 4] : p[k], send = bt ? p[k] : p[k + 4]; x4[k] = keep + __shfl_xor(send, 4); } }
    { const bool bt = (lane & 2) != 0;
#pragma unroll
      for (int k = 0; k < 2; ++k) { const float keep = bt ? x4[k + 2] : x4[k], send = bt ? x4[k] : x4[k + 2]; x2[k] = keep + __shfl_xor(send, 2); } }
    float r;
    { const bool bt = (lane & 1) != 0; const float keep = bt ? x2[1] : x2[0], send = bt ? x2[0] : x2[1]; r = keep + __shfl_xor(send, 1); }
    r += __shfl_xor(r, 8); r += __shfl_xor(r, 16); r += __shfl_xor(r, 32);
    return r;
}
__device__ __forceinline__ void cexf(float& a, float& b) { float mx, mn; asm("v_max_f32 %0, %1, %2" : "=v"(mx) : "v"(a), "v"(b)); asm("v_min_f32 %0, %1, %2" : "=v"(mn) : "v"(a), "v"(b)); a = mx; b = mn; }
__device__ __forceinline__ float fmaxr(float a, float b) { float mx; asm("v_max_f32 %0, %1, %2" : "=v"(mx) : "v"(a), "v"(b)); return mx; }
__device__ __forceinline__ void sort16f(float (&a)[16]) {
#define CX(i, j) cexf(a[i], a[j]);
    CX(0,1) CX(2,3) CX(4,5) CX(6,7) CX(8,9) CX(10,11) CX(12,13) CX(14,15) CX(0,2) CX(1,3) CX(4,6) CX(5,7) CX(8,10) CX(9,11) CX(12,14) CX(13,15) CX(1,2) CX(5,6) CX(9,10) CX(13,14) CX(0,4) CX(1,5) CX(2,6) CX(3,7) CX(8,12) CX(9,13) CX(10,14) CX(11,15) CX(2,4) CX(3,5) CX(10,12) CX(11,13) CX(1,2) CX(3,4) CX(5,6) CX(9,10) CX(11,12) CX(13,14) CX(0,8) CX(1,9) CX(2,10) CX(3,11) CX(4,12) CX(5,13) CX(6,14) CX(7,15) CX(4,8) CX(5,9) CX(6,10) CX(7,11) CX(2,4) CX(3,5) CX(6,8) CX(7,9) CX(10,12) CX(11,13) CX(1,2) CX(3,4) CX(5,6) CX(7,8) CX(9,10) CX(11,12) CX(13,14)
#undef CX
}
__device__ __forceinline__ void merge16f(float (&A)[16], const float (&B)[16]) {
#pragma unroll
    for (int i = 0; i < 16; ++i) A[i] = fmaxr(A[i], B[15 - i]);
#pragma unroll
    for (int j = 8; j > 0; j >>= 1) {
#pragma unroll
        for (int i = 0; i < 16; ++i) { const int l = i ^ j; if (l > i) cexf(A[i], A[l]); }
    }
}
__device__ __forceinline__ float keyf(float v, unsigned mask, unsigned code) { return __builtin_bit_cast(float, (__builtin_bit_cast(unsigned, v) & mask) | code); }
}

__device__ __forceinline__ void p6a_ldq(const bf16* QP, int tg32, int h, int c, int ln, bf16x8 (&bq)[8]) {
    const bf16* base = QP + ((size_t)(tg32 * 16 + (h * 2 + c)) * 8) * 512 + ln * 8;
#pragma unroll
    for (int s = 0; s < 8; ++s) bq[s] = *(const GAS bf16x8*)(base + 512 * s);
}
template <bool LOADQ, bool PREQ> __device__ __forceinline__ void p6a_top(Frame& F, const bf16* QP, int tg32, int h, int c, int hn, int cn, int hi, int r32, bf16x8 (&bq)[8], bf16x8 (&bqn)[8], float (&top)[16]) {
    int ln = hi * 32 + r32; asm volatile("" : "+v"(ln));
    if (LOADQ) p6a_ldq(QP, tg32, h, c, ln, bq);
    const bf16* ap0 = F_SUBK + (size_t)((h * 2 + c) * 32) * 512 + ln * 8;
    bf16x8 af[8];
#pragma unroll
    for (int s = 0; s < 8; ++s) af[s] = *(const GAS bf16x8*)(ap0 + 512 * s);
    unsigned km = ~127u; asm volatile("" : "+s"(km));
#pragma unroll
    for (int kt = 0; kt < 4; ++kt) {
        f32x16 acc;
#pragma unroll
        for (int r = 0; r < 16; ++r) acc[r] = 0.f;
#pragma unroll
        for (int s = 0; s < 8; ++s) acc = __builtin_amdgcn_mfma_f32_32x32x16_bf16(af[s], bq[s], acc, 0, 0, 0);
        if (kt < 3) {
#pragma unroll
            for (int s = 0; s < 8; ++s) af[s] = *(const GAS bf16x8*)(ap0 + 512 * (8 * (kt + 1) + s));
        }
        if (PREQ && kt == 3) p6a_ldq(QP, tg32, hn, cn, ln, bqn);
        __builtin_amdgcn_sched_group_barrier(0x008, 8, 0);
        if (kt < 3 || PREQ) __builtin_amdgcn_sched_group_barrier(0x020, 8, 0);
        float g[16];
#pragma unroll
        for (int r = 0; r < 16; ++r) g[r] = peer::keyf(acc[r], km, 63u - (unsigned)(16 * kt + r));
        peer::sort16f(g);
        if (kt == 0) {
#pragma unroll
            for (int r = 0; r < 16; ++r) top[r] = g[r];
        } else peer::merge16f(top, g);
    }
    const unsigned hb = hi ? 0u : 64u;
#pragma unroll
    for (int r = 0; r < 16; ++r) top[r] = __builtin_bit_cast(float, __builtin_bit_cast(unsigned, top[r]) | hb);
}
__device__ __forceinline__ void p6a_unit(Frame& F, int unit) {
    LAS unsigned char* L = F.lds + RING_OFF;
    const int lane = F.lane, w = F.wave, hi = lane >> 5, r32 = lane & 31;
    const bf16* QP = F_PROJ;
    const int tg = w & 3, hs = w >> 2;
    const size_t tokrow = (size_t)unit * 128 + tg * 32 + r32;
    LAS unsigned char* myidx = L + peer::IDX_OFF + (w * 64 + lane) * 32;
    const int tg32 = unit * 4 + tg;
    bf16x8 bqa[8], bqb[8];
    { int ln0 = lane; asm volatile("" : "+v"(ln0)); p6a_ldq(QP, tg32, hs * 4, 0, ln0, bqa); }
    for (int hp = 0; hp < 2; ++hp) {
        const int h0 = hs * 4 + 2 * hp, h = h0 + hi;
        const int hnx = hp ? h0 : h0 + 2;
        float s01[2][16];
#define P6A_XMERGE(C) do { \
            _Pragma("unroll") for (int r = 0; r < 16; ++r) { auto rr = __builtin_amdgcn_permlane32_swap(__builtin_bit_cast(unsigned, T0[r]), __builtin_bit_cast(unsigned, T1[r]), false, false); \
                T0[r] = __builtin_bit_cast(float, (unsigned)rr[0]); T1[r] = __builtin_bit_cast(float, (unsigned)rr[1]); }     \
            peer::merge16f(T0, T1); \
            _Pragma("unroll") for (int r = 0; r < 16; ++r) s01[C][r] = T0[r]; } while (0)
        { float T0[16], T1[16];
          p6a_top<false, true>(F, QP, tg32, h0, 0, h0 + 1, 0, hi, r32, bqa, bqb, T0); p6a_top<false, true>(F, QP, tg32, h0 + 1, 0, h0, 1, hi, r32, bqb, bqa, T1);
          P6A_XMERGE(0); }
        { float T0[16], T1[16];
          p6a_top<false, true>(F, QP, tg32, h0, 1, h0 + 1, 1, hi, r32, bqa, bqb, T0); p6a_top<false, true>(F, QP, tg32, h0 + 1, 1, hnx, 0, hi, r32, bqb, bqa, T1);
          P6A_XMERGE(1); }
#undef P6A_XMERGE
        { v4u i0, i1;
#define IDX4(S, o) ((127u - (__builtin_bit_cast(unsigned, (S)[o]) & 127u)) | ((127u - (__builtin_bit_cast(unsigned, (S)[o + 1]) & 127u)) << 8) | ((127u - (__builtin_bit_cast(unsigned, (S)[o + 2]) & 127u)) << 16) | ((127u - (__builtin_bit_cast(unsigned, (S)[o + 3]) & 127u)) << 24))
          i0.x = IDX4(s01[0], 0); i0.y = IDX4(s01[0], 4); i0.z = IDX4(s01[0], 8); i0.w = IDX4(s01[0], 12);
          i1.x = IDX4(s01[1], 0); i1.y = IDX4(s01[1], 4); i1.z = IDX4(s01[1], 8); i1.w = IDX4(s01[1], 12);
#undef IDX4
          *(LAS v4u*)(myidx) = i0; *(LAS v4u*)(myidx + 16) = i1; }
        const float NEG = __builtin_bit_cast(float, 0xFF800000u);
        const float (&f0)[16] = s01[0]; const float (&f1)[16] = s01[1];
#define CK(a, b) peer::keyf(f0[a] + f1[b], ~255u, 255u - (unsigned)(16 * (a) + (b)))
        float best[16], g[16];
#pragma unroll
        for (int b = 0; b < 16; ++b) best[b] = CK(0, b);
#pragma unroll
        for (int a = 1; a < 16; ++a) g[a - 1] = CK(a, 0);
        g[15] = NEG;
        peer::merge16f(best, g);
        g[0] = CK(1, 1); g[1] = CK(1, 2); g[2] = CK(1, 3); g[3] = CK(1, 4); g[4] = CK(1, 5); g[5] = CK(1, 6); g[6] = CK(1, 7);
        g[7] = CK(2, 1); g[8] = CK(2, 2); g[9] = CK(2, 3); g[10] = CK(2, 4); g[11] = CK(3, 1); g[12] = CK(3, 2); g[13] = CK(3, 3); g[14] = CK(4, 1); g[15] = CK(4, 2);
        peer::sort16f(g); peer::merge16f(best, g);
        g[0] = CK(5, 1); g[1] = CK(6, 1); g[2] = CK(7, 1);
#pragma unroll
        for (int r = 3; r < 16; ++r) g[r] = NEG;
        peer::merge16f(best, g);
#undef CK
        float ev[16]; float esum = 0.f; const float vmax = best[0];
#pragma unroll
        for (int k = 0; k < 16; ++k) { ev[k] = __expf(best[k] - vmax); esum += ev[k]; }
        const float einv = 1.f / esum;
        unsigned ent[16];
#pragma unroll
        for (int k = 0; k < 16; ++k) { const unsigned ab = 255u - (__builtin_bit_cast(unsigned, best[k]) & 255u); const unsigned ia = *(const LAS unsigned char*)(myidx + (ab >> 4)), ib = *(const LAS unsigned char*)(myidx + 16 + (ab & 15u));
            ent[k] = (ia * 128u + ib) | (f2bf(ev[k] * einv) << 16); }
        GAS v4u* dst = (GAS v4u*)((GAS unsigned*)(FWS(unsigned, WS_EXPG)) + tokrow * 128 + h * 16);
#pragma unroll
        for (int k = 0; k < 4; ++k) { v4u o; o.x = ent[4 * k]; o.y = ent[4 * k + 1]; o.z = ent[4 * k + 2]; o.w = ent[4 * k + 3]; dst[k] = o; }
    }
}
template <bool DUMMY> __device__ __forceinline__ void p6b_phase(Frame& F) {
    LAS unsigned char* L = F.lds + RING_OFF;
    const int lane = F.lane, w = F.wave;
    const unsigned* EXPG = FWS(unsigned, WS_EXPG);
    LAS unsigned* EW = (LAS unsigned*)(L + peer::W6_OFF + w * 6144);
    LAS _Float16* AH = (LAS _Float16*)(L + peer::W6_OFF + w * 6144 + 4096);
    const int gw = F.vcu * NWAVES + w, NGW = F.G * NWAVES;
    for (int tok0 = gw * 8; tok0 < TT; tok0 += NGW * 8) {
        int ln = lane; asm volatile("" : "+v"(ln));
        const int ts = ln >> 3, dc = ln & 7;
        const unsigned char* ubase = F_U + dc * 16;
        const unsigned char* vbase = F_V + dc * 16;
        const size_t tok = (size_t)tok0 + ts;
#pragma unroll
        for (int i = 0; i < 16; ++i) EW[i * 64 + ln] = EXPG[(size_t)tok0 * 128 + i * 64 + ln];
        float rstd;
        { const float* sq = F_SSQ + tok * 16 + 2 * dc; float ssp = sq[0] + sq[1]; ssp += __shfl_xor(ssp, 1); ssp += __shfl_xor(ssp, 2); ssp += __shfl_xor(ssp, 4);
          rstd = 1.f / sqrtf(ssp * (1.f / 1024.f) + RMS_EPS); }
        unsigned hq[16];
        { const float qs = rstd * (1.f / QSTEP);
#pragma unroll
          for (int q = 0; q < 16; ++q) { float g8[8]; up8(*(const GAS v4u*)(F_XN + tok * 1024 + 64 * q + 8 * dc), g8); unsigned wq = 0u;
#pragma unroll
              for (int e2 = 0; e2 < 8; ++e2) { const int qv = (int)__builtin_rintf(__builtin_fminf(__builtin_fmaxf(g8[e2] * qs, -8.f), 7.f)); wq |= ((unsigned)qv & 15u) << (4 * e2); }
              hq[q] = wq; } }
        const float dscale = QSTEP * QSTEP * (1.f / 32.f);
        LDS_WAIT(); asm volatile("" ::: "memory");
#define P6_ROWLD(R, base_, st_) do { const unsigned e0_ = EW[ts * 128 + 2 * (st_)] & 0xffffu, e1_ = EW[ts * 128 + 2 * (st_) + 1] & 0xffffu; \
            _Pragma("unroll") for (int c = 0; c < 4; ++c) { R[c] = *(const GAS v4u*)((base_) + (size_t)e0_ * 512 + 128 * c); R[4 + c] = *(const GAS v4u*)((base_) + (size_t)e1_ * 512 + 128 * c); } } while (0)
#define P6_IDOT(V4, hq4_, acc_) do { acc_ = __builtin_amdgcn_sdot8((int)(V4).x, (int)hq[(hq4_)], acc_, false); acc_ = __builtin_amdgcn_sdot8((int)(V4).y, (int)hq[(hq4_) + 1], acc_, false); \
            acc_ = __builtin_amdgcn_sdot8((int)(V4).z, (int)hq[(hq4_) + 2], acc_, false); acc_ = __builtin_amdgcn_sdot8((int)(V4).w, (int)hq[(hq4_) + 3], acc_, false); } while (0)
#define P6_DOT2(R, P, j0_) do { int i0_ = 0, i1_ = 0, i2_ = 0, i3_ = 0; \
            P6_IDOT(R[0], 0, i0_); P6_IDOT(R[1], 4, i1_); P6_IDOT(R[2], 8, i0_); P6_IDOT(R[3], 12, i1_); \
            P6_IDOT(R[4], 0, i2_); P6_IDOT(R[5], 4, i3_); P6_IDOT(R[6], 8, i2_); P6_IDOT(R[7], 12, i3_); \
            P[j0_] = (float)(i0_ + i1_); P[(j0_) + 1] = (float)(i2_ + i3_); } while (0)
        {
            v4u ra[8], rb[8];
            P6_ROWLD(ra, ubase, 0);
#pragma unroll 1
            for (int gq = 0; gq < 16; ++gq) {
                float p8[8];
                const int st = 4 * gq;
                P6_ROWLD(rb, ubase, st + 1); P6_DOT2(ra, p8, 0);
                P6_ROWLD(ra, ubase, st + 2); P6_DOT2(rb, p8, 2);
                P6_ROWLD(rb, ubase, st + 3); P6_DOT2(ra, p8, 4);
                if (gq < 15) P6_ROWLD(ra, ubase, st + 4);
                P6_DOT2(rb, p8, 6);
                const float d = peer::transpose_reduce8_dc(p8, lane);
                const unsigned ent = EW[ts * 128 + 8 * gq + dc];
                AH[ts * 128 + 8 * gq + dc] = (_Float16)(__builtin_bit_cast(float, ent & 0xffff0000u) * gelu_tanh(d * dscale));
            }
        }
        LDS_WAIT(); asm volatile("" ::: "memory");
        peer::h16x2 acc[64];
#pragma unroll
        for (int j = 0; j < 64; ++j) acc[j] = (peer::h16x2){(_Float16)0.f, (_Float16)0.f};
#define P6_AXPY2(R, st_) do { const _Float16 a0_ = AH[ts * 128 + 2 * (st_)], a1_ = AH[ts * 128 + 2 * (st_) + 1]; \
            _Pragma("unroll") for (int c = 0; c < 4; ++c) { peer::axpy32h(*(peer::h16x2 (*)[16])(acc + 16 * c), R[c], a0_); peer::axpy32h(*(peer::h16x2 (*)[16])(acc + 16 * c), R[4 + c], a1_); } } while (0)
        {
            v4u ra[8], rb[8];
            P6_ROWLD(ra, vbase, 0);
#pragma unroll 1
            for (int st = 0; st < 64; st += 2) {
                P6_ROWLD(rb, vbase, st + 1); P6_AXPY2(ra, st);
                if (st + 2 < 64) P6_ROWLD(ra, vbase, st + 2);
                P6_AXPY2(rb, st + 1);
            }
        }
#undef P6_ROWLD
#undef P6_DOT2
#undef P6_IDOT
#undef P6_AXPY2
        const float vs = 1.f / VSCALE; float ss = 0.f;
        int ln2 = lane; asm volatile("" : "+v"(ln2));
        const int ts2 = ln2 >> 3, dc2 = ln2 & 7; const size_t tok2 = (size_t)tok0 + ts2;
#pragma unroll
        for (int q = 0; q < 16; ++q) { float g8[8]; up8(*(const GAS v4u*)(F_XN + tok2 * 1024 + 64 * q + 8 * dc2), g8);
#pragma unroll
            for (int e2 = 0; e2 < 4; ++e2) { const peer::h16x2 av = acc[4 * q + e2]; g8[2 * e2] += (float)av.x * vs; g8[2 * e2 + 1] += (float)av.y * vs; }
#pragma unroll
            for (int e2 = 0; e2 < 8; ++e2) ss += g8[e2] * g8[e2]; }
        ss += __shfl_xor(ss, 1); ss += __shfl_xor(ss, 2); ss += __shfl_xor(ss, 4);
        const float rs = 1.f / sqrtf(ss * (1.f / 1024.f) + RMS_EPS);
        int zo = 0; asm volatile("" : "+v"(zo));
#pragma unroll
        for (int q = 0; q < 16; ++q) { const bf16* hp = F_XN + tok2 * 1024 + 64 * q + 8 * dc2 + zo; float* op = (DUMMY ? FWS(float, 160 * MiB) : F_out) + tok2 * 1024 + 64 * q + 8 * dc2; const float* gp = F_lnf + 64 * q + 8 * dc2;
            float g8[8]; up8(*(const GAS v4u*)hp, g8);
#pragma unroll
            for (int e2 = 0; e2 < 4; ++e2) { const peer::h16x2 av = acc[4 * q + e2]; g8[2 * e2] += (float)av.x * vs; g8[2 * e2 + 1] += (float)av.y * vs; }
            const f32x4 ga = *(const GAS f32x4*)gp, gb = *(const GAS f32x4*)(gp + 4);
            *(GAS f32x4*)op = (f32x4){g8[0], g8[1], g8[2], g8[3]} * rs * ga; *(GAS f32x4*)(op + 4) = (f32x4){g8[4], g8[5], g8[6], g8[7]} * rs * gb; }
        LDS_WAIT(); asm volatile("" ::: "memory");
    }
}
__device__ __forceinline__ void p6a_phase(Frame& F) { for (int u = F.vcu; u < TT / 128; u += F.G) p6a_unit(F, u); }
#ifndef HYB
#define HYB 7
#endif
__global__ void __launch_bounds__(NWAVES * 64, 2) mk_fwd(Args args) {
    extern __shared__ __attribute__((aligned(16))) unsigned char lds[];
    Frame F;
    F.lds = (LAS unsigned char*)lds;
    F.MISC = (volatile LAS unsigned*)(F.lds + MISC_OFF);
    F.tid = threadIdx.x; F.lane = F.tid & 63; F.wave = __builtin_amdgcn_readfirstlane(F.tid >> 6);
    F.G = gridDim.x; { const int bx = blockIdx.x; F.vcu = (F.G % 8 == 0) ? (bx % 8) * (F.G / 8) + bx / 8 : bx; }
    F.a = &args;
    F.ctl = (gu32*)(args.ws + WS_CTL);
    for (int u = F.tid; u < (LDS_BYTES - LDSCTL_OFF) / 4; u += NWAVES * 64) ((LAS unsigned*)(F.lds + LDSCTL_OFF))[u] = 0u;
    __syncthreads();
    XcdBarrier bar = xcd_barrier_post((unsigned*)(F.ctl + CW_BAR), F.MISC + 8);
    const int lo = args.ph_lo, hi = args.ph_hi;
#define IN(k) (lo <= (k) && (k) < hi)
#define BOTH(k) (IN(k) && IN((k) + 1))
    if (IN(0)) { p0_prologue(F);
#ifdef DUP_P0
        p0_prologue(F);
#endif
        if (BOTH(0)) xcd_barrier(bar); }
    if (IN(1)) {
        pg8::Gemm g{F_XN, F_WinT, TT, NPROJ, DM}; pg8::StaticOrder S; S.init(TT, NPROJ, F.G, (int)blockIdx.x);
        pg8::EpiProj E{F_PROJ, NPROJ, C_Q / 256, C_KC / 256, QSCALE};
        pg8::gemm_phase<pg8::EpiProj, pg8::StaticOrder, true, true>(F.lds + RING_OFF, g, S, E);
#ifdef DUP_P1
        pg8::gemm_phase<pg8::EpiProj, pg8::StaticOrder, true, true>(F.lds + RING_OFF, g, S, E);
#endif
        if (BOTH(1)) xcd_barrier(bar);
    }
#ifdef DUP_BAR
    if (IN(2)) { for (int zz = 0; zz < 10; ++zz) xcd_barrier(bar); }
#endif
    if (IN(2)) { p2_phase(F);
#ifdef DUP_P2
        p2_phase(F);
#endif
        if (BOTH(2)) xcd_barrier(bar); }
#if HYB >= 4
    if (IN(3)) { p3_attention(F);
#ifdef DUP_P3
        p3_attention(F);
#endif
        if (BOTH(3)) xcd_barrier(bar); }
#endif
#if HYB >= 5
    if (IN(4)) {
        pg8::Gemm g{F_MIXA, F_WoutT, TT, DM, DM}; pg8::StaticOrder S; S.init(TT, DM, F.G, (int)blockIdx.x);
        pg8::EpiResid E{F_x, F_XN, F_SSQ, DM};
        pg8::gemm_phase<pg8::EpiResid, pg8::StaticOrder, true, true>(F.lds + RING_OFF, g, S, E);
#ifdef DUP_P4
        pg8::gemm_phase<pg8::EpiResid, pg8::StaticOrder, true, true>(F.lds + RING_OFF, g, S, E);
#endif
        if (BOTH(4)) xcd_barrier(bar);
    }
#endif
#if HYB >= 6
    if (IN(5)) {
        pg8::Gemm g{F_XN, F_WqT, TT, NQP, DM}; pg8::StaticOrder S; S.init(TT, NQP, F.G, (int)blockIdx.x);
        pg8::EpiScaleRow E{F_PROJ, NQP, F_SSQ, RMS_EPS};
        pg8::gemm_phase<pg8::EpiScaleRow, pg8::StaticOrder, true, true>(F.lds + RING_OFF, g, S, E);
#ifdef DUP_P5
        pg8::gemm_phase<pg8::EpiScaleRow, pg8::StaticOrder, true, true>(F.lds + RING_OFF, g, S, E);
#endif
        if (BOTH(5)) xcd_barrier(bar);
    }
#endif
#if HYB >= 7
    if (IN(6)) { p6a_phase(F);
#ifdef DUP_6A
        p6a_phase(F);
#endif
        xcd_barrier(bar);
#ifdef DUP_6B
        p6b_phase<true>(F);
#endif
        p6b_phase<false>(F); }
#endif
#undef IN
#undef BOTH
}

extern "C" void kernel_launch(void* const* d_in, const int* in_sizes, int n_in, void* d_out, int out_size, void* d_ws, size_t ws_size, hipStream_t stream) {
    static int grid = 0;
    if (grid == 0) {
        if (n_in != 19 || in_sizes[0] != TT * DM || out_size != TT * DM || ws_size < 512 * MiB) { fprintf(stderr, "kernel_launch: unexpected shapes (n_in %d, in0 %d, out %d, ws %zu); nothing launched\n", n_in, n_in > 0 ? in_sizes[0] : -1, out_size, ws_size); grid = -1; return; }
        int dev = 0, cus = 0, per_cu = 0;
        if (hipGetDevice(&dev) != hipSuccess || hipDeviceGetAttribute(&cus, hipDeviceAttributeMultiprocessorCount, dev) != hipSuccess) { grid = -1; return; }
        if (hipFuncSetAttribute((const void*)mk_fwd, hipFuncAttributeMaxDynamicSharedMemorySize, LDS_BYTES) != hipSuccess) { fprintf(stderr, "kernel_launch: hipFuncSetAttribute failed\n"); grid = -1; return; }
        if (hipOccupancyMaxActiveBlocksPerMultiprocessor(&per_cu, (const void*)mk_fwd, NWAVES * 64, LDS_BYTES) != hipSuccess || per_cu < 1) fprintf(stderr, "kernel_launch: note: occupancy query reports %d workgroups per CU\n", per_cu);
        (void)hipGetLastError();
        grid = cus;
    }
    if (grid < 0) return;
    if (hipMemsetAsync((char*)d_ws + WS_CTL, 0, CTL_ZERO_BYTES, stream) != hipSuccess) return;
    Args a{};
    for (int i = 0; i < 19; ++i) a.in[i] = (const float*)d_in[i];
    a.out = (float*)d_out; a.ws = (unsigned char*)d_ws; a.ph_lo = 0; a.ph_hi = HYB;
    hipLaunchKernelGGL(mk_fwd, dim3(grid), dim3(NWAVES * 64), LDS_BYTES, stream, a);
#if HYB < 7
    using namespace nv;
    char* ws = (char*)d_ws;
    const float* x = a.in[0]; const float* conv_w = a.in[3]; const float* pos_k = a.in[4]; const float* pos_v = a.in[5]; const float* k_w1 = a.in[6]; const float* k_w2 = a.in[7]; const float* v_w1 = a.in[8]; const float* v_w2 = a.in[9];
    const float* gn_conv = a.in[10]; const float* gn_attn = a.in[11]; const float* w_out = a.in[12]; const float* ln2 = a.in[13]; const float* wq = a.in[14]; const float* subkeys = a.in[15]; const float* pu = a.in[16]; const float* pv = a.in[17]; const float* lnf = a.in[18];
    float* out = (float*)d_out;
    const bf16* PROJ = (const bf16*)(ws + WS_PROJ); const bf16* MIXA = (const bf16*)(ws + WS_MIXA); const bf16* KCC = (const bf16*)(ws + WS_KCC); const bf16* VCC = (const bf16*)(ws + WS_VCC);
    float* MIXF = (float*)(ws + 32 * MiB);
    float* KCF = (float*)(ws + 420 * MiB); float* VCF = (float*)(ws + 422 * MiB);
    float* QPF = (float*)(ws + 160 * MiB);
    int* EIDX = (int*)(ws + 424 * MiB); float* EGATE = (float*)(ws + 440 * MiB);
#if HYB <= 2
    conv_kernel<bf16><<<TT / 4, 256, 0, stream>>>(PROJ, NPROJ, conv_w, gn_conv, MIXF);
    (void)hipMemsetAsync(KCF, 0, 4 * MiB, stream);
    compress_kernel<bf16><<<BATCH * N_CMP * 2, 256, 0, stream>>>(PROJ, NPROJ, C_KC, pos_k, k_w1, k_w2, KCF);
    compress_kernel<bf16><<<BATCH * N_CMP * 2, 256, 0, stream>>>(PROJ, NPROJ, C_VC, pos_v, v_w1, v_w2, VCF);
    nsa_naive<bf16, float, true><<<TT * 2, 256, 0, stream>>>(PROJ, NPROJ, KCF, VCF, MIXF);
    attn_norm<<<TT / 4, 256, 0, stream>>>(MIXF, gn_attn);
#elif HYB == 3
    cvt_bf16_f32<<<4096, 256, 0, stream>>>(MIXA, 1024, MIXF, 1024, TT, 512);
    nsa_naive<bf16, bf16, true><<<TT * 2, 256, 0, stream>>>(PROJ, NPROJ, KCC, VCC, MIXF);
    attn_norm<<<TT / 4, 256, 0, stream>>>(MIXF, gn_attn);
#elif HYB == 4
    cvt_bf16_f32<<<4096, 256, 0, stream>>>(MIXA, 1024, MIXF, 1024, TT, 1024);
#endif
#if HYB <= 4
    gemm_f32<float, true><<<dim3(1024 / 64, TT / 64), 256, 0, stream>>>(MIXF, 1024, w_out, out, x, TT, 1024, 1024);
#endif
    rmsnorm1024<<<TT / 4, 256, 0, stream>>>(out, ln2, MIXF, TT);
#if HYB <= 5
    gemm_f32<float, false><<<dim3(2048 / 64, TT / 64), 256, 0, stream>>>(MIXF, 1024, wq, QPF, nullptr, TT, 2048, 1024);
    peer_topk<float><<<TT * 8, 128, 0, stream>>>(QPF, subkeys, EIDX, EGATE);
#else
    peer_topk<bf16><<<TT * 8, 128, 0, stream>>>(PROJ, subkeys, EIDX, EGATE);
#endif
    peer_experts<<<TT, 256, 0, stream>>>(MIXF, EIDX, EGATE, pu, pv, lnf, out);
    (void)ln2; (void)KCC; (void)VCC; (void)MIXA;
#endif
}
```

```cpp
#include <hip/hip_runtime.h>
#include <cstdio>
#include <cstdint>
namespace pg8 {
#define PG8_LAS __attribute__((address_space(3)))
typedef unsigned short bf16_t;
typedef short bf16x8 __attribute__((ext_vector_type(8)));
typedef float f32x4 __attribute__((ext_vector_type(4)));
typedef unsigned u32x4 __attribute__((ext_vector_type(4)));
constexpr int BM = 256, BK = 64, HALF = 128, HTB = HALF * BK * 2  , STAGE_BYTES = 8 * HTB, NXCD = 8, WGM = 8;

__host__ __device__ __forceinline__ int lds_byte(int r, int c) { const int st = (r >> 4) * 2 + (c >> 5), rr = r & 15, cc = c & 31, ob = rr * 64 + cc * 2; return st * 1024 + (ob ^ (((ob >> 9) & 1) << 5)); }
__host__ __device__ __forceinline__ void stage_rc(int b, int& R, int& C) { const int st = b / 1024, sb = b % 1024, swz = sb ^ (((sb >> 9) & 1) << 5); R = (st >> 1) * 16 + swz / 64; C = (st & 1) * 32 + (swz % 64) / 2; }
__host__ __device__ __forceinline__ int perm32(int rho) { const int n = rho >> 4, i = rho & 15; return 8 * (i >> 2) + 4 * n + (i & 3); }

struct Unit { int pm, pn; };
struct Gemm { const bf16_t* A; const bf16_t* Bt; int M, N, K; };

struct StaticOrder {
    int nM, nN, nwg, G, c;
    __host__ __device__ void init(int M, int N, int G_, int c_) { nM = M / BM; nN = N / BM; nwg = nM * nN; G = G_; c = c_; }
    __host__ __device__ bool next(int i, Unit& u) const {
        const long L = (long)i * G + c; if (L >= nwg) return false;
        int wgid = (int)L; { const int q = nwg / NXCD, r = nwg % NXCD, xcd = wgid % NXCD, off = wgid / NXCD; wgid = (xcd < r ? xcd * (q + 1) : r * (q + 1) + (xcd - r) * q) + off; }
        const int nig = WGM * nN, gid = wgid / nig, fm = gid * WGM, gsz = (nM - fm) < WGM ? (nM - fm) : WGM;
        u.pm = fm + ((wgid % nig) % gsz); u.pn = (wgid % nig) / gsz; return true;
    }
    __device__ __forceinline__ void a_ready(const Unit&) const {}
    __device__ __forceinline__ void done(const Unit&) const {}
};

__device__ __forceinline__ unsigned cvt_pk_bf16(float lo, float hi) { unsigned r; asm volatile("v_cvt_pk_bf16_f32 %0, %1, %2" : "=v"(r) : "v"(lo), "v"(hi)); return r; }
typedef float f32x2 __attribute__((ext_vector_type(2)));
__device__ __forceinline__ f32x2 gelu_pk(f32x2 v) {
    const f32x2 av = __builtin_elementwise_abs(v), d = av * 0.2316418882f + 1.0f;
    f32x2 t; t.x = __builtin_amdgcn_rcpf(d.x); t.y = __builtin_amdgcn_rcpf(d.y);
    f32x2 q = t * 0.5307027145f + (-0.7265760135f); q = q * t + 0.7107068705f; q = q * t + (-0.142248368f); q = q * t + 0.127414796f; q = q * t;
    const f32x2 s = (v * v) * (-0.72134752044f);
    f32x2 e; e.x = __builtin_amdgcn_exp2f(s.x); e.y = __builtin_amdgcn_exp2f(s.y);
    const f32x2 m = v * (q * e), r = v - m;
    f32x2 o; o.x = v.x < 0.f ? m.x : r.x; o.y = v.y < 0.f ? m.y : r.y; return o;
}

template <int ACT  > struct EpiBf16 {
    static constexpr bool PERM = true, AFTER_DRAIN = false, PRE = false; static_assert(ACT == 0 || ACT == 1, "EpiBf16: ACT is 0 (none) or 1 (gelu_pk)");
    bf16_t* O; int ldc; const float* bias; int split_cols; size_t split_stride; float scale0;
    __device__ __forceinline__ void operator()(const f32x4 (&acc)[2][2][4][2], const Unit& u, int wr, int wc, int fr, int fq) const {
        const int row0 = u.pm * BM + wr * 64 + fr; int colt = u.pn * BM; bf16_t* base = O;
        float sc = 1.f; if (split_cols) { const int t = colt / split_cols; base += (size_t)t * split_stride; colt -= t * split_cols; if (t == 0) sc = scale0; }
        const int col0 = colt + wc * 32 + 8 * fq, bcol0 = u.pn * BM + wc * 32 + 8 * fq;
        f32x4 bv[2][2];
#pragma unroll
        for (int bj = 0; bj < 2; ++bj)
#pragma unroll
            for (int n = 0; n < 2; ++n) bv[bj][n] = bias ? *(const f32x4*)(bias + bcol0 + bj * HALF + 4 * n) : (f32x4){0.f, 0.f, 0.f, 0.f};
#pragma unroll
        for (int ai = 0; ai < 2; ++ai)
#pragma unroll
            for (int m = 0; m < 4; ++m) { bf16_t* rowp = base + (size_t)(row0 + ai * HALF + m * 16) * ldc + col0;
#pragma unroll
                for (int bj = 0; bj < 2; ++bj) { f32x4 v0 = acc[ai][bj][m][0] + bv[bj][0], v1 = acc[ai][bj][m][1] + bv[bj][1];
                    if (ACT == 1) { f32x2 a = gelu_pk((f32x2){v0[0], v0[1]}), b = gelu_pk((f32x2){v0[2], v0[3]}), c = gelu_pk((f32x2){v1[0], v1[1]}), d = gelu_pk((f32x2){v1[2], v1[3]});
                        v0 = (f32x4){a.x, a.y, b.x, b.y}; v1 = (f32x4){c.x, c.y, d.x, d.y}; }
                    v0 = v0 * sc; v1 = v1 * sc; u32x4 w; w.x = cvt_pk_bf16(v0[0], v0[1]); w.y = cvt_pk_bf16(v0[2], v0[3]); w.z = cvt_pk_bf16(v1[0], v1[1]); w.w = cvt_pk_bf16(v1[2], v1[3]);
                    *(u32x4*)(rowp + bj * HALF) = w; } }
    }
};
typedef unsigned u32x2e __attribute__((ext_vector_type(2)));
struct EpiProj {
    static constexpr bool PERM = true, AFTER_DRAIN = false, PRE = false;
    bf16_t* O; int ldc; int qt0, qt1; float qscale;
    __device__ __forceinline__ void operator()(const f32x4 (&acc)[2][2][4][2], const Unit& u, int wr, int wc, int fr, int fq) const {
        const int row0 = u.pm * BM + wr * 64 + fr; const int col0 = u.pn * BM + wc * 32 + 8 * fq;
        const float sc = (u.pn >= qt0 && u.pn < qt1) ? qscale : 1.f;
#pragma unroll
        for (int ai = 0; ai < 2; ++ai)
#pragma unroll
            for (int m = 0; m < 4; ++m) { bf16_t* rowp = O + (size_t)(row0 + ai * HALF + m * 16) * ldc + col0;
#pragma unroll
                for (int bj = 0; bj < 2; ++bj) { const f32x4 v0 = acc[ai][bj][m][0] * sc, v1 = acc[ai][bj][m][1] * sc;
                    u32x4 w; w.x = cvt_pk_bf16(v0[0], v0[1]); w.y = cvt_pk_bf16(v0[2], v0[3]); w.z = cvt_pk_bf16(v1[0], v1[1]); w.w = cvt_pk_bf16(v1[2], v1[3]);
                    asm volatile("global_store_dwordx4 %0, %1, off sc0 sc1 nt\n\ts_nop 1" :: "v"(rowp + bj * HALF), "v"(w) : "memory");     } }
    }
};
struct EpiResid {
    static constexpr bool PERM = true, AFTER_DRAIN = false, PRE = true;
    const float* base; bf16_t* hb; float* ssq; int ldc;
    __device__ __forceinline__ void pre(const Unit& u, int wr, int wc, int fr, int fq, f32x4 (&pq)[8]) const {
        const int col0 = u.pn * BM + wc * 32 + 8 * fq;
#pragma unroll
        for (int m = 0; m < 1; ++m) { const size_t off = (size_t)(u.pm * BM + wr * 64 + m * 16 + fr) * ldc + col0;
#pragma unroll
            for (int bj = 0; bj < 2; ++bj) { pq[m * 4 + bj * 2] = *(const f32x4*)(base + off + bj * HALF); pq[m * 4 + bj * 2 + 1] = *(const f32x4*)(base + off + bj * HALF + 4); } }
    }
    __device__ __forceinline__ void operator()(const f32x4 (&acc)[2][2][4][2], const Unit& u, int wr, int wc, int fr, int fq, const f32x4 (&pq)[8]) const {
        const int col0 = u.pn * BM + wc * 32 + 8 * fq;
#pragma unroll
        for (int ai = 0; ai < 2; ++ai)
#pragma unroll
            for (int m = 0; m < 4; ++m) { const int r = u.pm * BM + ai * HALF + wr * 64 + m * 16 + fr; const size_t off = (size_t)r * ldc + col0; float s = 0.f;
#pragma unroll
                for (int bj = 0; bj < 2; ++bj) { const bool pf = (ai == 0 && m < 1);
                    const f32x4 b0 = pf ? pq[(m & 1) * 4 + bj * 2] : *(const f32x4*)(base + off + bj * HALF), b1 = pf ? pq[(m & 1) * 4 + bj * 2 + 1] : *(const f32x4*)(base + off + bj * HALF + 4);
                    const f32x4 o0 = b0 + acc[ai][bj][m][0], o1 = b1 + acc[ai][bj][m][1];
                    s += ((o0[0] * o0[0] + o0[1] * o0[1]) + (o0[2] * o0[2] + o0[3] * o0[3])) + ((o1[0] * o1[0] + o1[1] * o1[1]) + (o1[2] * o1[2] + o1[3] * o1[3]));
                    u32x4 w; w.x = cvt_pk_bf16(o0[0], o0[1]); w.y = cvt_pk_bf16(o0[2], o0[3]); w.z = cvt_pk_bf16(o1[0], o1[1]); w.w = cvt_pk_bf16(o1[2], o1[3]); *(u32x4*)(hb + off + bj * HALF) = w; }
                s += __shfl_xor(s, 16); s += __shfl_xor(s, 32);
                if (fq == 0) ssq[(size_t)r * 16 + u.pn * 4 + wc] = s;
                if (m & 1) asm volatile("" ::: "memory"); }
    }
};
struct EpiScaleRow {
    static constexpr bool PERM = true, AFTER_DRAIN = false, PRE = true;
    bf16_t* O; int ldc; const float* ssq; float eps;
    __device__ __forceinline__ void pre(const Unit& u, int wr, int  , int fr, int fq, f32x4 (&pq)[8]) const {
        const int row0 = u.pm * BM + wr * 64 + fr;
#pragma unroll
        for (int m = 0; m < 4; ++m) pq[m] = *(const f32x4*)(ssq + (size_t)(row0 + m * 16) * 16 + 4 * fq);
    }
    __device__ __forceinline__ void operator()(const f32x4 (&acc)[2][2][4][2], const Unit& u, int wr, int wc, int fr, int fq, const f32x4 (&pq)[8]) const {
        const int row0 = u.pm * BM + wr * 64 + fr;
        f32x4 p2[4];
#pragma unroll
        for (int m = 0; m < 4; ++m) p2[m] = *(const f32x4*)(ssq + (size_t)(row0 + HALF + m * 16) * 16 + 4 * fq);
#pragma unroll
        for (int ai = 0; ai < 2; ++ai)
#pragma unroll
            for (int m = 0; m < 4; ++m) { const int r = row0 + ai * HALF + m * 16; const f32x4 t4 = ai ? p2[m] : pq[m]; float tot = (t4[0] + t4[1]) + (t4[2] + t4[3]);
                tot += __shfl_xor(tot, 16); tot += __shfl_xor(tot, 32);
                const float rs = 1.0f / sqrtf(tot * (1.0f / 1024.0f) + eps);
#pragma unroll
                for (int bj = 0; bj < 2; ++bj) { const f32x4 v0 = acc[ai][bj][m][0] * rs, v1 = acc[ai][bj][m][1] * rs;
                    u32x4 w; w.x = cvt_pk_bf16(v0[0], v0[1]); w.y = cvt_pk_bf16(v0[2], v0[3]); w.z = cvt_pk_bf16(v1[0], v1[1]); w.w = cvt_pk_bf16(v1[2], v1[3]);
                    const size_t blk = ((size_t)(r >> 5) * 16 + (u.pn * 2 + bj)) * 8 + (2 * wc + (fq >> 1));
                    __builtin_nontemporal_store(w, (u32x4*)(O + blk * 512 + ((fq & 1) * 32 + (r & 31)) * 8)); } }
    }
};

template <class Epi, class Sched, bool ALIGN_EPI = false, bool SP2 = false>
__device__ __forceinline__ void gemm_phase(PG8_LAS unsigned char* lds, const Gemm g, const Sched& S, const Epi& E) {
    const int tid = threadIdx.x, wid = __builtin_amdgcn_readfirstlane(tid >> 6), lane = tid & 63, wr = wid >> 2, wc = wid & 3, fr = lane & 15, fq = lane >> 4;
    const int K = g.K, nt = K / BK;
    unsigned voffA[2], voffB[2];
#pragma unroll
    for (int i = 0; i < 2; ++i) { int R, C; stage_rc(tid * 16 + i * 8192, R, C); const int Rb = Epi::PERM ? ((R & ~31) + perm32(R & 31)) : R;
        voffA[i] = (unsigned)(R * K + C) * 2u; voffB[i] = (unsigned)(Rb * K + C) * 2u; }
    const size_t kstep = (size_t)(BK * 2);
    const size_t hstep = (size_t)HALF * K * 2;
    const size_t tstep = 2 * hstep;
    const unsigned ldsw = (unsigned)wid * 1024u;
    const int aoff = lds_byte(wr * 64 + fr, fq * 8), boff = lds_byte(wc * 32 + fr, fq * 8);
#define PG8_SA(b, h) (((b) * 2 + (h)) * HTB)
#define PG8_SB(b, h) ((4 + (b) * 2 + (h)) * HTB)
#define PG8_STAGE(bufoff, gbase, voff) do { _Pragma("unroll") for (int _i = 0; _i < 2; ++_i) \
        __builtin_amdgcn_global_load_lds((const unsigned*)((const char*)(gbase) + (voff)[_i]), (PG8_LAS unsigned*)(lds + (bufoff) + ldsw + _i * 8192), 16, 0, 0); } while (0)
#define PG8_LDA(dst, b, h) do { _Pragma("unroll") for (int m = 0; m < 4; ++m) _Pragma("unroll") for (int k = 0; k < 2; ++k) dst[m][k] = *(const PG8_LAS bf16x8*)(lds + PG8_SA(b, h) + aoff + m * 2048 + k * 1024); } while (0)
#define PG8_LDB(dst, b, h) do { _Pragma("unroll") for (int n = 0; n < 2; ++n) _Pragma("unroll") for (int k = 0; k < 2; ++k) dst[n][k] = *(const PG8_LAS bf16x8*)(lds + PG8_SB(b, h) + boff + n * 2048 + k * 1024); } while (0)
#define PG8_MMA(ai, bj, At, Bt) do { __builtin_amdgcn_s_setprio(1); _Pragma("unroll") for (int m = 0; m < 4; ++m) _Pragma("unroll") for (int n = 0; n < 2; ++n) _Pragma("unroll") for (int k = 0; k < 2; ++k) \
        acc[ai][bj][m][n] = __builtin_amdgcn_mfma_f32_16x16x32_bf16(Bt[n][k], At[m][k], acc[ai][bj][m][n], 0, 0, 0); __builtin_amdgcn_s_setprio(0); } while (0)
#define PG8_WAIT_V(n) asm volatile("s_waitcnt vmcnt(" #n ")" ::: "memory")
#define PG8_WAIT_L(n) asm volatile("s_waitcnt lgkmcnt(" #n ")" ::: "memory")
#define PG8_BAR __builtin_amdgcn_s_barrier()
#define PG8_SCHED __builtin_amdgcn_sched_barrier(0)
    Unit cur, nxt; int ui = 0;
    if (!S.next(0, cur)) return;
    f32x4 acc[2][2][4][2];
#pragma unroll
    for (int a = 0; a < 2; ++a)
#pragma unroll
        for (int b = 0; b < 2; ++b)
#pragma unroll
            for (int m = 0; m < 4; ++m)
#pragma unroll
                for (int n = 0; n < 2; ++n) acc[a][b][m][n] = (f32x4){0.f, 0.f, 0.f, 0.f};
    bf16x8 At[4][2], B0[2][2], B1[2][2];
    const char* cA = (const char*)g.A + (size_t)cur.pm * tstep; const char* cB = (const char*)g.Bt + (size_t)cur.pn * tstep;
    S.a_ready(cur);
    if constexpr (SP2) {
        PG8_STAGE(PG8_SB(0, 0), cB, voffB); PG8_STAGE(PG8_SB(0, 1), cB + hstep, voffB); PG8_STAGE(PG8_SA(0, 0), cA, voffA); PG8_STAGE(PG8_SA(0, 1), cA + hstep, voffA);
        if (wr == 1) PG8_BAR;
        PG8_WAIT_V(2); PG8_BAR;
        PG8_STAGE(PG8_SB(1, 0), cB + kstep, voffB); PG8_STAGE(PG8_SA(1, 0), cA + kstep, voffA); PG8_STAGE(PG8_SB(1, 1), cB + hstep + kstep, voffB);
        PG8_WAIT_V(6); PG8_BAR;
    } else {
        PG8_STAGE(PG8_SB(0, 0), cB, voffB); PG8_STAGE(PG8_SA(0, 0), cA, voffA); PG8_STAGE(PG8_SB(0, 1), cB + hstep, voffB); PG8_STAGE(PG8_SA(0, 1), cA + hstep, voffA);
        if (wr == 1) PG8_BAR;
        PG8_WAIT_V(4); PG8_BAR;
        PG8_STAGE(PG8_SB(1, 0), cB + kstep, voffB); PG8_STAGE(PG8_SA(1, 0), cA + kstep, voffA); PG8_STAGE(PG8_SB(1, 1), cB + hstep + kstep, voffB);
        PG8_WAIT_V(6); PG8_BAR;
    }
    for (;;) {
        const bool has_next = S.next(ui + 1, nxt);
        const char* nA = has_next ? (const char*)g.A + (size_t)nxt.pm * tstep : cA; const char* nB = has_next ? (const char*)g.Bt + (size_t)nxt.pn * tstep : cB;
        f32x4 epre[8]; if constexpr (Epi::PRE) E.pre(cur, wr, wc, fr, fq, epre);
        for (int t = 0; t < nt; t += 2) {
            const bool last = (t == nt - 2);
            const char* a1 = cA + (size_t)(t + 1) * kstep;
            const char* a2 = last ? nA : cA + (size_t)(t + 2) * kstep; const char* b2 = last ? nB : cB + (size_t)(t + 2) * kstep;
            const char* a3 = a2 + kstep; const char* b3 = b2 + kstep;
            if (last && has_next) S.a_ready(nxt);
            if constexpr (SP2) {
            PG8_LDB(B0, 0, 0); PG8_LDB(B1, 0, 1); PG8_SCHED; PG8_LDA(At, 0, 0); PG8_STAGE(PG8_SA(1, 1), a1 + hstep, voffA);
            PG8_WAIT_V(8); PG8_WAIT_L(0); PG8_BAR; PG8_MMA(0, 0, At, B0); PG8_MMA(0, 1, At, B1); PG8_BAR; PG8_SCHED;
            PG8_LDA(At, 0, 1); PG8_STAGE(PG8_SB(0, 0), b2, voffB); PG8_STAGE(PG8_SB(0, 1), b2 + hstep, voffB); PG8_STAGE(PG8_SA(0, 0), a2, voffA);
            PG8_WAIT_V(8); PG8_WAIT_L(0); PG8_BAR; PG8_MMA(1, 0, At, B0); PG8_MMA(1, 1, At, B1); PG8_BAR; PG8_SCHED;
            PG8_LDB(B0, 1, 0); PG8_LDB(B1, 1, 1); PG8_SCHED; PG8_LDA(At, 1, 0); PG8_STAGE(PG8_SA(0, 1), a2 + hstep, voffA);
            PG8_WAIT_V(8); PG8_WAIT_L(0); PG8_BAR; PG8_MMA(0, 0, At, B0); PG8_MMA(0, 1, At, B1); PG8_BAR; PG8_SCHED;
            PG8_LDA(At, 1, 1); PG8_STAGE(PG8_SB(1, 0), b3, voffB); PG8_STAGE(PG8_SB(1, 1), b3 + hstep, voffB); PG8_STAGE(PG8_SA(1, 0), a3, voffA);
            PG8_WAIT_V(8); PG8_WAIT_L(0); PG8_BAR; PG8_MMA(1, 0, At, B0); PG8_MMA(1, 1, At, B1); PG8_BAR; PG8_SCHED;
            } else {
            PG8_LDB(B0, 0, 0); PG8_SCHED; PG8_LDA(At, 0, 0); PG8_STAGE(PG8_SA(1, 1), a1 + hstep, voffA);
            PG8_WAIT_L(8); PG8_BAR; PG8_WAIT_L(0); PG8_MMA(0, 0, At, B0); PG8_BAR; PG8_SCHED;
            PG8_LDB(B1, 0, 1); PG8_STAGE(PG8_SB(0, 0), b2, voffB);
            PG8_BAR; PG8_WAIT_L(0); PG8_MMA(0, 1, At, B1); PG8_BAR;
            PG8_LDA(At, 0, 1); PG8_STAGE(PG8_SA(0, 0), a2, voffA);
            PG8_BAR; PG8_WAIT_L(0); PG8_MMA(1, 0, At, B0); PG8_BAR; PG8_SCHED;
            PG8_STAGE(PG8_SB(0, 1), b2 + hstep, voffB);
            PG8_WAIT_V(6); PG8_BAR; PG8_MMA(1, 1, At, B1); PG8_BAR;
            PG8_LDB(B0, 1, 0); PG8_SCHED; PG8_LDA(At, 1, 0); PG8_STAGE(PG8_SA(0, 1), a2 + hstep, voffA);
            PG8_WAIT_L(8); PG8_BAR; PG8_WAIT_L(0); PG8_MMA(0, 0, At, B0); PG8_BAR; PG8_SCHED;
            PG8_LDB(B1, 1, 1); PG8_STAGE(PG8_SB(1, 0), b3, voffB);
            PG8_BAR; PG8_WAIT_L(0); PG8_MMA(0, 1, At, B1); PG8_BAR;
            PG8_LDA(At, 1, 1); PG8_STAGE(PG8_SA(1, 0), a3, voffA);
            PG8_BAR; PG8_WAIT_L(0); PG8_MMA(1, 0, At, B0); PG8_BAR; PG8_SCHED;
            PG8_STAGE(PG8_SB(1, 1), b3 + hstep, voffB);
            PG8_WAIT_V(6); PG8_BAR; PG8_MMA(1, 1, At, B1); PG8_BAR;
            }
        }
        if constexpr (ALIGN_EPI) { if (wr == 0) PG8_BAR; }
        if constexpr (!Epi::AFTER_DRAIN) { if constexpr (Epi::PRE) E(acc, cur, wr, wc, fr, fq, epre); else E(acc, cur, wr, wc, fr, fq); S.done(cur); }
        if (!has_next) break;
#pragma unroll
        for (int a = 0; a < 2; ++a)
#pragma unroll
            for (int b = 0; b < 2; ++b)
#pragma unroll
                for (int m = 0; m < 4; ++m)
#pragma unroll
                    for (int n = 0; n < 2; ++n) acc[a][b][m][n] = (f32x4){0.f, 0.f, 0.f, 0.f};
        cur = nxt; cA = nA; cB = nB; ++ui;
        if constexpr (ALIGN_EPI) { if (wr == 1) PG8_BAR; }
    }
    PG8_WAIT_V(0);
    if constexpr (!ALIGN_EPI) { if (wr == 0) PG8_BAR; }
    PG8_BAR;
    if constexpr (Epi::AFTER_DRAIN) { E.fused(acc, cur, wr, wc, fr, fq, lds, wid, lane); S.done(cur); }
#undef PG8_SA
#undef PG8_SB
#undef PG8_STAGE
#undef PG8_LDA
#undef PG8_LDB
#undef PG8_MMA
#undef PG8_WAIT_V
#undef PG8_WAIT_L
#undef PG8_BAR
#undef PG8_SCHED
}
}
#define GAS __attribute__((address_space(1)))
#define LAS __attribute__((address_space(3)))
typedef unsigned short bf16;
typedef unsigned v4u __attribute__((ext_vector_type(4)));
typedef unsigned v2u __attribute__((ext_vector_type(2)));
typedef float f32x4 __attribute__((ext_vector_type(4)));
typedef float f32x16 __attribute__((ext_vector_type(16)));
typedef float f32x2 __attribute__((ext_vector_type(2)));
typedef short bf16x8 __attribute__((ext_vector_type(8)));
typedef short s16x4 __attribute__((ext_vector_type(4)));
typedef __bf16 bf16x2v __attribute__((ext_vector_type(2)));
typedef GAS unsigned gu32;
typedef GAS unsigned long long gu64;
#define RLX_AGENT __ATOMIC_RELAXED, __HIP_MEMORY_SCOPE_AGENT
#define LDS_WAIT() asm volatile("s_waitcnt lgkmcnt(0)" ::: "memory")
#define VM_WAIT() asm volatile("s_waitcnt vmcnt(0)" ::: "memory")
__device__ __forceinline__ unsigned f2bf(float f) { unsigned u = __builtin_bit_cast(unsigned, f); return (u + 0x7fffu + ((u >> 16) & 1u)) >> 16; }
__device__ __forceinline__ unsigned pk2(float lo, float hi) { return f2bf(lo) | (f2bf(hi) << 16); }
__device__ __forceinline__ float bf2f(unsigned short b) { return __builtin_bit_cast(float, (unsigned)b << 16); }
__device__ __forceinline__ float bflo(unsigned w) { return __builtin_bit_cast(float, w << 16); }
__device__ __forceinline__ float bfhi(unsigned w) { return __builtin_bit_cast(float, w & 0xffff0000u); }
__device__ __forceinline__ float wave_sum(float v) {
#pragma unroll
    for (int o = 1; o < 64; o <<= 1) v += __shfl_xor(v, o);
    return v;
}
__device__ __forceinline__ float wave_max(float v) {
#pragma unroll
    for (int o = 1; o < 64; o <<= 1) v = fmaxf(v, __shfl_xor(v, o));
    return v;
}
__device__ __forceinline__ float gelu_tanh(float x) {
    const float u = 0.7978845608028654f * (x + 0.044715f * x * x * x);
    const float e = __expf(2.f * u);
    const float th = 1.f - 2.f / (e + 1.f);
    return 0.5f * x * (1.f + th);
}

#define XB_TMO      128
#define XB_XCNT(j)  (256  + 64 * (j))
#define XB_XSUB(j)  (1280 + 64 * (j))
#define XB_XGEN(j)  (2304 + 64 * (j))
#define XB_TOP      3328
#define XB_TOPGEN   3392
#define XCD_BAR_WORDS 3456
#define XB_SPIN_CAP (1u << 18)

__device__ __forceinline__ unsigned xb_ld(unsigned* p)              { return __hip_atomic_load(p, __ATOMIC_RELAXED, __HIP_MEMORY_SCOPE_AGENT); }
__device__ __forceinline__ unsigned xb_add(unsigned* p, unsigned v) { return __hip_atomic_fetch_add(p, v, __ATOMIC_RELAXED, __HIP_MEMORY_SCOPE_AGENT); }
__device__ __forceinline__ unsigned xb_xcc_id() { return (unsigned)__builtin_amdgcn_s_getreg((3 << 11) | 20) & 0xFu; }
#define XB_SPIN(cond, bar) do { unsigned _sp = 0; while (cond) { __builtin_amdgcn_s_sleep(1); \
    if ((++_sp & 255u) == 0u) { if (xb_ld(&(bar)[XB_TMO])) break; if (_sp > XB_SPIN_CAP) { atomicAdd(&(bar)[XB_TMO], 1u); break; } } } } while (0)

struct XcdBarrier {
    unsigned* bar; unsigned x;
    volatile LAS unsigned* st;
};

__device__ __forceinline__ XcdBarrier xcd_barrier_post(unsigned* bar, volatile LAS unsigned* st) {
    XcdBarrier b; b.bar = bar; b.x = xb_xcc_id(); b.st = st;
    if (threadIdx.x == 0) (void)xb_add(&bar[XB_XCNT(b.x)], 1u);
    return b;
}
__device__ __forceinline__ void xcd_barrier_complete(unsigned* bar, unsigned x, unsigned& nloc, unsigned& nx) {
    const unsigned G = gridDim.x * gridDim.y * gridDim.z;
    unsigned sum, cnt, mine, sp = 0u;
    for (;;) {
        sum = 0u; cnt = 0u; mine = 0u;
#pragma unroll
        for (unsigned j = 0; j < 16; ++j) { const unsigned c = xb_ld(&bar[XB_XCNT(j)]); sum += c; cnt += (c > 0u) ? 1u : 0u; mine = (j == x) ? c : mine; }
        if (sum == G) break;
        __builtin_amdgcn_s_sleep(1);
        if ((++sp & 255u) == 0u) { if (xb_ld(&bar[XB_TMO])) break; if (sp > XB_SPIN_CAP) { atomicAdd(&bar[XB_TMO], 1u); break; } }
    }
    nloc = mine > 0u ? mine : 1u; nx = cnt > 0u ? cnt : 1u;
}

__device__ __forceinline__ void xcd_barrier(const XcdBarrier& b) {
    asm volatile("s_waitcnt vmcnt(0)" ::: "memory");
    __syncthreads();
    if (threadIdx.x == 0) {
        unsigned* bar = b.bar;
        __builtin_amdgcn_s_waitcnt(0);
        unsigned nloc = b.st[0], nx = b.st[1];
        if (nloc == 0u) { xcd_barrier_complete(bar, b.x, nloc, nx); b.st[0] = nloc; b.st[1] = nx; }
        const unsigned old = xb_add(&bar[XB_XSUB(b.x)], 1u);
        const unsigned gen = old / nloc;
        if (old + 1u == (gen + 1u) * nloc) {
            __builtin_amdgcn_fence(__ATOMIC_RELEASE, "agent");
            asm volatile("s_waitcnt vmcnt(0)" ::: "memory");
            const unsigned og = xb_add(&bar[XB_TOP], 1u);
            const unsigned tg = og / nx;
            if (og + 1u == (tg + 1u) * nx) xb_add(&bar[XB_TOPGEN], 1u);
            else XB_SPIN(xb_ld(&bar[XB_TOPGEN]) == tg, bar);
            __builtin_amdgcn_fence(__ATOMIC_ACQUIRE, "agent");
            xb_add(&bar[XB_XGEN(b.x)], 1u);
            asm volatile("s_waitcnt vmcnt(0)" ::: "memory");
        } else {
            XB_SPIN(xb_ld(&bar[XB_XGEN(b.x)]) == gen, bar);
            __builtin_amdgcn_fence(__ATOMIC_ACQUIRE, "agent");
            asm volatile("s_waitcnt vmcnt(0)" ::: "memory");
        }
    }
    __syncthreads();
}
constexpr int NWAVES = 8;
constexpr int BATCH = 8, SEQ = 4096, TT = BATCH * SEQ, DM = 1024;
constexpr int NPROJ = 3072, IN_COLS = 2840;
constexpr int C_H = 0, C_B = 512, C_C = 1024, C_Q = 1536, C_KC = 2048, C_VC = 2176, C_KS = 2304, C_VS = 2432, C_KW = 2560, C_VW = 2688, C_G = 2816;
constexpr int NQP = 2048;
constexpr float RMS_EPS = 1e-6f;
constexpr float QSCALE = 0.125f * 1.4426950408889634f;
constexpr size_t MiB = 1u << 20;
constexpr size_t WS_CTL = 0, CTL_ZERO_BYTES = 32768;
constexpr size_t WS_WIN = 2 * MiB, WS_WOUT = 8 * MiB, WS_WQ = 10 * MiB, WS_KW1 = 14 * MiB, WS_VW1 = 15 * MiB, WS_KW2 = 16 * MiB, WS_VW2 = 16 * MiB + 65536, WS_B1 = 16 * MiB + 131072, WS_SUBK = 17 * MiB;
constexpr size_t WS_U = 32 * MiB, WS_V = 48 * MiB;
constexpr float QSTEP = 0.3352f;
constexpr float USCALE = 32.f / QSTEP, VSCALE = 4.f;
constexpr int NSL = 4;
constexpr size_t WS_XN = 96 * MiB;
constexpr size_t WS_PROJ = 160 * MiB;
constexpr size_t WS_MIXA = 352 * MiB;
constexpr size_t WS_KCC = 416 * MiB, WS_VCC = 417 * MiB;
constexpr size_t WS_SSQ = 418 * MiB;
constexpr size_t WS_EXPG = 64 * MiB, WS_AG = 80 * MiB, WS_DGP = 288 * MiB, WS_SSQF = 420 * MiB;
constexpr size_t WS_END = 421 * MiB;
constexpr int CW_BAR = 4096;
constexpr int RING_OFF = 0, RING_BYTES = 131072;
constexpr int LDSCTL_OFF = RING_BYTES, MISC_OFF = LDSCTL_OFF + 320;
constexpr int LDS_BYTES = 155648;

struct Args { const float* in[19]; float* out; unsigned char* ws; int ph_lo, ph_hi; };
struct Frame {
    LAS unsigned char* lds;
    volatile LAS unsigned* MISC;
    gu32* ctl;
    int tid, lane, wave;
    int vcu, G;
    const Args* a;
};
#define FIN(k) (F.a->in[k])
#define FWS(T, off) ((T*)(F.a->ws + (off)))
#define F_x FIN(0)
#define F_ln1 FIN(1)
#define F_w_in FIN(2)
#define F_conv_w FIN(3)
#define F_pos_k FIN(4)
#define F_pos_v FIN(5)
#define F_k_w1 FIN(6)
#define F_k_w2 FIN(7)
#define F_v_w1 FIN(8)
#define F_v_w2 FIN(9)
#define F_gn_conv FIN(10)
#define F_gn_attn FIN(11)
#define F_w_out FIN(12)
#define F_ln2 FIN(13)
#define F_wq FIN(14)
#define F_subkeys FIN(15)
#define F_pu FIN(16)
#define F_pv FIN(17)
#define F_lnf FIN(18)
#define F_out (F.a->out)
#define F_WinT FWS(bf16, WS_WIN)
#define F_WoutT FWS(bf16, WS_WOUT)
#define F_WqT FWS(bf16, WS_WQ)
#define F_KW1T FWS(bf16, WS_KW1)
#define F_VW1T FWS(bf16, WS_VW1)
#define F_KW2T FWS(bf16, WS_KW2)
#define F_VW2T FWS(bf16, WS_VW2)
#define F_SUBK FWS(bf16, WS_SUBK)
#define F_U FWS(unsigned char, WS_U)
#define F_V FWS(unsigned char, WS_V)
#define F_XN FWS(bf16, WS_XN)
#define F_PROJ FWS(bf16, WS_PROJ)
#define F_MIXA FWS(bf16, WS_MIXA)
#define F_KCC FWS(bf16, WS_KCC)
#define F_VCC FWS(bf16, WS_VCC)
#define F_B1 FWS(float, WS_B1)
#define F_SSQ FWS(float, WS_SSQ)

__device__ __forceinline__ void p0_transpose_item(const float* W, int K, int N, bf16* WT, const float* kscale, LAS float* scr, int item, int nblk, int lane, bool frag = false) {
    const int kb = item / nblk, nb = item % nblk, k0 = 64 * kb, n0 = 32 * nb;
#pragma unroll
    for (int i = 0; i < 32; ++i) { const int kk = 2 * i + (lane >> 5); const int n = n0 + (lane & 31); float v = (n < N) ? __builtin_nontemporal_load(W + (size_t)(k0 + kk) * N + n) : 0.f; if (kscale) v *= kscale[k0 + kk]; scr[kk * 33 + (lane & 31)] = v; }
    LDS_WAIT(); asm volatile("" ::: "memory");
    const int c = lane & 7;
#pragma unroll
    for (int j = 0; j < 4; ++j) { const int n = (lane >> 3) + 8 * j; const LAS float* s = scr + (8 * c) * 33 + n;
        v4u o; o.x = pk2(s[0 * 33], s[1 * 33]); o.y = pk2(s[2 * 33], s[3 * 33]); o.z = pk2(s[4 * 33], s[5 * 33]); o.w = pk2(s[6 * 33], s[7 * 33]);
        const int na = n0 + n, ka = k0 + 8 * c;
        const size_t off = frag ? ((size_t)((na >> 4) * 64 + (ka >> 5)) * 64 + (((ka >> 3) & 3) * 16 + (na & 15))) * 8 : (size_t)na * K + ka;
        *(GAS v4u*)(WT + off) = o; }
    LDS_WAIT(); asm volatile("" ::: "memory");
}
__device__ __forceinline__ void p0_cvt_item(const float* src, bf16* dst, const float* cscale, size_t item, int lane) {
    const size_t idx = item * 512 + (size_t)lane * 8;
    f32x4 a = *(const GAS f32x4*)(src + idx), b = *(const GAS f32x4*)(src + idx + 4);
    if (cscale) { const int d = (int)(idx & 1023); const f32x4 sa = *(const GAS f32x4*)(cscale + d), sb = *(const GAS f32x4*)(cscale + d + 4); a = a * sa; b = b * sb; }
    v4u o; o.x = pk2(a[0], a[1]); o.y = pk2(a[2], a[3]); o.z = pk2(b[0], b[1]); o.w = pk2(b[2], b[3]);
    *(GAS v4u*)(dst + idx) = o;
}
__device__ __forceinline__ void p0_cvt4_load(const float* src, size_t item0, int lane, f32x4 (&a)[4], f32x4 (&b)[4]) {
#pragma unroll
    for (int u = 0; u < 4; ++u) { const size_t idx = (item0 + u) * 512 + (size_t)lane * 4; a[u] = __builtin_nontemporal_load((const GAS f32x4*)(src + idx)); b[u] = __builtin_nontemporal_load((const GAS f32x4*)(src + idx + 256)); }
}
__device__ __forceinline__ unsigned p0_code4(const f32x4 x, bool as_int4) {
    unsigned h = 0u;
    if (as_int4) {
#pragma unroll
        for (int e4 = 0; e4 < 4; ++e4) { const int qa = (int)__builtin_rintf(__builtin_fminf(__builtin_fmaxf(x[e4], -8.f), 7.f)); h |= ((unsigned)qa & 15u) << (4 * e4); }
    } else { h = __builtin_amdgcn_cvt_scalef32_pk_fp4_f32(h, x[0], x[1], 1.0f, 0); h = __builtin_amdgcn_cvt_scalef32_pk_fp4_f32(h, x[2], x[3], 1.0f, 1); }
    return h & 0xffffu;
}
__device__ __forceinline__ void p0_cvt4_conv(const f32x4 (&a)[4], const f32x4 (&b)[4], unsigned char* dst, const float* cscale, float scale, bool as_int4, size_t item0, int lane) {
#pragma unroll
    for (int u = 0; u < 4; ++u) {
        const size_t idx = (item0 + u) * 512 + (size_t)lane * 4; const int col = (int)(idx & 1023);
        f32x4 x = a[u] * scale, y = b[u] * scale;
        if (cscale) { const f32x4 sa = *(const GAS f32x4*)(cscale + col), sb = *(const GAS f32x4*)(cscale + col + 256); x = x * sa; y = y * sb; }
        const unsigned hA = p0_code4(x, as_int4), hB = p0_code4(y, as_int4);
        const bool odd = (lane & 1) != 0;
        const unsigned got = (unsigned)__builtin_amdgcn_update_dpp(0, (int)(odd ? hA : hB), 0xB1, 0xF, 0xF, true);
        const unsigned w = odd ? (got | (hB << 16)) : (hA | (got << 16));
        const int c8 = odd ? col + 256 - 4 : col;
        const size_t e = idx >> 10; const int q = c8 >> 6, dc = (c8 >> 3) & 7;
        *(GAS unsigned*)(dst + e * 512 + 128 * (q >> 2) + 16 * dc + 4 * (q & 3)) = w;
    }
}
__device__ __forceinline__ void rms_row_load(const float* xrow, int lane, f32x4 (&v)[4]) {
    const GAS f32x4* xr = (const GAS f32x4*)xrow + lane;
#pragma unroll
    for (int j = 0; j < 4; ++j) v[j] = __builtin_nontemporal_load(xr + 64 * j);
}
__device__ __forceinline__ void rms_row_finish(const f32x4 (&v)[4], const f32x4 (&g)[4], bf16* orow, int lane) {
    float s = 0.f;
#pragma unroll
    for (int j = 0; j < 4; ++j) s += (v[j].x * v[j].x + v[j].y * v[j].y) + (v[j].z * v[j].z + v[j].w * v[j].w);
    const float rstd = 1.f / sqrtf(wave_sum(s) * (1.f / DM) + RMS_EPS);
    GAS v2u* o8 = (GAS v2u*)orow + lane;
#pragma unroll
    for (int j = 0; j < 4; ++j) { v2u w; w.x = pk2(v[j].x * rstd * g[j].x, v[j].y * rstd * g[j].y); w.y = pk2(v[j].z * rstd * g[j].z, v[j].w * rstd * g[j].w); o8[64 * j] = w; }
}
__device__ __forceinline__ void p0_prologue(Frame& F) {
    LAS float* scr = (LAS float*)(F.lds + RING_OFF + F.wave * 16384);
    const int gw = F.vcu * NWAVES + F.wave, NGW = F.G * NWAVES, lane = F.lane;
    constexpr int I_IN = 16 * 96, I_OUT = 16 * 32, I_Q = 16 * 64, I_W1 = 32 * 8, I_W2 = 4 * 2;
    constexpr int NTR = I_IN + I_OUT + I_Q + 2 * I_W1 + 2 * I_W2;
    for (int it = gw; it < NTR; it += NGW) {
        int r = it;
        if (r < I_IN) { p0_transpose_item(F_w_in, 1024, IN_COLS, F_WinT, nullptr, scr, r, 96, lane); continue; } r -= I_IN;
        if (r < I_OUT) { p0_transpose_item(F_w_out, 1024, 1024, F_WoutT, nullptr, scr, r, 32, lane); continue; } r -= I_OUT;
        if (r < I_Q) { p0_transpose_item(F_wq, 1024, NQP, F_WqT, F_ln2, scr, r, 64, lane); continue; } r -= I_Q;
        if (r < I_W1) { p0_transpose_item(F_k_w1, 2048, 256, F_KW1T, nullptr, scr, r, 8, lane, true); continue; } r -= I_W1;
        if (r < I_W1) { p0_transpose_item(F_v_w1, 2048, 256, F_VW1T, nullptr, scr, r, 8, lane, true); continue; } r -= I_W1;
        if (r < I_W2) { p0_transpose_item(F_k_w2, 256, 64, F_KW2T, nullptr, scr, r, 2, lane); continue; } r -= I_W2;
        p0_transpose_item(F_v_w2, 256, 64, F_VW2T, nullptr, scr, r, 2, lane);
    }
    for (int it = (gw + 512) % NGW; it < 512; it += NGW) { const int mat = it >> 8, j = it & 255; const float* pos = mat ? F_pos_v : F_pos_k; const float* w1 = mat ? F_v_w1 : F_k_w1;
        float a = 0.f; for (int i = lane; i < 2048; i += 64) a += pos[i] * w1[(size_t)i * 256 + j];
        a = wave_sum(a); if (lane == 0) F_B1[it] = a; }
    for (int it = gw; it < 512; it += NGW) { const int s8 = it & 7, kt = (it >> 3) & 3, hc = it >> 5, hi = lane >> 5, r32 = lane & 31; const int key = 16 * kt + (r32 & 3) + 4 * (r32 >> 3) + 64 * ((r32 >> 2) & 1);
        const float* src = F_subkeys + ((size_t)(hc * 128 + key) * 128 + 16 * s8 + 8 * hi); const f32x4 a = *(const GAS f32x4*)src, b = *(const GAS f32x4*)(src + 4);
        v4u o; o.x = pk2(a[0], a[1]); o.y = pk2(a[2], a[3]); o.z = pk2(b[0], b[1]); o.w = pk2(b[2], b[3]); *(GAS v4u*)(F_SUBK + (size_t)it * 512 + lane * 8) = o; }
    {
        f32x4 ua0[4], ub0[4], va0[4], vb0[4], ua1[4], ub1[4], va1[4], vb1[4];
        int it = gw;
        if (it < 8192) { p0_cvt4_load(F_pu, (size_t)it * 4, lane, ua0, ub0); p0_cvt4_load(F_pv, (size_t)it * 4, lane, va0, vb0); }
        for (; it < 8192; it += 2 * NGW) {
            const int i1 = it + NGW, i2 = it + 2 * NGW;
            if (i1 < 8192) { p0_cvt4_load(F_pu, (size_t)i1 * 4, lane, ua1, ub1); p0_cvt4_load(F_pv, (size_t)i1 * 4, lane, va1, vb1); }
            p0_cvt4_conv(ua0, ub0, F_U, F_ln2, USCALE, true, (size_t)it * 4, lane); p0_cvt4_conv(va0, vb0, F_V, nullptr, VSCALE, false, (size_t)it * 4, lane);
            if (i1 < 8192) {
                if (i2 < 8192) { p0_cvt4_load(F_pu, (size_t)i2 * 4, lane, ua0, ub0); p0_cvt4_load(F_pv, (size_t)i2 * 4, lane, va0, vb0); }
                p0_cvt4_conv(ua1, ub1, F_U, F_ln2, USCALE, true, (size_t)i1 * 4, lane); p0_cvt4_conv(va1, vb1, F_V, nullptr, VSCALE, false, (size_t)i1 * 4, lane);
            }
        }
    }
    {
        f32x4 g[4];
#pragma unroll
        for (int j = 0; j < 4; ++j) g[j] = ((const GAS f32x4*)F_ln1)[lane + 64 * j];
        f32x4 xa0[4], xb0[4], xa1[4], xb1[4];
        int m = gw;
        if (m < TT) rms_row_load(F_x + (size_t)m * DM, lane, xa0); if (m + NGW < TT) rms_row_load(F_x + (size_t)(m + NGW) * DM, lane, xb0);
        for (; m < TT; m += 4 * NGW) {
            const int m1 = m + NGW, m2 = m + 2 * NGW, m3 = m + 3 * NGW, m4 = m + 4 * NGW, m5 = m + 5 * NGW;
            if (m2 < TT) rms_row_load(F_x + (size_t)m2 * DM, lane, xa1); if (m3 < TT) rms_row_load(F_x + (size_t)m3 * DM, lane, xb1);
            rms_row_finish(xa0, g, F_XN + (size_t)m * DM, lane); if (m1 < TT) rms_row_finish(xb0, g, F_XN + (size_t)m1 * DM, lane);
            if (m4 < TT) rms_row_load(F_x + (size_t)m4 * DM, lane, xa0); if (m5 < TT) rms_row_load(F_x + (size_t)m5 * DM, lane, xb0);
            if (m2 < TT) rms_row_finish(xa1, g, F_XN + (size_t)m2 * DM, lane); if (m3 < TT) rms_row_finish(xb1, g, F_XN + (size_t)m3 * DM, lane);
        }
    }
}

__device__ __forceinline__ void up8(const v4u w, float (&f)[8]) { f[0] = bflo(w.x); f[1] = bfhi(w.x); f[2] = bflo(w.y); f[3] = bfhi(w.y); f[4] = bflo(w.z); f[5] = bfhi(w.z); f[6] = bflo(w.w); f[7] = bfhi(w.w); }
struct P2Rows { v4u cc[4], ch[4], cb[4]; };
__device__ __forceinline__ void p2_conv_load(Frame& F, P2Rows& R, int bt0, int lane) {
#pragma unroll
    for (int j = 0; j < 4; ++j) { const bf16* pr = F_PROJ + (size_t)(bt0 + j) * NPROJ + 8 * lane; R.cc[j] = __builtin_nontemporal_load((const GAS v4u*)(pr + C_C)); R.ch[j] = __builtin_nontemporal_load((const GAS v4u*)(pr + C_H)); R.cb[j] = __builtin_nontemporal_load((const GAS v4u*)(pr + C_B)); }
}
__device__ __forceinline__ void p2_conv_four(Frame& F, const P2Rows& R, int bt0, int lane, float (&g1)[8], float (&g2)[8], const float (&w)[3][8], const float (&gn)[8]) {
#pragma unroll
    for (int j = 0; j < 4; ++j) {
        float cc[8], ch[8], cb[8], y[8]; up8(R.cc[j], cc); up8(R.ch[j], ch); up8(R.cb[j], cb);
        float ss = 0.f;
#pragma unroll
        for (int e = 0; e < 8; ++e) { const float g0 = cc[e] * ch[e]; y[e] = (w[0][e] * g2[e] + w[1][e] * g1[e] + w[2][e] * g0) * cb[e]; ss += y[e] * y[e]; g2[e] = g1[e]; g1[e] = g0; }
        const float rs = 1.f / sqrtf(wave_sum(ss) * (1.f / 512.f) + RMS_EPS);
        v4u o; o.x = pk2(y[0] * rs * gn[0], y[1] * rs * gn[1]); o.y = pk2(y[2] * rs * gn[2], y[3] * rs * gn[3]); o.z = pk2(y[4] * rs * gn[4], y[5] * rs * gn[5]); o.w = pk2(y[6] * rs * gn[6], y[7] * rs * gn[7]);
        *(GAS v4u*)(F_MIXA + (size_t)(bt0 + j) * 1024 + 8 * lane) = o;
    }
}
__device__ __forceinline__ void p2_conv_run(Frame& F, int run) {
    const int lane = F.lane; const int bt0 = 16 * run; const int t0 = bt0 & (SEQ - 1);
    P2Rows A, B;
    p2_conv_load(F, A, bt0, lane);
    float w[3][8], gn[8], g1[8], g2[8];
#pragma unroll
    for (int k = 0; k < 3; ++k) { const f32x4 w0 = *(const GAS f32x4*)(F_conv_w + k * 512 + 8 * lane), w1 = *(const GAS f32x4*)(F_conv_w + k * 512 + 8 * lane + 4);
#pragma unroll
        for (int e = 0; e < 4; ++e) { w[k][e] = w0[e]; w[k][4 + e] = w1[e]; } }
    { const f32x4 a0 = *(const GAS f32x4*)(F_gn_conv + 8 * lane), a1 = *(const GAS f32x4*)(F_gn_conv + 8 * lane + 4);
#pragma unroll
      for (int e = 0; e < 4; ++e) { gn[e] = a0[e]; gn[4 + e] = a1[e]; } }
#pragma unroll
    for (int e = 0; e < 8; ++e) { g1[e] = 0.f; g2[e] = 0.f; }
    if (t0 > 0) {
        const bf16* pr = F_PROJ + (size_t)(bt0 - 2) * NPROJ + 8 * lane; float c2[8], h2[8], c1[8], h1[8];
        up8(*(const GAS v4u*)(pr + C_C), c2); up8(*(const GAS v4u*)(pr + C_H), h2); up8(*(const GAS v4u*)(pr + NPROJ + C_C), c1); up8(*(const GAS v4u*)(pr + NPROJ + C_H), h1);
#pragma unroll
        for (int e = 0; e < 8; ++e) { g2[e] = c2[e] * h2[e]; g1[e] = c1[e] * h1[e]; }
    }
    p2_conv_load(F, B, bt0 + 4, lane);  p2_conv_four(F, A, bt0, lane, g1, g2, w, gn);
    p2_conv_load(F, A, bt0 + 8, lane);  p2_conv_four(F, B, bt0 + 4, lane, g1, g2, w, gn);
    p2_conv_load(F, B, bt0 + 12, lane); p2_conv_four(F, A, bt0 + 8, lane, g1, g2, w, gn);
    p2_conv_four(F, B, bt0 + 12, lane, g1, g2, w, gn);
}
__device__ __forceinline__ void p2_compress_unit(Frame& F, int u) {
    const int b = u >> 5, g = (u >> 4) & 1, nb = u & 15; const int tid = F.tid, lane = F.lane, w = F.wave;
    LAS unsigned char* AST = F.lds + RING_OFF;
    LAS unsigned char* HID = F.lds + RING_OFF + 36864;
    const int nrow = lane & 15, kq = lane >> 4;
    for (int mat = 0; mat < 2; ++mat) {
        const int col0 = (mat ? C_VC : C_KC) + g * 64; const bf16* W1T = mat ? F_VW1T : F_KW1T; const bf16* W2T = mat ? F_VW2T : F_KW2T; const float* B1 = F_B1 + mat * 256; bf16* OUT = mat ? F_VCC : F_KCC;
        for (int idx = tid; idx < 272 * 8; idx += NWAVES * 64) { const int pos = idx >> 3, ch = idx & 7; const int p = 256 * nb + pos;
            v4u v = (v4u){0u, 0u, 0u, 0u}; if (p < SEQ) v = __builtin_nontemporal_load((const GAS v4u*)(F_PROJ + (size_t)(b * SEQ + p) * NPROJ + col0 + 8 * ch));
            *(LAS v4u*)(AST + pos * 128 + (pos >> 4) * 16 + ch * 16) = v; }
        __syncthreads();
        f32x4 acc0 = (f32x4){0.f, 0.f, 0.f, 0.f}, acc1 = acc0;
        const bf16* b0p = W1T + (size_t)(2 * w) * 64 * 512 + lane * 8; const bf16* b1p = b0p + (size_t)64 * 512;
#define P2_LOADB(S0, S1, bb) do { _Pragma("unroll") for (int k8 = 0; k8 < 8; ++k8) { S0[k8] = *(const GAS bf16x8*)(b0p + 512 * (8 * (bb) + k8)); S1[k8] = *(const GAS bf16x8*)(b1p + 512 * (8 * (bb) + k8)); } } while (0)
#define P2_MMA(S0, S1, bb) do { _Pragma("unroll") for (int k8 = 0; k8 < 8; ++k8) { const int k0 = 32 * (8 * (bb) + k8) + 8 * kq; const int l = k0 >> 6, d = k0 & 63; \
            const bf16x8 a = *(const LAS bf16x8*)(AST + (16 * nrow + l) * 128 + (nrow + (l >> 4)) * 16 + d * 2); \
            acc0 = __builtin_amdgcn_mfma_f32_16x16x32_bf16(a, S0[k8], acc0, 0, 0, 0); acc1 = __builtin_amdgcn_mfma_f32_16x16x32_bf16(a, S1[k8], acc1, 0, 0, 0); } } while (0)
        { bf16x8 pa0[8], pa1[8], pb0[8], pb1[8];
          P2_LOADB(pa0, pa1, 0);
#pragma unroll 1
          for (int bb = 0; bb < 8; bb += 2) {
              P2_LOADB(pb0, pb1, bb + 1);
              P2_MMA(pa0, pa1, bb);
              if (bb + 2 < 8) P2_LOADB(pa0, pa1, bb + 2);
              P2_MMA(pb0, pb1, bb + 1);
          } }
#undef P2_LOADB
#undef P2_MMA
        { const int j0 = 32 * w + nrow, j1 = j0 + 16; const float bj0 = B1[j0], bj1 = B1[j1];
#pragma unroll
            for (int r = 0; r < 4; ++r) { const int n = 4 * kq + r;
                *(LAS unsigned short*)(HID + n * 528 + j0 * 2) = (unsigned short)f2bf(gelu_tanh(acc0[r] + bj0));
                *(LAS unsigned short*)(HID + n * 528 + j1 * 2) = (unsigned short)f2bf(gelu_tanh(acc1[r] + bj1)); } }
        __syncthreads();
        if (w < 4) { f32x4 acc = (f32x4){0.f, 0.f, 0.f, 0.f}; const bf16* bp = W2T + (size_t)(16 * w + nrow) * 256 + 8 * kq;
#pragma unroll
            for (int kk = 0; kk < 8; ++kk) { const bf16x8 a = *(const LAS bf16x8*)(HID + nrow * 528 + (32 * kk + 8 * kq) * 2); const bf16x8 bb = *(const GAS bf16x8*)(bp + 32 * kk);
                acc = __builtin_amdgcn_mfma_f32_16x16x32_bf16(a, bb, acc, 0, 0, 0); }
            const int d = 16 * w + nrow;
#pragma unroll
            for (int r = 0; r < 4; ++r) { const int n = 16 * nb + 4 * kq + r; OUT[((size_t)(b * 256 + n) * 2 + g) * 64 + d] = (bf16)f2bf(acc[r]); } }
        __syncthreads();
    }
}
__device__ __forceinline__ void p2_phase(Frame& F) {
    const int gw = F.vcu * NWAVES + F.wave, NGW = F.G * NWAVES;
    for (int u = F.vcu; u < 256; u += F.G) p2_compress_unit(F, u);
    for (int run = gw; run < TT / 16; run += NGW) p2_conv_run(F, run);
}

namespace att {
constexpr int IMP_ROW = 66  , IMP_PLANE = 64 * IMP_ROW * 2;
constexpr int KBUF = 0, VBUF = 16384, IMP_OFF = 32768  , OST_OFF = IMP_OFF + 3 * IMP_PLANE, OST_ROW = 1040, SELM_OFF = OST_OFF + 64 * OST_ROW, ANYW_OFF = SELM_OFF + 512, SSQ_OFF = ANYW_OFF + 64, LINV_OFF = SSQ_OFF + 256  , SSQH_OFF = LINV_OFF + 1024  ;
constexpr int GATE_OFF = RING_BYTES + 1024  , IMP3_OFF = GATE_OFF + 8192  ;
static_assert(OST_OFF % 16 == 0 && SSQH_OFF + 2048 <= RING_BYTES && IMP3_OFF + IMP_PLANE <= LDS_BYTES, "attention LDS map");
__device__ __forceinline__ LAS _Float16* imp_plane(LAS unsigned char* L, int h) { return (LAS _Float16*)(L + (h < 3 ? IMP_OFF + h * IMP_PLANE : IMP3_OFF)); }
__device__ __forceinline__ int crow(int r, int hi) { return (r & 3) + 8 * (r >> 2) + 4 * hi; }
__device__ __forceinline__ float max3f(float a, float b, float c) { float r; asm("v_max3_f32 %0, %1, %2, %3" : "=v"(r) : "v"(a), "v"(b), "v"(c)); return r; }
__device__ __forceinline__ float max2f(float a, float b) { float r; asm("v_max_f32_e32 %0, %1, %2" : "=v"(r) : "v"(a), "v"(b)); return r; }
__device__ __forceinline__ float swapmax(float v) { auto rr = __builtin_amdgcn_permlane32_swap(__float_as_uint(v), __float_as_uint(v), false, false); return max2f(__uint_as_float(rr[0]), __uint_as_float(rr[1])); }
__device__ __forceinline__ float swapsum(float v) { auto rr = __builtin_amdgcn_permlane32_swap(__float_as_uint(v), __float_as_uint(v), false, false); return __uint_as_float(rr[0]) + __uint_as_float(rr[1]); }
__device__ __forceinline__ unsigned cvtpk(float lo, float hi) { typedef float f2 __attribute__((ext_vector_type(2))); f2 v = {lo, hi}; bf16x2v b = __builtin_convertvector(v, bf16x2v); return __builtin_bit_cast(unsigned, b); }
__device__ __forceinline__ s16x4 vtr(const LAS unsigned char* p) { typedef short v4i16_t __attribute__((ext_vector_type(4))); return __builtin_bit_cast(s16x4, __builtin_amdgcn_ds_read_tr16_b64_v4i16((LAS v4i16_t*)p)); }

struct Stg { v4u k, v; };
__device__ __forceinline__ void tile_load(Stg& s, const bf16* kbase, const bf16* vbase, int rs, int tid) {
    const unsigned ov = (unsigned)((tid >> 3) * rs + (tid & 7) * 8) * 2u, ok = ov;
    s.k = *(const GAS v4u*)((const GAS unsigned char*)kbase + ok);
    s.v = *(const GAS v4u*)((const GAS unsigned char*)vbase + ov);
}
__device__ __forceinline__ void tile_store(const Stg& s, LAS unsigned char* kbuf, LAS unsigned char* vbuf, int tid) {
    const int key = tid >> 3, c = tid & 7;
    *(LAS v4u*)(kbuf + c * 1024 + ((((key + c) & 7) | (key & ~7)) * 16)) = s.k;
    *(LAS v4u*)(vbuf + (c >> 2) * 4096 + (key >> 3) * 512 + (key & 7) * 64 + (c & 3) * 16) = s.v;
}
__device__ __forceinline__ void qkt(f32x16& p0, f32x16& p1, const LAS unsigned char* kbuf, const bf16x8 (&qr)[4], float cinit, int hi, int r32) {
#pragma unroll
    for (int r = 0; r < 16; ++r) { p0[r] = cinit; p1[r] = cinit; }
    bf16x8 kf[8];
#pragma unroll
    for (int s = 0; s < 4; ++s) { const int ch = 2 * s + hi; const LAS unsigned char* kb = kbuf + ch * 1024 + ((((r32 + ch) & 7) | (r32 & ~7)) * 16);
        kf[2 * s] = *(const LAS bf16x8*)(kb); kf[2 * s + 1] = *(const LAS bf16x8*)(kb + 512); }
#pragma unroll
    for (int s = 0; s < 4; ++s) {
        p0 = __builtin_amdgcn_mfma_f32_32x32x16_bf16(kf[2 * s], qr[s], p0, 0, 0, 0);
        p1 = __builtin_amdgcn_mfma_f32_32x32x16_bf16(kf[2 * s + 1], qr[s], p1, 0, 0, 0);
    }
    __builtin_amdgcn_sched_group_barrier(0x100, 8, 0);
    __builtin_amdgcn_sched_group_barrier(0x008, 8, 0);
}
__device__ __forceinline__ void qkt_v(f32x16& p0, f32x16& p1, s16x4 (&vlo)[8], s16x4 (&vhi)[8], const LAS unsigned char* kbuf, const LAS unsigned char* vb, const bf16x8 (&qr)[4], int hi, int r32) {
#pragma unroll
    for (int r = 0; r < 16; ++r) { p0[r] = 0.f; p1[r] = 0.f; }
    bf16x8 kf[8];
#pragma unroll
    for (int s = 0; s < 4; ++s) { const int ch = 2 * s + hi; const LAS unsigned char* kb = kbuf + ch * 1024 + ((((r32 + ch) & 7) | (r32 & ~7)) * 16);
        kf[2 * s] = *(const LAS bf16x8*)(kb); kf[2 * s + 1] = *(const LAS bf16x8*)(kb + 512); }
#pragma unroll
    for (int s = 0; s < 4; ++s) {
        p0 = __builtin_amdgcn_mfma_f32_32x32x16_bf16(kf[2 * s], qr[s], p0, 0, 0, 0);
        vlo[s] = vtr(vb + s * 1024); vhi[s] = vtr(vb + s * 1024 + 512);
        p1 = __builtin_amdgcn_mfma_f32_32x32x16_bf16(kf[2 * s + 1], qr[s], p1, 0, 0, 0);
        vlo[4 + s] = vtr(vb + 4096 + s * 1024); vhi[4 + s] = vtr(vb + 4096 + s * 1024 + 512);
    }
    __builtin_amdgcn_sched_group_barrier(0x100, 8, 0);
#pragma unroll
    for (int s = 0; s < 8; ++s) { __builtin_amdgcn_sched_group_barrier(0x008, 1, 0); __builtin_amdgcn_sched_group_barrier(0x100, 2, 0); }
}
constexpr float ATT_THR = 6.f;
template <bool HAS_LO, bool IMPA = false> __device__ __forceinline__ void tile_step(const LAS unsigned char* kbuf, const LAS unsigned char* vbuf, const bf16x8 (&qr)[4], float& mref, float& l, f32x16& o0, f32x16& o1,
                                          bool sel, bool first, bool need_mask, int hi_lim, int lo_lim, int hi, int r32, int lane, LAS _Float16* improw = nullptr, int jbase = 0) {
    f32x16 p0, p1;
#ifdef DUP_QK
    { f32x16 d0, d1; qkt(d0, d1, kbuf, qr, 0.f, hi, r32); float dm = fmaxf(d0[0], d1[0]);
#pragma unroll
      for (int r = 1; r < 16; ++r) dm = fmaxf(dm, fmaxf(d0[r], d1[r]));
      dm = swapmax(dm); float ds = 0.f;
#pragma unroll
      for (int r = 0; r < 16; ++r) { d0[r] = __builtin_amdgcn_exp2f(d0[r] - dm); d1[r] = __builtin_amdgcn_exp2f(d1[r] - dm); ds += d0[r] + d1[r]; }
      unsigned dk = 0;
#pragma unroll
      for (int r = 0; r < 16; r += 2) dk ^= cvtpk(d0[r], d0[r + 1]) ^ cvtpk(d1[r], d1[r + 1]);
      asm volatile("" :: "v"(ds), "v"(dk)); }
#endif
    if (!first) {
        const float l2 = swapsum(l);
        const bool big = l2 > 1048576.f;
        if (__any(big)) {
            const float dl = big ? __builtin_amdgcn_logf(l2) : 0.f;
            mref += dl;
            const float alpha = __builtin_amdgcn_exp2f(-dl);
            l *= alpha;
#pragma unroll
            for (int r = 0; r < 16; ++r) { o0[r] *= alpha; o1[r] *= alpha; }
            if constexpr (IMPA) { if (hi == 0) { for (int c = 0; c < 64; ++c) improw[c] = (_Float16)((float)improw[c] * alpha); } asm volatile("" ::: "memory"); }
        }
    }
    const LAS unsigned char* vb = vbuf + ((lane >> 4) & 1) * 32 + (lane & 3) * 8 + (4 * hi + ((lane & 15) >> 2)) * 64;
    s16x4 vlo[8], vhi[8];
    qkt_v(p0, p1, vlo, vhi, kbuf, vb, qr, hi, r32);
    const float NEG = -INFINITY;
    if (need_mask) {
        int hl = hi_lim - 4 * hi, ll = lo_lim - 4 * hi;
        asm volatile("" : "+v"(hl), "+v"(ll));
#pragma unroll
        for (int r = 0; r < 16; ++r) { const int c = (r & 3) + 8 * (r >> 2); if (!(c <= hl && (!HAS_LO || c > ll))) p0[r] = NEG; if (!(c + 32 <= hl && (!HAS_LO || c + 32 > ll))) p1[r] = NEG; }
    }
    if (first) {
        float mxa = max3f(p0[0], p0[1], p1[0]), mxb = max3f(p0[2], p0[3], p1[1]);
        mxa = max3f(mxa, p1[2], p1[3]);
#pragma unroll
        for (int r = 4; r < 16; r += 4) { mxa = max3f(mxa, p0[r], p0[r + 1]); mxb = max3f(mxb, p0[r + 2], p0[r + 3]); mxa = max3f(mxa, p1[r], p1[r + 1]); mxb = max3f(mxb, p1[r + 2], p1[r + 3]); }
        const float mx = swapmax(max2f(mxa, mxb));
        if (sel && mx > NEG) mref = mx;
    }
    const float msub = sel ? mref : INFINITY;
    float sum = 0.f;
#pragma unroll
    for (int r = 0; r < 16; ++r) { p0[r] = __builtin_amdgcn_exp2f(p0[r] - msub); p1[r] = __builtin_amdgcn_exp2f(p1[r] - msub); sum += p0[r] + p1[r]; }
    l += sum;
    if constexpr (IMPA) {
        LAS _Float16* c0 = improw + jbase + hi;
#pragma unroll
        for (int gq = 0; gq < 4; ++gq) { c0[2 * gq] = c0[2 * gq] + (_Float16)((p0[4 * gq] + p0[4 * gq + 1]) + (p0[4 * gq + 2] + p0[4 * gq + 3]));
                                          c0[8 + 2 * gq] = c0[8 + 2 * gq] + (_Float16)((p1[4 * gq] + p1[4 * gq + 1]) + (p1[4 * gq + 2] + p1[4 * gq + 3])); }
        asm volatile("" ::: "memory");
#pragma unroll
        for (int gq = 0; gq < 4; ++gq) { c0[2 * gq + 1] = c0[2 * gq + 1] + (_Float16)p0[4 * gq + 3];
                                          if (jbase + hi + 8 + 2 * gq + 1 < 64) c0[8 + 2 * gq + 1] = c0[8 + 2 * gq + 1] + (_Float16)p1[4 * gq + 3]; }
        asm volatile("" ::: "memory");
    }
    bf16x8 pf[4];
    { v4u w;
      w.x = cvtpk(p0[0], p0[1]); w.y = cvtpk(p0[2], p0[3]); w.z = cvtpk(p0[4], p0[5]); w.w = cvtpk(p0[6], p0[7]); pf[0] = __builtin_bit_cast(bf16x8, w);
      w.x = cvtpk(p0[8], p0[9]); w.y = cvtpk(p0[10], p0[11]); w.z = cvtpk(p0[12], p0[13]); w.w = cvtpk(p0[14], p0[15]); pf[1] = __builtin_bit_cast(bf16x8, w);
      w.x = cvtpk(p1[0], p1[1]); w.y = cvtpk(p1[2], p1[3]); w.z = cvtpk(p1[4], p1[5]); w.w = cvtpk(p1[6], p1[7]); pf[2] = __builtin_bit_cast(bf16x8, w);
      w.x = cvtpk(p1[8], p1[9]); w.y = cvtpk(p1[10], p1[11]); w.z = cvtpk(p1[12], p1[13]); w.w = cvtpk(p1[14], p1[15]); pf[3] = __builtin_bit_cast(bf16x8, w); }
#pragma unroll
    for (int s = 0; s < 4; ++s) {
        const bf16x8 va = (bf16x8){vlo[s][0], vlo[s][1], vlo[s][2], vlo[s][3], vhi[s][0], vhi[s][1], vhi[s][2], vhi[s][3]};
        const bf16x8 vb8 = (bf16x8){vlo[4 + s][0], vlo[4 + s][1], vlo[4 + s][2], vlo[4 + s][3], vhi[4 + s][0], vhi[4 + s][1], vhi[4 + s][2], vhi[4 + s][3]};
        o0 = __builtin_amdgcn_mfma_f32_32x32x16_bf16(va, pf[s], o0, 0, 0, 0);
        o1 = __builtin_amdgcn_mfma_f32_32x32x16_bf16(vb8, pf[s], o1, 0, 0, 0);
    }
#ifdef DUP_PV
    { f32x16 d0, d1;
#pragma unroll
      for (int r = 0; r < 16; ++r) { d0[r] = 0.f; d1[r] = 0.f; }
      s16x4 ulo[8], uhi[8];
#pragma unroll
      for (int s = 0; s < 4; ++s) { ulo[s] = vtr(vb + s * 1024); uhi[s] = vtr(vb + s * 1024 + 512); ulo[4 + s] = vtr(vb + 4096 + s * 1024); uhi[4 + s] = vtr(vb + 4096 + s * 1024 + 512); }
#pragma unroll
      for (int s = 0; s < 4; ++s) {
          const bf16x8 va = (bf16x8){ulo[s][0], ulo[s][1], ulo[s][2], ulo[s][3], uhi[s][0], uhi[s][1], uhi[s][2], uhi[s][3]};
          const bf16x8 vb8 = (bf16x8){ulo[4 + s][0], ulo[4 + s][1], ulo[4 + s][2], ulo[4 + s][3], uhi[4 + s][0], uhi[4 + s][1], uhi[4 + s][2], uhi[4 + s][3]};
          d0 = __builtin_amdgcn_mfma_f32_32x32x16_bf16(va, pf[s], d0, 0, 0, 0);
          d1 = __builtin_amdgcn_mfma_f32_32x32x16_bf16(vb8, pf[s], d1, 0, 0, 0);
      }
      asm volatile("" :: "v"(d0), "v"(d1)); }
#endif
}
__device__ __forceinline__ void imp_step(const LAS unsigned char* kbuf, const bf16x8 (&qr)[4], float mfin, float linv, int hi_lim, int hi, int r32, LAS float* improw, int jbase) {
    f32x16 p0, p1;
    qkt(p0, p1, kbuf, qr, 0.f, hi, r32);
    int hl = hi_lim - 4 * hi; asm volatile("" : "+v"(hl));
#pragma unroll
    for (int r = 0; r < 16; ++r) { const int c = (r & 3) + 8 * (r >> 2);
        p0[r] = (c <= hl) ? __builtin_amdgcn_exp2f(p0[r] - mfin) * linv : 0.f;
        p1[r] = (c + 32 <= hl) ? __builtin_amdgcn_exp2f(p1[r] - mfin) * linv : 0.f; }
#pragma unroll
    for (int gq = 0; gq < 4; ++gq) {
        { const float G = (p0[4 * gq] + p0[4 * gq + 1]) + (p0[4 * gq + 2] + p0[4 * gq + 3]); const int j = jbase + 2 * gq + hi;
          __hip_atomic_fetch_add(improw + j, G, __ATOMIC_RELAXED, __HIP_MEMORY_SCOPE_WORKGROUP);
          if (j + 1 < 64) __hip_atomic_fetch_add(improw + j + 1, p0[4 * gq + 3], __ATOMIC_RELAXED, __HIP_MEMORY_SCOPE_WORKGROUP); }
        { const float G = (p1[4 * gq] + p1[4 * gq + 1]) + (p1[4 * gq + 2] + p1[4 * gq + 3]); const int j = jbase + 8 + 2 * gq + hi;
          __hip_atomic_fetch_add(improw + j, G, __ATOMIC_RELAXED, __HIP_MEMORY_SCOPE_WORKGROUP);
          if (j + 1 < 64) __hip_atomic_fetch_add(improw + j + 1, p1[4 * gq + 3], __ATOMIC_RELAXED, __HIP_MEMORY_SCOPE_WORKGROUP); }
    }
}
__device__ __forceinline__ void ost_acc(LAS unsigned char* orow, const f32x16& o0, const f32x16& o1, float sc, bool first, int hi) {
#pragma unroll
    for (int rg = 0; rg < 4; ++rg) {
        const int d = 8 * rg + 4 * hi;
        float a[4], c[4];
#pragma unroll
        for (int e = 0; e < 4; ++e) { a[e] = o0[4 * rg + e] * sc; c[e] = o1[4 * rg + e] * sc; }
        if (!first) { const v2u w0 = *(const LAS v2u*)(orow + d * 2), w1 = *(const LAS v2u*)(orow + (32 + d) * 2);
            a[0] += bflo(w0.x); a[1] += bfhi(w0.x); a[2] += bflo(w0.y); a[3] += bfhi(w0.y); c[0] += bflo(w1.x); c[1] += bfhi(w1.x); c[2] += bflo(w1.y); c[3] += bfhi(w1.y); }
        v2u w0; w0.x = cvtpk(a[0], a[1]); w0.y = cvtpk(a[2], a[3]); *(LAS v2u*)(orow + d * 2) = w0;
        v2u w1; w1.x = cvtpk(c[0], c[1]); w1.y = cvtpk(c[2], c[3]); *(LAS v2u*)(orow + (32 + d) * 2) = w1;
    }
}
}

#define ATT_PRE(T0, KP, VP, RS) do { const int t_ = (T0); att::tile_load(sA_, (KP), (VP), (RS), tid); } while (0)
#define ATT_PASS(T0, NTL, KP, VP, RS, BODY) do { \
    const int tend_ = (T0) + (NTL); int t_ = (T0), cur_ = 0; \
    { att::tile_store(sA_, L + att::KBUF, L + att::VBUF, tid); } \
    if (t_ + 1 < tend_) { ++t_; att::tile_load(sB_, (KP), (VP), (RS), tid); --t_; } \
    __syncthreads(); \
    for (;;) { \
        if (t_ + 2 < tend_) { t_ += 2; att::tile_load(sA_, (KP), (VP), (RS), tid); t_ -= 2; } \
        { const LAS unsigned char* kb_ = L + att::KBUF + cur_ * 8192; const LAS unsigned char* vb_ = L + att::VBUF + cur_ * 8192; BODY; } \
        if (t_ + 1 >= tend_) break; \
        att::tile_store(sB_, L + att::KBUF + (cur_ ^ 1) * 8192, L + att::VBUF + (cur_ ^ 1) * 8192, tid); \
        __syncthreads(); cur_ ^= 1; ++t_; \
        if (t_ + 2 < tend_) { t_ += 2; att::tile_load(sB_, (KP), (VP), (RS), tid); t_ -= 2; } \
        { const LAS unsigned char* kb_ = L + att::KBUF + cur_ * 8192; const LAS unsigned char* vb_ = L + att::VBUF + cur_ * 8192; BODY; } \
        if (t_ + 1 >= tend_) break; \
        att::tile_store(sA_, L + att::KBUF + (cur_ ^ 1) * 8192, L + att::VBUF + (cur_ ^ 1) * 8192, tid); \
        __syncthreads(); cur_ ^= 1; ++t_; } \
    __syncthreads(); } while (0)

__device__ __forceinline__ void p3_unit(Frame& F, int b, int i) {
    LAS unsigned char* L = F.lds + RING_OFF;
    const int tid = F.tid, lane = F.lane, w = F.wave, hi = lane >> 5, r32 = lane & 31;
    LAS float* LINV = (LAS float*)(L + att::LINV_OFF);
    LAS unsigned long long* SELM = (LAS unsigned long long*)(L + att::SELM_OFF);
    LAS float* SSQ = (LAS float*)(L + att::SSQ_OFF);
    const int q = (w & 1) * 32 + r32;
    const int t = 64 * i + q;
    const size_t bt = (size_t)b * SEQ + t;
    const float NEG = -INFINITY;
    if (tid < 64) SSQ[tid] = 0.f;
    att::Stg sA_, sB_;
#define ATT_CMP_K(G) (F_KCC + ((size_t)(b * 256 + 64 * t_) * 2 + (G)) * 64)
#define ATT_CMP_V(G) (F_VCC + ((size_t)(b * 256 + 64 * t_) * 2 + (G)) * 64)
    ATT_PRE(0, ATT_CMP_K(0), ATT_CMP_V(0), 128);
    for (int g = 0; g < 2; ++g) {
        const int H = g * 4 + (w >> 1);
        for (int z = tid; z < 3 * att::IMP_PLANE / 4; z += NWAVES * 64) ((LAS unsigned*)(L + att::IMP_OFF))[z] = 0u;
        for (int z = tid; z < att::IMP_PLANE / 4; z += NWAVES * 64) ((LAS unsigned*)(L + att::IMP3_OFF))[z] = 0u;
        bf16x8 qr[4];
#pragma unroll
        for (int s = 0; s < 4; ++s) qr[s] = *(const GAS bf16x8*)(F_PROJ + bt * NPROJ + C_Q + H * 64 + 16 * s + 8 * hi);
        LAS float* gslot = (LAS float*)(L + att::GATE_OFF + tid * 16);
        { const bf16* gp = F_PROJ + bt * NPROJ + C_G + H * 3; const float g0 = bf2f(gp[0]), g1 = bf2f(gp[1]), g2 = bf2f(gp[2]);
          gslot[0] = 1.f / (1.f + __expf(-g0)); gslot[1] = 1.f / (1.f + __expf(-g1)); gslot[2] = 1.f / (1.f + __expf(-g2)); }
#define ATT_GATE(k) (gslot[k])
        LAS unsigned char* orow = L + att::OST_OFF + q * att::OST_ROW + (H * 64) * 2;
        const int nlim = (t - 31) >> 4;
        const int nmaxb = (4 * i + 2 < 254) ? 4 * i + 2 : 254;
        const int nct = (nmaxb >> 6) + 1;
        float m = 0.f, l = 0.f; f32x16 o0, o1;
#pragma unroll
        for (int r = 0; r < 16; ++r) { o0[r] = 0.f; o1[r] = 0.f; }
        bool first = true;
        ATT_PASS(0, nct, ATT_CMP_K(g), ATT_CMP_V(g), 128,
                 { (att::tile_step<false, true>)(kb_, vb_, qr, m, l, o0, o1, true, first, true, nlim - 64 * t_, -1, hi, r32, lane, att::imp_plane(L, w >> 1) + q * att::IMP_ROW, 16 * t_); first = false; });
        ATT_PRE(0, F_PROJ + ((size_t)b * SEQ + 64 * t_) * NPROJ + C_KS + g * 64, F_PROJ + ((size_t)b * SEQ + 64 * t_) * NPROJ + C_VS + g * 64, NPROJ);
        { const float lt = att::swapsum(l); const float linv = lt > 0.f ? 1.f / lt : 0.f; if (hi == 0) LINV[(w >> 1) * 64 + q] = linv; att::ost_acc(orow, o0, o1, ATT_GATE(0) * linv, true, hi); }
        __syncthreads();
        { const int j = lane; const bool forced = (j == 0) || (j == i) || (j == i - 1);
          for (int qq = 0; qq < 8; qq += 4) {
              unsigned key[4]; int rank[4];
#pragma unroll
              for (int u = 0; u < 4; ++u) { const int qx = 8 * w + qq + u;
                  const int co = qx * att::IMP_ROW + lane;
                  const float v0 = ((float)att::imp_plane(L, 0)[co] * LINV[qx] + (float)att::imp_plane(L, 1)[co] * LINV[64 + qx]) + ((float)att::imp_plane(L, 2)[co] * LINV[128 + qx] + (float)att::imp_plane(L, 3)[co] * LINV[192 + qx]);
                  key[u] = (j > i) ? (unsigned)(63 - j) : (((__builtin_bit_cast(unsigned, v0) & ~63u) | (unsigned)(63 - j)) | (forced ? 0x80000000u : 0u)); rank[u] = 0; }
              LAS unsigned* kq = (LAS unsigned*)(L + att::KBUF + w * 1024);
#pragma unroll
              for (int u = 0; u < 4; ++u) kq[u * 64 + lane] = key[u];
#pragma unroll
              for (int jc = 0; jc < 4; ++jc) {
                  if (16 * jc <= i) {
#pragma unroll
                      for (int j4 = 4 * jc; j4 < 4 * jc + 4; ++j4) {
#pragma unroll
                          for (int u = 0; u < 4; ++u) { const v4u o = *(const LAS v4u*)(kq + u * 64 + 4 * j4);
                              rank[u] += ((o.x > key[u]) ? 1 : 0) + ((o.y > key[u]) ? 1 : 0) + ((o.z > key[u]) ? 1 : 0) + ((o.w > key[u]) ? 1 : 0); } } } }
#pragma unroll
              for (int u = 0; u < 4; ++u) { const unsigned long long msk = __ballot(rank[u] < 16); if (lane == 0) SELM[8 * w + qq + u] = msk; } } }
        __syncthreads();
        m = 0.f; l = 0.f; first = true;
#pragma unroll
        for (int r = 0; r < 16; ++r) { o0[r] = 0.f; o1[r] = 0.f; }
        ATT_PASS(0, i + 1, F_PROJ + ((size_t)b * SEQ + 64 * t_) * NPROJ + C_KS + g * 64, F_PROJ + ((size_t)b * SEQ + 64 * t_) * NPROJ + C_VS + g * 64, NPROJ,
                 { att::tile_step<false>(kb_, vb_, qr, m, l, o0, o1, ((SELM[q] >> t_) & 1ull) != 0ull, first, t_ == i, (t_ == i) ? q : 63, -1, hi, r32, lane); first = false; });
        const int wlo = (i >= 8) ? i - 8 : 0;
        ATT_PRE(wlo, F_PROJ + ((size_t)b * SEQ + 64 * t_) * NPROJ + C_KW + g * 64, F_PROJ + ((size_t)b * SEQ + 64 * t_) * NPROJ + C_VW + g * 64, NPROJ);
        { const float lt = att::swapsum(l); att::ost_acc(orow, o0, o1, lt > 0.f ? ATT_GATE(1) / lt : 0.f, false, hi); }
        m = 0.f; l = 0.f; first = true;
#pragma unroll
        for (int r = 0; r < 16; ++r) { o0[r] = 0.f; o1[r] = 0.f; }
        ATT_PASS(wlo, i - wlo + 1, F_PROJ + ((size_t)b * SEQ + 64 * t_) * NPROJ + C_KW + g * 64, F_PROJ + ((size_t)b * SEQ + 64 * t_) * NPROJ + C_VW + g * 64, NPROJ,
                 { att::tile_step<true>(kb_, vb_, qr, m, l, o0, o1, true, first, (t_ == i) || (t_ == i - 8), (t_ == i) ? q : 63, (t_ == i - 8) ? q : -1, hi, r32, lane); first = false; });
        if (g == 0) ATT_PRE(0, ATT_CMP_K(1), ATT_CMP_V(1), 128);
        { const float lt = att::swapsum(l); att::ost_acc(orow, o0, o1, lt > 0.f ? ATT_GATE(2) / lt : 0.f, false, hi); }
        { float ss = 0.f;
#pragma unroll
          for (int rg = 0; rg < 4; ++rg) { const int d = 8 * rg + 4 * hi; const v2u w0 = *(const LAS v2u*)(orow + d * 2), w1 = *(const LAS v2u*)(orow + (32 + d) * 2);
              const float a0 = bflo(w0.x), a1 = bfhi(w0.x), a2 = bflo(w0.y), a3 = bfhi(w0.y), c0 = bflo(w1.x), c1 = bfhi(w1.x), c2 = bflo(w1.y), c3 = bfhi(w1.y);
              ss += (a0 * a0 + a1 * a1) + (a2 * a2 + a3 * a3) + (c0 * c0 + c1 * c1) + (c2 * c2 + c3 * c3); }
          ss = att::swapsum(ss); if (hi == 0) ((LAS float*)(L + att::SSQH_OFF))[H * 64 + q] = ss; }
        __syncthreads();
    }
    { const int qx = tid >> 3, part = tid & 7; const LAS float* sh = (const LAS float*)(L + att::SSQH_OFF) + qx;
      const float rs = 1.f / sqrtf((((sh[0] + sh[64]) + (sh[128] + sh[192])) + ((sh[256] + sh[320]) + (sh[384] + sh[448]))) * (1.f / 512.f) + RMS_EPS);
      const LAS unsigned char* orow = L + att::OST_OFF + qx * att::OST_ROW + part * 16; bf16* dst = F_MIXA + ((size_t)b * SEQ + 64 * i + qx) * 1024 + 512 + part * 8;
#pragma unroll
      for (int c8 = 0; c8 < 8; ++c8) { const int c = 8 * c8; float f[8]; up8(*(const LAS v4u*)(orow + c8 * 128), f); const f32x4 g0 = *(const GAS f32x4*)(F_gn_attn + part * 8 + c * 8), g1 = *(const GAS f32x4*)(F_gn_attn + part * 8 + c * 8 + 4);
          v4u o; o.x = pk2(f[0] * rs * g0[0], f[1] * rs * g0[1]); o.y = pk2(f[2] * rs * g0[2], f[3] * rs * g0[3]); o.z = pk2(f[4] * rs * g1[0], f[5] * rs * g1[1]); o.w = pk2(f[6] * rs * g1[2], f[7] * rs * g1[3]);
          *(GAS v4u*)(dst + c * 8) = o; } }
    __syncthreads();
}
__device__ __forceinline__ void p3_attention(Frame& F) {
    for (int u = F.vcu; u < 512; u += F.G) { const int k = u >> 8, v = u & 255; const int b = v >> 5, s = v & 31; p3_unit(F, b, k ? 63 - s : s); }
}

namespace peer {
constexpr int IDX_OFF = 0, W6_OFF = 16384;
__device__ __forceinline__ unsigned f2key(float f) { const unsigned u = __builtin_bit_cast(unsigned, f); return u ^ ((unsigned)((int)u >> 31) | 0x80000000u); }
__device__ __forceinline__ float key2f(unsigned k) { return __builtin_bit_cast(float, k ^ ((k & 0x80000000u) ? 0x80000000u : 0xFFFFFFFFu)); }
__device__ __forceinline__ unsigned umax(unsigned a, unsigned b) { return a > b ? a : b; }
__device__ __forceinline__ unsigned umin(unsigned a, unsigned b) { return a < b ? a : b; }
__device__ __forceinline__ void sort16_desc(unsigned (&a)[16]) {
#pragma unroll
    for (int k = 2; k <= 16; k <<= 1) {
#pragma unroll
        for (int j = k >> 1; j > 0; j >>= 1) {
#pragma unroll
            for (int i = 0; i < 16; ++i) { const int l = i ^ j; if (l > i) { const bool up = ((i & k) == 0); const unsigned mx = umax(a[i], a[l]), mn = umin(a[i], a[l]); a[i] = up ? mx : mn; a[l] = up ? mn : mx; } }
        }
    }
}
__device__ __forceinline__ void merge16_desc(unsigned (&A)[16], const unsigned (&B)[16]) {
#pragma unroll
    for (int i = 0; i < 16; ++i) A[i] = umax(A[i], B[15 - i]);
#pragma unroll
    for (int j = 8; j > 0; j >>= 1) {
#pragma unroll
        for (int i = 0; i < 16; ++i) { const int l = i ^ j; if (l > i) { const unsigned mx = umax(A[i], A[l]), mn = umin(A[i], A[l]); A[i] = mx; A[l] = mn; } }
    }
}
template <int GQ> __device__ __forceinline__ void fill_cands(unsigned (&g)[16], const float (&f0)[16], const float (&f1)[16]) {
    if constexpr (GQ == 0) {
        g[0] = (f2key(f0[0] + f1[0]) & ~255u) | 255u;
        g[1] = (f2key(f0[0] + f1[1]) & ~255u) | 254u;
        g[2] = (f2key(f0[0] + f1[2]) & ~255u) | 253u;
        g[3] = (f2key(f0[0] + f1[3]) & ~255u) | 252u;
        g[4] = (f2key(f0[0] + f1[4]) & ~255u) | 251u;
        g[5] = (f2key(f0[0] + f1[5]) & ~255u) | 250u;
        g[6] = (f2key(f0[0] + f1[6]) & ~255u) | 249u;
        g[7] = (f2key(f0[0] + f1[7]) & ~255u) | 248u;
        g[8] = (f2key(f0[0] + f1[8]) & ~255u) | 247u;
        g[9] = (f2key(f0[0] + f1[9]) & ~255u) | 246u;
        g[10] = (f2key(f0[0] + f1[10]) & ~255u) | 245u;
        g[11] = (f2key(f0[0] + f1[11]) & ~255u) | 244u;
        g[12] = (f2key(f0[0] + f1[12]) & ~255u) | 243u;
        g[13] = (f2key(f0[0] + f1[13]) & ~255u) | 242u;
        g[14] = (f2key(f0[0] + f1[14]) & ~255u) | 241u;
        g[15] = (f2key(f0[0] + f1[15]) & ~255u) | 240u;
    }
    if constexpr (GQ == 1) {
        g[0] = (f2key(f0[1] + f1[0]) & ~255u) | 239u;
        g[1] = (f2key(f0[1] + f1[1]) & ~255u) | 238u;
        g[2] = (f2key(f0[1] + f1[2]) & ~255u) | 237u;
        g[3] = (f2key(f0[1] + f1[3]) & ~255u) | 236u;
        g[4] = (f2key(f0[1] + f1[4]) & ~255u) | 235u;
        g[5] = (f2key(f0[1] + f1[5]) & ~255u) | 234u;
        g[6] = (f2key(f0[1] + f1[6]) & ~255u) | 233u;
        g[7] = (f2key(f0[1] + f1[7]) & ~255u) | 232u;
        g[8] = (f2key(f0[2] + f1[0]) & ~255u) | 223u;
        g[9] = (f2key(f0[2] + f1[1]) & ~255u) | 222u;
        g[10] = (f2key(f0[2] + f1[2]) & ~255u) | 221u;
        g[11] = (f2key(f0[2] + f1[3]) & ~255u) | 220u;
        g[12] = (f2key(f0[2] + f1[4]) & ~255u) | 219u;
        g[13] = (f2key(f0[3] + f1[0]) & ~255u) | 207u;
        g[14] = (f2key(f0[3] + f1[1]) & ~255u) | 206u;
        g[15] = (f2key(f0[3] + f1[2]) & ~255u) | 205u;
    }
    if constexpr (GQ == 2) {
        g[0] = (f2key(f0[3] + f1[3]) & ~255u) | 204u;
        g[1] = (f2key(f0[4] + f1[0]) & ~255u) | 191u;
        g[2] = (f2key(f0[4] + f1[1]) & ~255u) | 190u;
        g[3] = (f2key(f0[4] + f1[2]) & ~255u) | 189u;
        g[4] = (f2key(f0[5] + f1[0]) & ~255u) | 175u;
        g[5] = (f2key(f0[5] + f1[1]) & ~255u) | 174u;
        g[6] = (f2key(f0[6] + f1[0]) & ~255u) | 159u;
        g[7] = (f2key(f0[6] + f1[1]) & ~255u) | 158u;
        g[8] = (f2key(f0[7] + f1[0]) & ~255u) | 143u;
        g[9] = (f2key(f0[7] + f1[1]) & ~255u) | 142u;
        g[10] = (f2key(f0[8] + f1[0]) & ~255u) | 127u;
        g[11] = (f2key(f0[9] + f1[0]) & ~255u) | 111u;
        g[12] = (f2key(f0[10] + f1[0]) & ~255u) | 95u;
        g[13] = (f2key(f0[11] + f1[0]) & ~255u) | 79u;
        g[14] = (f2key(f0[12] + f1[0]) & ~255u) | 63u;
        g[15] = (f2key(f0[13] + f1[0]) & ~255u) | 47u;
    }
    if constexpr (GQ == 3) {
        g[0] = (f2key(f0[14] + f1[0]) & ~255u) | 31u;
        g[1] = (f2key(f0[15] + f1[0]) & ~255u) | 15u;
        g[2] = 0u;
        g[3] = 0u;
        g[4] = 0u;
        g[5] = 0u;
        g[6] = 0u;
        g[7] = 0u;
        g[8] = 0u;
        g[9] = 0u;
        g[10] = 0u;
        g[11] = 0u;
        g[12] = 0u;
        g[13] = 0u;
        g[14] = 0u;
        g[15] = 0u;
    }
}
__device__ __forceinline__ float dot2bf(unsigned a, unsigned b, float c) { return __builtin_amdgcn_fdot2_f32_bf16(__builtin_bit_cast(bf16x2v, a), __builtin_bit_cast(bf16x2v, b), c, false); }
__device__ __forceinline__ float dot8(const v4u a, const v4u b, float c) { c = dot2bf(a.x, b.x, c); c = dot2bf(a.y, b.y, c); c = dot2bf(a.z, b.z, c); return dot2bf(a.w, b.w, c); }
__device__ __forceinline__ float dot32b(const v4u u, const unsigned (&h)[16]) {
    float s0 = 0.f, s1 = 0.f, s2 = 0.f, s3 = 0.f;
#define P6_D2(W, bs, hi_, acc_) acc_ = __builtin_amdgcn_fdot2_f32_bf16(__builtin_amdgcn_cvt_scalef32_pk_bf16_fp4((W), 1.0f, (bs)), __builtin_bit_cast(bf16x2v, h[hi_]), acc_, false)
    P6_D2(u.x, 0, 0, s0); P6_D2(u.x, 1, 1, s1); P6_D2(u.x, 2, 2, s2); P6_D2(u.x, 3, 3, s3);
    P6_D2(u.y, 0, 4, s0); P6_D2(u.y, 1, 5, s1); P6_D2(u.y, 2, 6, s2); P6_D2(u.y, 3, 7, s3);
    P6_D2(u.z, 0, 8, s0); P6_D2(u.z, 1, 9, s1); P6_D2(u.z, 2, 10, s2); P6_D2(u.z, 3, 11, s3);
    P6_D2(u.w, 0, 12, s0); P6_D2(u.w, 1, 13, s1); P6_D2(u.w, 2, 14, s2); P6_D2(u.w, 3, 15, s3);
#undef P6_D2
    return (s0 + s1) + (s2 + s3);
}
typedef _Float16 h16x2 __attribute__((ext_vector_type(2)));
template <int BS> __device__ __forceinline__ h16x2 cvt4h(unsigned w) { return __builtin_bit_cast(h16x2, __builtin_amdgcn_cvt_scalef32_pk_f16_fp4(w, 1.0f, BS)); }
__device__ __forceinline__ void axpy32h(h16x2 (&acc)[16], const v4u v, _Float16 a) {
    const h16x2 a2 = (h16x2){a, a};
    acc[0] = __builtin_elementwise_fma(cvt4h<0>(v.x), a2, acc[0]); acc[1] = __builtin_elementwise_fma(cvt4h<1>(v.x), a2, acc[1]); acc[2] = __builtin_elementwise_fma(cvt4h<2>(v.x), a2, acc[2]); acc[3] = __builtin_elementwise_fma(cvt4h<3>(v.x), a2, acc[3]);
    acc[4] = __builtin_elementwise_fma(cvt4h<0>(v.y), a2, acc[4]); acc[5] = __builtin_elementwise_fma(cvt4h<1>(v.y), a2, acc[5]); acc[6] = __builtin_elementwise_fma(cvt4h<2>(v.y), a2, acc[6]); acc[7] = __builtin_elementwise_fma(cvt4h<3>(v.y), a2, acc[7]);
    acc[8] = __builtin_elementwise_fma(cvt4h<0>(v.z), a2, acc[8]); acc[9] = __builtin_elementwise_fma(cvt4h<1>(v.z), a2, acc[9]); acc[10] = __builtin_elementwise_fma(cvt4h<2>(v.z), a2, acc[10]); acc[11] = __builtin_elementwise_fma(cvt4h<3>(v.z), a2, acc[11]);
    acc[12] = __builtin_elementwise_fma(cvt4h<0>(v.w), a2, acc[12]); acc[13] = __builtin_elementwise_fma(cvt4h<1>(v.w), a2, acc[13]); acc[14] = __builtin_elementwise_fma(cvt4h<2>(v.w), a2, acc[14]); acc[15] = __builtin_elementwise_fma(cvt4h<3>(v.w), a2, acc[15]);
}
__device__ __forceinline__ float dot32(const v4u u, const f32x2 (&h)[16]) {
    f32x2 s = __builtin_amdgcn_cvt_scalef32_pk_f32_fp4(u.x, 1.0f, 0) * h[0];
    s += __builtin_amdgcn_cvt_scalef32_pk_f32_fp4(u.x, 1.0f, 1) * h[1]; s += __builtin_amdgcn_cvt_scalef32_pk_f32_fp4(u.x, 1.0f, 2) * h[2]; s += __builtin_amdgcn_cvt_scalef32_pk_f32_fp4(u.x, 1.0f, 3) * h[3];
    s += __builtin_amdgcn_cvt_scalef32_pk_f32_fp4(u.y, 1.0f, 0) * h[4]; s += __builtin_amdgcn_cvt_scalef32_pk_f32_fp4(u.y, 1.0f, 1) * h[5]; s += __builtin_amdgcn_cvt_scalef32_pk_f32_fp4(u.y, 1.0f, 2) * h[6]; s += __builtin_amdgcn_cvt_scalef32_pk_f32_fp4(u.y, 1.0f, 3) * h[7];
    s += __builtin_amdgcn_cvt_scalef32_pk_f32_fp4(u.z, 1.0f, 0) * h[8]; s += __builtin_amdgcn_cvt_scalef32_pk_f32_fp4(u.z, 1.0f, 1) * h[9]; s += __builtin_amdgcn_cvt_scalef32_pk_f32_fp4(u.z, 1.0f, 2) * h[10]; s += __builtin_amdgcn_cvt_scalef32_pk_f32_fp4(u.z, 1.0f, 3) * h[11];
    s += __builtin_amdgcn_cvt_scalef32_pk_f32_fp4(u.w, 1.0f, 0) * h[12]; s += __builtin_amdgcn_cvt_scalef32_pk_f32_fp4(u.w, 1.0f, 1) * h[13]; s += __builtin_amdgcn_cvt_scalef32_pk_f32_fp4(u.w, 1.0f, 2) * h[14]; s += __builtin_amdgcn_cvt_scalef32_pk_f32_fp4(u.w, 1.0f, 3) * h[15];
    return s.x + s.y;
}
__device__ __forceinline__ void axpy32(f32x2 (&acc)[16], const v4u v, float a) {
    const f32x2 a2 = (f32x2){a, a};
    acc[0] += __builtin_amdgcn_cvt_scalef32_pk_f32_fp4(v.x, 1.0f, 0) * a2; acc[1] += __builtin_amdgcn_cvt_scalef32_pk_f32_fp4(v.x, 1.0f, 1) * a2; acc[2] += __builtin_amdgcn_cvt_scalef32_pk_f32_fp4(v.x, 1.0f, 2) * a2; acc[3] += __builtin_amdgcn_cvt_scalef32_pk_f32_fp4(v.x, 1.0f, 3) * a2;
    acc[4] += __builtin_amdgcn_cvt_scalef32_pk_f32_fp4(v.y, 1.0f, 0) * a2; acc[5] += __builtin_amdgcn_cvt_scalef32_pk_f32_fp4(v.y, 1.0f, 1) * a2; acc[6] += __builtin_amdgcn_cvt_scalef32_pk_f32_fp4(v.y, 1.0f, 2) * a2; acc[7] += __builtin_amdgcn_cvt_scalef32_pk_f32_fp4(v.y, 1.0f, 3) * a2;
    acc[8] += __builtin_amdgcn_cvt_scalef32_pk_f32_fp4(v.z, 1.0f, 0) * a2; acc[9] += __builtin_amdgcn_cvt_scalef32_pk_f32_fp4(v.z, 1.0f, 1) * a2; acc[10] += __builtin_amdgcn_cvt_scalef32_pk_f32_fp4(v.z, 1.0f, 2) * a2; acc[11] += __builtin_amdgcn_cvt_scalef32_pk_f32_fp4(v.z, 1.0f, 3) * a2;
    acc[12] += __builtin_amdgcn_cvt_scalef32_pk_f32_fp4(v.w, 1.0f, 0) * a2; acc[13] += __builtin_amdgcn_cvt_scalef32_pk_f32_fp4(v.w, 1.0f, 1) * a2; acc[14] += __builtin_amdgcn_cvt_scalef32_pk_f32_fp4(v.w, 1.0f, 2) * a2; acc[15] += __builtin_amdgcn_cvt_scalef32_pk_f32_fp4(v.w, 1.0f, 3) * a2;
}
__device__ __forceinline__ float dot16(const v4u u, const f32x2 (&h)[8]) {
    f32x2 s = __builtin_amdgcn_cvt_pk_f32_fp8((int)u.x, false) * h[0];
    s += __builtin_amdgcn_cvt_pk_f32_fp8((int)u.x, true) * h[1];
    s += __builtin_amdgcn_cvt_pk_f32_fp8((int)u.y, false) * h[2]; s += __builtin_amdgcn_cvt_pk_f32_fp8((int)u.y, true) * h[3];
    s += __builtin_amdgcn_cvt_pk_f32_fp8((int)u.z, false) * h[4]; s += __builtin_amdgcn_cvt_pk_f32_fp8((int)u.z, true) * h[5];
    s += __builtin_amdgcn_cvt_pk_f32_fp8((int)u.w, false) * h[6]; s += __builtin_amdgcn_cvt_pk_f32_fp8((int)u.w, true) * h[7];
    return s.x + s.y;
}
__device__ __forceinline__ void axpy16(f32x2 (&acc)[8], const v4u v, float a) {
    const f32x2 a2 = (f32x2){a, a};
    acc[0] += __builtin_amdgcn_cvt_pk_f32_fp8((int)v.x, false) * a2; acc[1] += __builtin_amdgcn_cvt_pk_f32_fp8((int)v.x, true) * a2;
    acc[2] += __builtin_amdgcn_cvt_pk_f32_fp8((int)v.y, false) * a2; acc[3] += __builtin_amdgcn_cvt_pk_f32_fp8((int)v.y, true) * a2;
    acc[4] += __builtin_amdgcn_cvt_pk_f32_fp8((int)v.z, false) * a2; acc[5] += __builtin_amdgcn_cvt_pk_f32_fp8((int)v.z, true) * a2;
    acc[6] += __builtin_amdgcn_cvt_pk_f32_fp8((int)v.w, false) * a2; acc[7] += __builtin_amdgcn_cvt_pk_f32_fp8((int)v.w, true) * a2;
}
__device__ __forceinline__ float xsum32(float a, float b) { auto r = __builtin_amdgcn_permlane32_swap(__float_as_uint(a), __float_as_uint(b), false, false); return __uint_as_float(r[0]) + __uint_as_float(r[1]); }
__device__ __forceinline__ float xsum16(float a, float b) { auto r = __builtin_amdgcn_permlane16_swap(__float_as_uint(a), __float_as_uint(b), false, false); return __uint_as_float(r[0]) + __uint_as_float(r[1]); }
template <int CTRL> __device__ __forceinline__ float dppf(float v) { return __builtin_bit_cast(float, __builtin_amdgcn_update_dpp(0, __builtin_bit_cast(int, v), CTRL, 0xF, 0xF, true)); }
__device__ __forceinline__ float transpose_reduce8_dc(const float (&p)[8], int lane) {
    float x4[4], x2[2];
    { const bool bt = (lane & 4) != 0;
#pragma unroll
      for (int k = 0; k < 4; ++k) { const float keep = bt ? p[k + 4] : p[k], send = bt ? p[k] : p[k + 4]; x4[k] = keep + dppf<0x141>(send); } }
    { const bool bt = (lane & 2) != 0;
#pragma unroll
      for (int k = 0; k < 2; ++k) { const float keep = bt ? x4[k + 2] : x4[k], send = bt ? x4[k] : x4[k + 2]; x2[k] = keep + dppf<0x4E>(send); } }
    const bool bt = (lane & 1) != 0; const float keep = bt ? x2[1] : x2[0], send = bt ? x2[0] : x2[1]; return keep + dppf<0xB1>(send);
}
__device__ __forceinline__ float transpose_reduce8(const float (&p)[8], int lane) {
    float x4[4], x2[2];
    { const bool bt = (lane & 4) != 0;
#pragma unroll
      for (int k = 0; k < 4; ++k) { const float keep = bt ? p[k + 4] : p[k], send = bt ? p[k] : p[k + 4]; x4[k] = keep + __shfl_xor(send, 4); } }
    { const bool bt = (lane & 2) != 0;
#pragma unroll
      for (int k = 0; k < 2; ++k) { const float keep = bt ? x4[k + 2] : x4[k], send = bt ? x4[k] : x4[k + 2]; x2[k] = keep + __shfl_xor(send, 2); } }
    float r;
    { const bool bt = (lane & 1) != 0; const float keep = bt ? x2[1] : x2[0], send = bt ? x2[0] : x2[1]; r = keep + __shfl_xor(send, 1); }
    r += __shfl_xor(r, 8); r += __shfl_xor(r, 16); r += __shfl_xor(r, 32);
    return r;
}
__device__ __forceinline__ void cexf(float& a, float& b) { float mx, mn; asm("v_max_f32 %0, %1, %2" : "=v"(mx) : "v"(a), "v"(b)); asm("v_min_f32 %0, %1, %2" : "=v"(mn) : "v"(a), "v"(b)); a = mx; b = mn; }
__device__ __forceinline__ float fmaxr(float a, float b) { float mx; asm("v_max_f32 %0, %1, %2" : "=v"(mx) : "v"(a), "v"(b)); return mx; }
__device__ __forceinline__ void sort16f(float (&a)[16]) {
#define CX(i, j) cexf(a[i], a[j]);
    CX(0,1) CX(2,3) CX(4,5) CX(6,7) CX(8,9) CX(10,11) CX(12,13) CX(14,15) CX(0,2) CX(1,3) CX(4,6) CX(5,7) CX(8,10) CX(9,11) CX(12,14) CX(13,15) CX(1,2) CX(5,6) CX(9,10) CX(13,14) CX(0,4) CX(1,5) CX(2,6) CX(3,7) CX(8,12) CX(9,13) CX(10,14) CX(11,15) CX(2,4) CX(3,5) CX(10,12) CX(11,13) CX(1,2) CX(3,4) CX(5,6) CX(9,10) CX(11,12) CX(13,14) CX(0,8) CX(1,9) CX(2,10) CX(3,11) CX(4,12) CX(5,13) CX(6,14) CX(7,15) CX(4,8) CX(5,9) CX(6,10) CX(7,11) CX(2,4) CX(3,5) CX(6,8) CX(7,9) CX(10,12) CX(11,13) CX(1,2) CX(3,4) CX(5,6) CX(7,8) CX(9,10) CX(11,12) CX(13,14)
#undef CX
}
__device__ __forceinline__ void merge16f(float (&A)[16], const float (&B)[16]) {
#pragma unroll
    for (int i = 0; i < 16; ++i) A[i] = fmaxr(A[i], B[15 - i]);
#pragma unroll
    for (int j = 8; j > 0; j >>= 1) {
#pragma unroll
        for (int i = 0; i < 16; ++i) { const int l = i ^ j; if (l > i) cexf(A[i], A[l]); }
    }
}
__device__ __forceinline__ float keyf(float v, unsigned mask, unsigned code) { return __builtin_bit_cast(float, (__builtin_bit_cast(unsigned, v) & mask) | code); }
}

__device__ __forceinline__ void p6a_ldq(const bf16* QP, int tg32, int h, int c, int ln, bf16x8 (&bq)[8]) {
    const bf16* base = QP + ((size_t)(tg32 * 16 + (h * 2 + c)) * 8) * 512 + ln * 8;
#pragma unroll
    for (int s = 0; s < 8; ++s) bq[s] = __builtin_nontemporal_load((const GAS bf16x8*)(base + 512 * s));
}
template <bool LOADQ, bool PREQ> __device__ __forceinline__ void p6a_top(Frame& F, const bf16* QP, int tg32, int h, int c, int hn, int cn, int hi, int r32, bf16x8 (&bq)[8], bf16x8 (&bqn)[8], float (&top)[16]) {
    int ln = hi * 32 + r32; asm volatile("" : "+v"(ln));
    if (LOADQ) p6a_ldq(QP, tg32, h, c, ln, bq);
    const bf16* ap0 = F_SUBK + (size_t)((h * 2 + c) * 32) * 512 + ln * 8;
    bf16x8 af[8];
#pragma unroll
    for (int s = 0; s < 8; ++s) af[s] = *(const GAS bf16x8*)(ap0 + 512 * s);
    unsigned km = ~127u; asm volatile("" : "+s"(km));
#pragma unroll
    for (int kt = 0; kt < 4; ++kt) {
        f32x16 acc;
#pragma unroll
        for (int r = 0; r < 16; ++r) acc[r] = 0.f;
#pragma unroll
        for (int s = 0; s < 8; ++s) acc = __builtin_amdgcn_mfma_f32_32x32x16_bf16(af[s], bq[s], acc, 0, 0, 0);
        if (kt < 3) {
#pragma unroll
            for (int s = 0; s < 8; ++s) af[s] = *(const GAS bf16x8*)(ap0 + 512 * (8 * (kt + 1) + s));
        }
        if (PREQ && kt == 3) p6a_ldq(QP, tg32, hn, cn, ln, bqn);
        __builtin_amdgcn_sched_group_barrier(0x008, 8, 0);
        if (kt < 3 || PREQ) __builtin_amdgcn_sched_group_barrier(0x020, 8, 0);
        float g[16];
#pragma unroll
        for (int r = 0; r < 16; ++r) g[r] = peer::keyf(acc[r], km, 63u - (unsigned)(16 * kt + r));
        peer::sort16f(g);
        if (kt == 0) {
#pragma unroll
            for (int r = 0; r < 16; ++r) top[r] = g[r];
        } else peer::merge16f(top, g);
    }
    const unsigned hb = hi ? 0u : 64u;
#pragma unroll
    for (int r = 0; r < 16; ++r) top[r] = __builtin_bit_cast(float, __builtin_bit_cast(unsigned, top[r]) | hb);
}
__device__ __forceinline__ void p6a_unit(Frame& F, int unit) {
    LAS unsigned char* L = F.lds + RING_OFF;
    const int lane = F.lane, w = F.wave, hi = lane >> 5, r32 = lane & 31;
    const bf16* QP = F_PROJ;
    const int tg = w & 3, hs = w >> 2;
    const int tbase = (F.G * 128 == TT) ? (tg >> 1) * (TT / 2) + unit * 64 + (tg & 1) * 32 : unit * 128 + tg * 32;
    const size_t tokrow = (size_t)tbase + r32;
    LAS unsigned char* myidx = L + peer::IDX_OFF + (w * 64 + lane) * 32;
    const int tg32 = tbase >> 5;
    bf16x8 bqa[8], bqb[8];
    { int ln0 = lane; asm volatile("" : "+v"(ln0)); p6a_ldq(QP, tg32, hs * 4, 0, ln0, bqa); }
    for (int hp = 0; hp < 2; ++hp) {
        const int h0 = hs * 4 + 2 * hp, h = h0 + hi;
        const int hnx = hp ? h0 : h0 + 2;
        float s01[2][16];
#define P6A_XMERGE(C) do { \
            _Pragma("unroll") for (int r = 0; r < 16; ++r) { auto rr = __builtin_amdgcn_permlane32_swap(__builtin_bit_cast(unsigned, T0[r]), __builtin_bit_cast(unsigned, T1[r]), false, false); \
                T0[r] = __builtin_bit_cast(float, (unsigned)rr[0]); T1[r] = __builtin_bit_cast(float, (unsigned)rr[1]); }     \
            peer::merge16f(T0, T1); \
            _Pragma("unroll") for (int r = 0; r < 16; ++r) s01[C][r] = T0[r]; } while (0)
        { float T0[16], T1[16];
          p6a_top<false, true>(F, QP, tg32, h0, 0, h0 + 1, 0, hi, r32, bqa, bqb, T0); p6a_top<false, true>(F, QP, tg32, h0 + 1, 0, h0, 1, hi, r32, bqb, bqa, T1);
          P6A_XMERGE(0); }
        { float T0[16], T1[16];
          p6a_top<false, true>(F, QP, tg32, h0, 1, h0 + 1, 1, hi, r32, bqa, bqb, T0); p6a_top<false, true>(F, QP, tg32, h0 + 1, 1, hnx, 0, hi, r32, bqb, bqa, T1);
          P6A_XMERGE(1); }
#undef P6A_XMERGE
        { v4u i0, i1;
#define IDX4(S, o) ((127u - (__builtin_bit_cast(unsigned, (S)[o]) & 127u)) | ((127u - (__builtin_bit_cast(unsigned, (S)[o + 1]) & 127u)) << 8) | ((127u - (__builtin_bit_cast(unsigned, (S)[o + 2]) & 127u)) << 16) | ((127u - (__builtin_bit_cast(unsigned, (S)[o + 3]) & 127u)) << 24))
          i0.x = IDX4(s01[0], 0); i0.y = IDX4(s01[0], 4); i0.z = IDX4(s01[0], 8); i0.w = IDX4(s01[0], 12);
          i1.x = IDX4(s01[1], 0); i1.y = IDX4(s01[1], 4); i1.z = IDX4(s01[1], 8); i1.w = IDX4(s01[1], 12);
#undef IDX4
          *(LAS v4u*)(myidx) = i0; *(LAS v4u*)(myidx + 16) = i1; }
        const float NEG = __builtin_bit_cast(float, 0xFF800000u);
        const float (&f0)[16] = s01[0]; const float (&f1)[16] = s01[1];
#define CK(a, b) peer::keyf(f0[a] + f1[b], ~255u, 255u - (unsigned)(16 * (a) + (b)))
        float best[16], g[16];
#pragma unroll
        for (int b = 0; b < 16; ++b) best[b] = CK(0, b);
#pragma unroll
        for (int a = 1; a < 16; ++a) g[a - 1] = CK(a, 0);
        g[15] = NEG;
        peer::merge16f(best, g);
        g[0] = CK(1, 1); g[1] = CK(1, 2); g[2] = CK(1, 3); g[3] = CK(1, 4); g[4] = CK(1, 5); g[5] = CK(1, 6); g[6] = CK(1, 7);
        g[7] = CK(2, 1); g[8] = CK(2, 2); g[9] = CK(2, 3); g[10] = CK(2, 4); g[11] = CK(3, 1); g[12] = CK(3, 2); g[13] = CK(3, 3); g[14] = CK(4, 1); g[15] = CK(4, 2);
        peer::sort16f(g); peer::merge16f(best, g);
        g[0] = CK(5, 1); g[1] = CK(6, 1); g[2] = CK(7, 1);
#pragma unroll
        for (int r = 3; r < 16; ++r) g[r] = NEG;
        peer::merge16f(best, g);
#undef CK
        float ev[16]; float esum = 0.f; const float vmax = best[0];
#pragma unroll
        for (int k = 0; k < 16; ++k) { ev[k] = __expf(best[k] - vmax); esum += ev[k]; }
        const float einv = 1.f / esum;
        unsigned ent[16];
#pragma unroll
        for (int k = 0; k < 16; ++k) { const unsigned ab = 255u - (__builtin_bit_cast(unsigned, best[k]) & 255u); const unsigned ia = *(const LAS unsigned char*)(myidx + (ab >> 4)), ib = *(const LAS unsigned char*)(myidx + 16 + (ab & 15u));
            ent[k] = (ia * 128u + ib) | (f2bf(ev[k] * einv) << 16); }
        GAS v4u* dst = (GAS v4u*)((GAS unsigned*)(FWS(unsigned, WS_EXPG)) + tokrow * 128 + h * 16);
#pragma unroll
        for (int k = 0; k < 4; ++k) { v4u o; o.x = ent[4 * k]; o.y = ent[4 * k + 1]; o.z = ent[4 * k + 2]; o.w = ent[4 * k + 3]; dst[k] = o; }
    }
}
template <bool DUMMY> __device__ __forceinline__ void p6b_phase(Frame& F) {
    LAS unsigned char* L = F.lds + RING_OFF;
    const int lane = F.lane, w = F.wave;
    const unsigned* EXPG = FWS(unsigned, WS_EXPG);
    LAS unsigned char* WB = L + peer::W6_OFF + w * 12288;
    const int gw = F.vcu * NWAVES + w, NGW = F.G * NWAVES;
    const int K = TT / (NGW * 8);
    const bool swapped = (K == 2) && (w >= 4);
#pragma unroll 1
    for (int step = 0; step < 2 * K; ++step) {
        const int kind = swapped ? (step >> 1) : (step & 1), grp = swapped ? (step & 1) : (step >> 1);
        const int tok0 = (gw + grp * NGW) * 8;
        LAS unsigned* EW = (LAS unsigned*)(WB + (grp & 1) * 4096);
        LAS _Float16* AH = (LAS _Float16*)(WB + 8192 + (grp & 1) * 2048);
        int ln = lane; asm volatile("" : "+v"(ln));
        const int ts = ln >> 3, dc = ln & 7;
        const __amdgpu_buffer_rsrc_t ubase = __builtin_amdgcn_make_buffer_rsrc((void*)F_U, 0, 16384 * 512, 0x00020000);
        const __amdgpu_buffer_rsrc_t vbase = __builtin_amdgcn_make_buffer_rsrc((void*)F_V, 0, 16384 * 512, 0x00020000);
        const int dc16 = dc * 16;
        const size_t tok = (size_t)tok0 + ts;
        if (kind == 0) {
#pragma unroll
        for (int i = 0; i < 16; ++i) EW[i * 64 + ln] = __builtin_nontemporal_load(EXPG + (size_t)tok0 * 128 + i * 64 + ln);
        LDS_WAIT(); asm volatile("" ::: "memory");
        {
            float k[16];
            LAS v4u* row = (LAS v4u*)(EW + ts * 128 + dc * 16);
#pragma unroll
            for (int c = 0; c < 4; ++c) { const v4u e = row[c];
#pragma unroll
                for (int i = 0; i < 4; ++i) k[4 * c + i] = __builtin_bit_cast(float, 0x3F800000u | ((e[i] & 0xffffu) << 7) | (unsigned)(dc * 16 + 4 * c + i)); }
            peer::sort16f(k);
            const float pinf = __builtin_inff();
            const float c1 = (dc & 1) ? -pinf : pinf, c2 = (dc & 2) ? -pinf : pinf, c4 = (dc & 4) ? -pinf : pinf;
#define P6_XFLIP(CTRL, cc) do { float t_[16]; _Pragma("unroll") for (int i = 0; i < 16; ++i) t_[i] = peer::dppf<CTRL>(k[15 - i]); \
                _Pragma("unroll") for (int i = 0; i < 16; ++i) k[i] = __builtin_amdgcn_fmed3f(k[i], t_[i], (cc)); } while (0)
#define P6_XSTEP(CTRL, cc) do { _Pragma("unroll") for (int i = 0; i < 16; ++i) k[i] = __builtin_amdgcn_fmed3f(k[i], peer::dppf<CTRL>(k[i]), (cc)); } while (0)
#define P6_INLANE() do { _Pragma("unroll") for (int j = 8; j >= 1; j >>= 1) { _Pragma("unroll") for (int i = 0; i < 16; ++i) { const int l = i ^ j; if (l > i) peer::cexf(k[i], k[l]); } } } while (0)
            P6_XFLIP(0xB1, c1); P6_INLANE();
            P6_XFLIP(0x1B, c2); P6_XSTEP(0xB1, c1); P6_INLANE();
            P6_XFLIP(0x141, c4); P6_XSTEP(0x4E, c2); P6_XSTEP(0xB1, c1); P6_INLANE();
#undef P6_XFLIP
#undef P6_XSTEP
#undef P6_INLANE
            unsigned ev[16];
#pragma unroll
            for (int i = 0; i < 16; ++i) ev[i] = EW[ts * 128 + (int)(__builtin_bit_cast(unsigned, k[i]) & 127u)];
            LDS_WAIT(); asm volatile("" ::: "memory");
#pragma unroll
            for (int c = 0; c < 4; ++c) row[c] = (v4u){ev[4 * c], ev[4 * c + 1], ev[4 * c + 2], ev[4 * c + 3]};
        }
        float rstd;
        { const float* sq = F_SSQ + tok * 16 + 2 * dc; float ssp = sq[0] + sq[1]; ssp += __shfl_xor(ssp, 1); ssp += __shfl_xor(ssp, 2); ssp += __shfl_xor(ssp, 4);
          rstd = 1.f / sqrtf(ssp * (1.f / 1024.f) + RMS_EPS); }
        unsigned hq[16];
        { const float qs = rstd * (1.f / QSTEP);
#pragma unroll
          for (int q = 0; q < 16; ++q) { float g8[8]; up8(*(const GAS v4u*)(F_XN + tok * 1024 + 64 * q + 8 * dc), g8); unsigned wq = 0u;
#pragma unroll
              for (int e2 = 0; e2 < 8; ++e2) { const int qv = (int)__builtin_rintf(__builtin_fminf(__builtin_fmaxf(g8[e2] * qs, -8.f), 7.f)); wq |= ((unsigned)qv & 15u) << (4 * e2); }
              hq[q] = wq; } }
        const float dscale = QSTEP * QSTEP * (1.f / 32.f);
        LDS_WAIT(); asm volatile("" ::: "memory");
#ifndef P6_AUX
#define P6_AUX 1
#endif
#define P6_ROWLD(R, base_, st_) do { const unsigned e0_ = EW[ts * 128 + 2 * (st_)] & 0xffffu, e1_ = EW[ts * 128 + 2 * (st_) + 1] & 0xffffu; \
            _Pragma("unroll") for (int c = 0; c < 4; ++c) { R[c] = __builtin_amdgcn_raw_buffer_load_b128((base_), (int)(e0_ * 512u) + dc16 + 128 * c, 0, P6_AUX); R[4 + c] = __builtin_amdgcn_raw_buffer_load_b128((base_), (int)(e1_ * 512u) + dc16 + 128 * c, 0, P6_AUX); } } while (0)
#define P6_IDOT(V4, hq4_, acc_) do { acc_ = __builtin_amdgcn_sdot8((int)(V4).x, (int)hq[(hq4_)], acc_, false); acc_ = __builtin_amdgcn_sdot8((int)(V4).y, (int)hq[(hq4_) + 1], acc_, false); \
            acc_ = __builtin_amdgcn_sdot8((int)(V4).z, (int)hq[(hq4_) + 2], acc_, false); acc_ = __builtin_amdgcn_sdot8((int)(V4).w, (int)hq[(hq4_) + 3], acc_, false); } while (0)
#define P6_DOT2(R, P, j0_) do { int i0_ = 0, i1_ = 0, i2_ = 0, i3_ = 0; \
            P6_IDOT(R[0], 0, i0_); P6_IDOT(R[1], 4, i1_); P6_IDOT(R[2], 8, i0_); P6_IDOT(R[3], 12, i1_); \
            P6_IDOT(R[4], 0, i2_); P6_IDOT(R[5], 4, i3_); P6_IDOT(R[6], 8, i2_); P6_IDOT(R[7], 12, i3_); \
            P[j0_] = (float)(i0_ + i1_); P[(j0_) + 1] = (float)(i2_ + i3_); } while (0)
        {
            v4u ra[8], rb[8];
            P6_ROWLD(ra, ubase, 0);
#pragma unroll 1
            for (int gq = 0; gq < 16; ++gq) {
                float p8[8];
                const int st = 4 * gq;
                P6_ROWLD(rb, ubase, st + 1); P6_DOT2(ra, p8, 0);
                P6_ROWLD(ra, ubase, st + 2); P6_DOT2(rb, p8, 2);
                P6_ROWLD(rb, ubase, st + 3); P6_DOT2(ra, p8, 4);
                if (gq < 15) P6_ROWLD(ra, ubase, st + 4);
                P6_DOT2(rb, p8, 6);
                const float d = peer::transpose_reduce8_dc(p8, lane);
                const unsigned ent = EW[ts * 128 + 8 * gq + dc];
                AH[ts * 128 + 8 * gq + dc] = (_Float16)(__builtin_bit_cast(float, ent & 0xffff0000u) * gelu_tanh(d * dscale));
            }
        }
        LDS_WAIT(); asm volatile("" ::: "memory");
        } else {
        peer::h16x2 acc[64];
#pragma unroll
        for (int j = 0; j < 64; ++j) acc[j] = (peer::h16x2){(_Float16)0.f, (_Float16)0.f};
#define P6_AXPY2(R, st_) do { const _Float16 a0_ = AH[ts * 128 + 2 * (st_)], a1_ = AH[ts * 128 + 2 * (st_) + 1]; \
            _Pragma("unroll") for (int c = 0; c < 4; ++c) { peer::axpy32h(*(peer::h16x2 (*)[16])(acc + 16 * c), R[c], a0_); peer::axpy32h(*(peer::h16x2 (*)[16])(acc + 16 * c), R[4 + c], a1_); } } while (0)
        {
            v4u ra[8], rb[8];
            P6_ROWLD(ra, vbase, 0);
#pragma unroll 1
            for (int st = 0; st < 64; st += 2) {
                P6_ROWLD(rb, vbase, st + 1); P6_AXPY2(ra, st);
                if (st + 2 < 64) P6_ROWLD(ra, vbase, st + 2);
                P6_AXPY2(rb, st + 1);
            }
        }
#undef P6_ROWLD
#undef P6_DOT2
#undef P6_IDOT
#undef P6_AXPY2
        const float vs = 1.f / VSCALE; float ss = 0.f;
        int ln2 = lane; asm volatile("" : "+v"(ln2));
        const int ts2 = ln2 >> 3, dc2 = ln2 & 7; const size_t tok2 = (size_t)tok0 + ts2;
        v4u hv[16];
#pragma unroll
        for (int q = 0; q < 16; ++q) hv[q] = *(const GAS v4u*)(F_XN + tok2 * 1024 + 64 * q + 8 * dc2);
#pragma unroll
        for (int q = 0; q < 16; ++q) { float g8[8]; up8(hv[q], g8);
#pragma unroll
            for (int e2 = 0; e2 < 4; ++e2) { const peer::h16x2 av = acc[4 * q + e2]; g8[2 * e2] += (float)av.x * vs; g8[2 * e2 + 1] += (float)av.y * vs; }
#pragma unroll
            for (int e2 = 0; e2 < 8; ++e2) ss += g8[e2] * g8[e2]; }
        ss += __shfl_xor(ss, 1); ss += __shfl_xor(ss, 2); ss += __shfl_xor(ss, 4);
        const float rs = 1.f / sqrtf(ss * (1.f / 1024.f) + RMS_EPS);
#pragma unroll
        for (int q = 0; q < 16; ++q) { float* op = (DUMMY ? FWS(float, 160 * MiB) : F_out) + tok2 * 1024 + 64 * q + 8 * dc2; const float* gp = F_lnf + 64 * q + 8 * dc2;
            float g8[8]; up8(hv[q], g8);
#pragma unroll
            for (int e2 = 0; e2 < 4; ++e2) { const peer::h16x2 av = acc[4 * q + e2]; g8[2 * e2] += (float)av.x * vs; g8[2 * e2 + 1] += (float)av.y * vs; }
            const f32x4 ga = *(const GAS f32x4*)gp, gb = *(const GAS f32x4*)(gp + 4);
            *(GAS f32x4*)op = (f32x4){g8[0], g8[1], g8[2], g8[3]} * rs * ga; *(GAS f32x4*)(op + 4) = (f32x4){g8[4], g8[5], g8[6], g8[7]} * rs * gb; }
        LDS_WAIT(); asm volatile("" ::: "memory");
        }
    }
}
__device__ __forceinline__ void p6a_phase(Frame& F) { for (int u = F.vcu; u < TT / 128; u += F.G) p6a_unit(F, u); }
#ifndef HYB
#define HYB 7
#endif
__global__ void __launch_bounds__(NWAVES * 64, 2) mk_fwd(Args args) {
    extern __shared__ __attribute__((aligned(16))) unsigned char lds[];
    Frame F;
    F.lds = (LAS unsigned char*)lds;
    F.MISC = (volatile LAS unsigned*)(F.lds + MISC_OFF);
    F.tid = threadIdx.x; F.lane = F.tid & 63; F.wave = __builtin_amdgcn_readfirstlane(F.tid >> 6);
    F.G = gridDim.x; { const int bx = blockIdx.x; F.vcu = (F.G % 8 == 0) ? (bx % 8) * (F.G / 8) + bx / 8 : bx; }
    F.a = &args;
    F.ctl = (gu32*)(args.ws + WS_CTL);
    for (int u = F.tid; u < (LDS_BYTES - LDSCTL_OFF) / 4; u += NWAVES * 64) ((LAS unsigned*)(F.lds + LDSCTL_OFF))[u] = 0u;
    __syncthreads();
    XcdBarrier bar = xcd_barrier_post((unsigned*)(F.ctl + CW_BAR), F.MISC + 8);
    const int lo = args.ph_lo, hi = args.ph_hi;
#define IN(k) (lo <= (k) && (k) < hi)
#define BOTH(k) (IN(k) && IN((k) + 1))
    if (IN(0)) { p0_prologue(F);
#ifdef DUP_P0
        p0_prologue(F);
#endif
        if (BOTH(0)) xcd_barrier(bar); }
    if (IN(1)) {
        pg8::Gemm g{F_XN, F_WinT, TT, NPROJ, DM}; pg8::StaticOrder S; S.init(TT, NPROJ, F.G, (int)blockIdx.x);
        pg8::EpiProj E{F_PROJ, NPROJ, C_Q / 256, C_KC / 256, QSCALE};
        pg8::gemm_phase<pg8::EpiProj, pg8::StaticOrder, true, true>(F.lds + RING_OFF, g, S, E);
#ifdef DUP_P1
        pg8::gemm_phase<pg8::EpiProj, pg8::StaticOrder, true, true>(F.lds + RING_OFF, g, S, E);
#endif
        if (BOTH(1)) xcd_barrier(bar);
    }
#ifdef DUP_BAR
    if (IN(2)) { for (int zz = 0; zz < 10; ++zz) xcd_barrier(bar); }
#endif
    if (IN(2)) { p2_phase(F);
#ifdef DUP_P2
        p2_phase(F);
#endif
        if (BOTH(2)) xcd_barrier(bar); }
#if HYB >= 4
    if (IN(3)) { p3_attention(F);
#ifdef DUP_P3
        p3_attention(F);
#endif
        if (BOTH(3)) xcd_barrier(bar); }
#endif
#if HYB >= 5
    if (IN(4)) {
        pg8::Gemm g{F_MIXA, F_WoutT, TT, DM, DM}; pg8::StaticOrder S; S.init(TT, DM, F.G, (int)blockIdx.x);
        pg8::EpiResid E{F_x, F_XN, F_SSQ, DM};
        pg8::gemm_phase<pg8::EpiResid, pg8::StaticOrder, true, true>(F.lds + RING_OFF, g, S, E);
#ifdef DUP_P4
        pg8::gemm_phase<pg8::EpiResid, pg8::StaticOrder, true, true>(F.lds + RING_OFF, g, S, E);
#endif
        if (BOTH(4)) xcd_barrier(bar);
    }
#endif
#if HYB >= 6
    if (IN(5)) {
        pg8::Gemm g{F_XN, F_WqT, TT, NQP, DM}; pg8::StaticOrder S; S.init(TT, NQP, F.G, (int)blockIdx.x);
        pg8::EpiScaleRow E{F_PROJ, NQP, F_SSQ, RMS_EPS};
        pg8::gemm_phase<pg8::EpiScaleRow, pg8::StaticOrder, true, true>(F.lds + RING_OFF, g, S, E);
#ifdef DUP_P5
        pg8::gemm_phase<pg8::EpiScaleRow, pg8::StaticOrder, true, true>(F.lds + RING_OFF, g, S, E);
#endif
        if (BOTH(5)) xcd_barrier(bar);
    }
#endif
#if HYB >= 7
    if (IN(6)) { p6a_phase(F);
#ifdef DUP_6A
        p6a_phase(F);
#endif
        if (F.G * 128 == TT) { asm volatile("s_waitcnt vmcnt(0)" ::: "memory"); __syncthreads(); }
        else xcd_barrier(bar);
#ifdef DUP_6B
        p6b_phase<true>(F);
#endif
        p6b_phase<false>(F); }
#endif
#undef IN
#undef BOTH
}

extern "C" void kernel_launch(void* const* d_in, const int* in_sizes, int n_in, void* d_out, int out_size, void* d_ws, size_t ws_size, hipStream_t stream) {
    static int grid = 0;
    if (grid == 0) {
        if (n_in != 19 || in_sizes[0] != TT * DM || out_size != TT * DM || ws_size < 512 * MiB) { fprintf(stderr, "kernel_launch: unexpected shapes (n_in %d, in0 %d, out %d, ws %zu); nothing launched\n", n_in, n_in > 0 ? in_sizes[0] : -1, out_size, ws_size); grid = -1; return; }
        int dev = 0, cus = 0, per_cu = 0;
        if (hipGetDevice(&dev) != hipSuccess || hipDeviceGetAttribute(&cus, hipDeviceAttributeMultiprocessorCount, dev) != hipSuccess) { grid = -1; return; }
        if (hipFuncSetAttribute((const void*)mk_fwd, hipFuncAttributeMaxDynamicSharedMemorySize, LDS_BYTES) != hipSuccess) { fprintf(stderr, "kernel_launch: hipFuncSetAttribute failed\n"); grid = -1; return; }
        if (hipOccupancyMaxActiveBlocksPerMultiprocessor(&per_cu, (const void*)mk_fwd, NWAVES * 64, LDS_BYTES) != hipSuccess || per_cu < 1) fprintf(stderr, "kernel_launch: note: occupancy query reports %d workgroups per CU\n", per_cu);
        (void)hipGetLastError();
        grid = cus;
    }
    if (grid < 0) return;
    if (hipMemsetAsync((char*)d_ws + WS_CTL, 0, CTL_ZERO_BYTES, stream) != hipSuccess) return;
    Args a{};
    for (int i = 0; i < 19; ++i) a.in[i] = (const float*)d_in[i];
    a.out = (float*)d_out; a.ws = (unsigned char*)d_ws; a.ph_lo = 0; a.ph_hi = HYB;
    hipLaunchKernelGGL(mk_fwd, dim3(grid), dim3(NWAVES * 64), LDS_BYTES, stream, a);
#if HYB < 7
    using namespace nv;
    char* ws = (char*)d_ws;
    const float* x = a.in[0]; const float* conv_w = a.in[3]; const float* pos_k = a.in[4]; const float* pos_v = a.in[5]; const float* k_w1 = a.in[6]; const float* k_w2 = a.in[7]; const float* v_w1 = a.in[8]; const float* v_w2 = a.in[9];
    const float* gn_conv = a.in[10]; const float* gn_attn = a.in[11]; const float* w_out = a.in[12]; const float* ln2 = a.in[13]; const float* wq = a.in[14]; const float* subkeys = a.in[15]; const float* pu = a.in[16]; const float* pv = a.in[17]; const float* lnf = a.in[18];
    float* out = (float*)d_out;
    const bf16* PROJ = (const bf16*)(ws + WS_PROJ); const bf16* MIXA = (const bf16*)(ws + WS_MIXA); const bf16* KCC = (const bf16*)(ws + WS_KCC); const bf16* VCC = (const bf16*)(ws + WS_VCC);
    float* MIXF = (float*)(ws + 32 * MiB);
    float* KCF = (float*)(ws + 420 * MiB); float* VCF = (float*)(ws + 422 * MiB);
    float* QPF = (float*)(ws + 160 * MiB);
    int* EIDX = (int*)(ws + 424 * MiB); float* EGATE = (float*)(ws + 440 * MiB);
#if HYB <= 2
    conv_kernel<bf16><<<TT / 4, 256, 0, stream>>>(PROJ, NPROJ, conv_w, gn_conv, MIXF);
    (void)hipMemsetAsync(KCF, 0, 4 * MiB, stream);
    compress_kernel<bf16><<<BATCH * N_CMP * 2, 256, 0, stream>>>(PROJ, NPROJ, C_KC, pos_k, k_w1, k_w2, KCF);
    compress_kernel<bf16><<<BATCH * N_CMP * 2, 256, 0, stream>>>(PROJ, NPROJ, C_VC, pos_v, v_w1, v_w2, VCF);
    nsa_naive<bf16, float, true><<<TT * 2, 256, 0, stream>>>(PROJ, NPROJ, KCF, VCF, MIXF);
    attn_norm<<<TT / 4, 256, 0, stream>>>(MIXF, gn_attn);
#elif HYB == 3
    cvt_bf16_f32<<<4096, 256, 0, stream>>>(MIXA, 1024, MIXF, 1024, TT, 512);
    nsa_naive<bf16, bf16, true><<<TT * 2, 256, 0, stream>>>(PROJ, NPROJ, KCC, VCC, MIXF);
    attn_norm<<<TT / 4, 256, 0, stream>>>(MIXF, gn_attn);
#elif HYB == 4
    cvt_bf16_f32<<<4096, 256, 0, stream>>>(MIXA, 1024, MIXF, 1024, TT, 1024);
#endif
#if HYB <= 4
    gemm_f32<float, true><<<dim3(1024 / 64, TT / 64), 256, 0, stream>>>(MIXF, 1024, w_out, out, x, TT, 1024, 1024);
#endif
    rmsnorm1024<<<TT / 4, 256, 0, stream>>>(out, ln2, MIXF, TT);
#if HYB <= 5
    gemm_f32<float, false><<<dim3(2048 / 64, TT / 64), 256, 0, stream>>>(MIXF, 1024, wq, QPF, nullptr, TT, 2048, 1024);
    peer_topk<float><<<TT * 8, 128, 0, stream>>>(QPF, subkeys, EIDX, EGATE);
#else
    peer_topk<bf16><<<TT * 8, 128, 0, stream>>>(PROJ, subkeys, EIDX, EGATE);
#endif
    peer_experts<<<TT, 256, 0, stream>>>(MIXF, EIDX, EGATE, pu, pv, lnf, out);
    (void)ln2; (void)KCC; (void)VCC; (void)MIXA;
#endif
}
```
